# Optimizing an MI355X kernel written in HIP

```python
import math
import jax, jax.numpy as jnp
from jax import lax
import numpy as np

D_MODEL = 2048
BATCH = 1
SEQ = 16384
DEPTH = 2

MIX_WIDTH = D_MODEL
POOL_WIDTH = MIX_WIDTH // 2
POOL_WINDOWS = (2, 4, 8, 16)
N_POOL_GROUPS = len(POOL_WINDOWS)
POOL_GROUP = POOL_WIDTH // N_POOL_GROUPS
GLA_WIDTH = MIX_WIDTH - POOL_WIDTH
GLA_HEADS = 4
GLA_DV = GLA_WIDTH // GLA_HEADS
GLA_KEY_WIDTH = GLA_WIDTH // 2
GLA_DK = GLA_KEY_WIDTH // GLA_HEADS
GATE_RANK = 16
GATE_TAU = 16.0
CHUNK = 64
IN_PROJ_WIDTH = POOL_WIDTH + 2 * GLA_KEY_WIDTH + GLA_WIDTH + GATE_RANK + GLA_WIDTH
D_FF_DENSE = 5632
N_EXPERTS = 8
TOP_K = 2
D_FF_EXPERT = 7168
MOE_BLOCK = 256
EPS = 1e-6
N_DENSE = (DEPTH + 1) // 2
N_MOE = DEPTH // 2

kernel_name = "hybrid_pool_gla_moe_trunk"


def rmsnorm(x, g):
    xf = x.astype(jnp.float32)
    y = xf * lax.rsqrt(jnp.mean(xf * xf, axis=-1, keepdims=True) + EPS)
    return (y * g.astype(jnp.float32)).astype(x.dtype)


def pool_mixer(u, w_pool, pool_scale):
    B, S, _ = u.shape
    ug = u.reshape(B, S, N_POOL_GROUPS, POOL_GROUP)
    c = jnp.cumsum(ug.astype(jnp.float32), axis=1)
    c = jnp.pad(c, ((0, 0), (1, 0), (0, 0), (0, 0)))
    t1 = jnp.arange(1, S + 1)
    diffs = []
    for gi, w in enumerate(POOL_WINDOWS):
        lo = jnp.maximum(t1 - w, 0)
        cg = c[:, :, gi]
        win_sum = cg[:, 1:] - cg[:, lo]
        count = (t1 - lo).astype(jnp.float32)[None, :, None]
        diffs.append(win_sum / count - ug[:, :, gi].astype(jnp.float32))
    d = jnp.stack(diffs, axis=2)
    y = jnp.einsum('bsgc,gcd->bsgd', d, w_pool.astype(jnp.float32)) * pool_scale.astype(jnp.float32)
    return y.reshape(B, S, POOL_WIDTH).astype(u.dtype)


def gla_mixer(q, k, v, gate_lr, r, w_gate_up, b_gate, gla_norm):
    B, S, _ = q.shape
    H, C, N = GLA_HEADS, CHUNK, S // CHUNK
    f32 = jnp.float32
    q = q.astype(f32).reshape(B, N, C, H, GLA_DK) * (GLA_DK ** -0.5)
    k = k.astype(f32).reshape(B, N, C, H, GLA_DK)
    v = v.astype(f32).reshape(B, N, C, H, GLA_DV)
    g = jax.nn.log_sigmoid(gate_lr.astype(f32) @ w_gate_up.astype(f32) + b_gate.astype(f32)) / GATE_TAU
    g = g.reshape(B, N, C, H, GLA_DK)
    bc = jnp.cumsum(g, axis=2)
    b_last = bc[:, :, -1]
    q_dec = q * jnp.exp(bc)
    k_dec = k * jnp.exp(-bc)
    k_to_end = k * jnp.exp(b_last[:, :, None] - bc)
    chunk_state = jnp.einsum('bnchk,bnchv->bnhkv', k_to_end, v)
    decay = jnp.exp(b_last)

    def step(state, inp):
        dec, cs = inp
        return dec[..., None] * state + cs, state

    init = jnp.zeros((B, H, GLA_DK, GLA_DV), f32)
    _, s_prev = lax.scan(step, init, (jnp.moveaxis(decay, 1, 0), jnp.moveaxis(chunk_state, 1, 0)))
    s_prev = jnp.moveaxis(s_prev, 0, 1)
    o_inter = jnp.einsum('bnchk,bnhkv->bnchv', q_dec, s_prev)
    att = jnp.einsum('bnihk,bnjhk->bnhij', q_dec, k_dec)
    causal = jnp.tril(jnp.ones((C, C), dtype=bool))
    att = jnp.where(causal, att, 0.0)
    o_intra = jnp.einsum('bnhij,bnjhv->bnihv', att, v)
    o = (o_inter + o_intra).reshape(B, S, H, GLA_DV)
    o = o * lax.rsqrt(jnp.mean(o * o, axis=-1, keepdims=True) + EPS) * gla_norm.astype(f32).reshape(H, GLA_DV)
    o = o.reshape(B, S, GLA_WIDTH) * jax.nn.silu(r.astype(f32))
    return o.astype(r.dtype)


def swiglu(h, w_gate, w_up, w_down):
    return (jax.nn.silu(h @ w_gate) * (h @ w_up)) @ w_down


def moe_swiglu(h, w_router, e_gate, e_up, e_down):
    B, S, D = h.shape
    T = B * S
    A = T * TOP_K
    hf = h.reshape(T, D)
    logits = (hf @ w_router).astype(jnp.float32)
    top_vals, top_idx = lax.top_k(logits, TOP_K)
    top_w = jax.nn.softmax(top_vals, axis=-1)
    flat_e = top_idx.reshape(-1)
    flat_w = top_w.reshape(-1)
    flat_tok = jnp.arange(A, dtype=jnp.int32) // TOP_K
    order = jnp.argsort(flat_e)
    e_sorted = flat_e[order]
    counts = jnp.bincount(flat_e, length=N_EXPERTS)
    padded = ((counts + MOE_BLOCK - 1) // MOE_BLOCK) * MOE_BLOCK
    grp_start = jnp.cumsum(counts) - counts
    cum_padded = jnp.cumsum(padded)
    pad_start = cum_padded - padded
    dest = pad_start[e_sorted] + (jnp.arange(A) - grp_start[e_sorted])
    n_blocks = (A + MOE_BLOCK - 1) // MOE_BLOCK + N_EXPERTS
    L = n_blocks * MOE_BLOCK
    slot_tok = jnp.full((L,), T, jnp.int32).at[dest].set(flat_tok[order])
    slot_w = jnp.zeros((L,), jnp.float32).at[dest].set(flat_w[order])
    block_expert = jnp.minimum(
        jnp.searchsorted(cum_padded, jnp.arange(n_blocks) * MOE_BLOCK, side='right'), N_EXPERTS - 1)
    x_pad = jnp.concatenate([hf, jnp.zeros((1, D), hf.dtype)], axis=0)
    xb = x_pad[slot_tok].reshape(n_blocks, MOE_BLOCK, D)

    def run_block(args):
        xblk, e = args
        return (jax.nn.silu(xblk @ e_gate[e]) * (xblk @ e_up[e])) @ e_down[e]

    yb = lax.map(run_block, (xb, block_expert))
    y = yb.reshape(L, D) * slot_w.astype(yb.dtype)[:, None]
    out = jnp.zeros((T + 1, D), y.dtype).at[slot_tok].add(y)[:T]
    return out.reshape(B, S, D)


def setup_inputs(seed: int = 0) -> dict:
    key = jax.random.key(seed)
    ks = jax.random.split(key, 20)
    nrm = lambda k, shape, fan_in: jax.random.normal(k, shape, jnp.float32) * (fan_in ** -0.5)
    gain = lambda k, shape: 1.0 + 0.02 * jax.random.normal(k, shape, jnp.float32)
    return {
        "x": jax.random.normal(ks[0], (BATCH, SEQ, D_MODEL), jnp.float32),
        "mix_norm": gain(ks[1], (DEPTH, D_MODEL)),
        "w_in": nrm(ks[2], (DEPTH, D_MODEL, IN_PROJ_WIDTH), D_MODEL),
        "w_pool": nrm(ks[3], (DEPTH, N_POOL_GROUPS, POOL_GROUP, POOL_GROUP), POOL_GROUP),
        "pool_scale": gain(ks[4], (DEPTH, N_POOL_GROUPS, POOL_GROUP)),
        "w_gate_up": nrm(ks[5], (DEPTH, GATE_RANK, GLA_KEY_WIDTH), GATE_RANK),
        "b_gate": 0.1 * jax.random.normal(ks[6], (DEPTH, GLA_KEY_WIDTH), jnp.float32),
        "gla_norm": gain(ks[7], (DEPTH, GLA_WIDTH)),
        "w_out": nrm(ks[8], (DEPTH, MIX_WIDTH, D_MODEL), MIX_WIDTH),
        "ffn_norm": gain(ks[9], (DEPTH, D_MODEL)),
        "dense_w_gate": nrm(ks[10], (N_DENSE, D_MODEL, D_FF_DENSE), D_MODEL),
        "dense_w_up": nrm(ks[11], (N_DENSE, D_MODEL, D_FF_DENSE), D_MODEL),
        "dense_w_down": nrm(ks[12], (N_DENSE, D_FF_DENSE, D_MODEL), D_FF_DENSE),
        "w_router": nrm(ks[13], (N_MOE, D_MODEL, N_EXPERTS), D_MODEL),
        "exp_w_gate": nrm(ks[14], (N_MOE, N_EXPERTS, D_MODEL, D_FF_EXPERT), D_MODEL),
        "exp_w_up": nrm(ks[15], (N_MOE, N_EXPERTS, D_MODEL, D_FF_EXPERT), D_MODEL),
        "exp_w_down": nrm(ks[16], (N_MOE, N_EXPERTS, D_FF_EXPERT, D_MODEL), D_FF_EXPERT),
        "final_norm": gain(ks[17], (D_MODEL,)),
    }


def reference(x, mix_norm, w_in, w_pool, pool_scale, w_gate_up, b_gate, gla_norm, w_out,
              ffn_norm, dense_w_gate, dense_w_up, dense_w_down, w_router,
              exp_w_gate, exp_w_up, exp_w_down, final_norm):
    splits = np.cumsum([POOL_WIDTH, GLA_KEY_WIDTH, GLA_KEY_WIDTH, GLA_WIDTH, GATE_RANK]).tolist()
    for l in range(DEPTH):
        h = rmsnorm(x, mix_norm[l])
        z = h @ w_in[l]
        u_pool, q, k, v, gate_lr, r = jnp.split(z, splits, axis=-1)
        pool_out = pool_mixer(u_pool, w_pool[l], pool_scale[l])
        gla_out = gla_mixer(q, k, v, gate_lr, r, w_gate_up[l], b_gate[l], gla_norm[l])
        x = x + jnp.concatenate([pool_out, gla_out], axis=-1) @ w_out[l]
        h = rmsnorm(x, ffn_norm[l])
        if l % 2 == 0:
            i = l // 2
            x = x + swiglu(h, dense_w_gate[i], dense_w_up[i], dense_w_down[i])
        else:
            i = l // 2
            x = x + moe_swiglu(h, w_router[i], exp_w_gate[i], exp_w_up[i], exp_w_down[i])
    return rmsnorm(x, final_norm)
```

```cpp
#include <hip/hip_runtime.h>
#include <cstdio>
#include <cstdint>
constexpr int T = 16384, DM = 2048, ZW = 4112;
constexpr float EPSF = 1e-6f;
constexpr int LSLOT = 34816, NRB_MAX = 136;
namespace ora {

__device__ __forceinline__ float wsum(float v) {
#pragma unroll
    for (int o = 1; o < 64; o <<= 1) v += __shfl_xor(v, o);
    return v;
}
__device__ __forceinline__ float siluf(float x) { return x / (1.0f + __expf(-x)); }

__global__ __launch_bounds__(256) void k_rmsnorm(const float* __restrict__ x, const float* __restrict__ g, float* __restrict__ y, int rows) {
    const int row = blockIdx.x * 4 + (threadIdx.x >> 6), lane = threadIdx.x & 63;
    if (row >= rows) return;
    const float4* xr = (const float4*)(x + (size_t)row * DM) + lane;
    float4 v[8]; float s = 0.f;
#pragma unroll
    for (int j = 0; j < 8; ++j) { v[j] = xr[64 * j]; s += v[j].x * v[j].x + v[j].y * v[j].y + v[j].z * v[j].z + v[j].w * v[j].w; }
    const float rstd = rsqrtf(wsum(s) * (1.0f / DM) + EPSF);
    const float4* gr = (const float4*)g + lane;
    float4* yr = (float4*)(y + (size_t)row * DM) + lane;
#pragma unroll
    for (int j = 0; j < 8; ++j) { const float4 gg = gr[64 * j]; float4 o; o.x = v[j].x * rstd * gg.x; o.y = v[j].y * rstd * gg.y; o.z = v[j].z * rstd * gg.z; o.w = v[j].w * rstd * gg.w; yr[64 * j] = o; }
}

struct GemmF {
    const float* A; int lda;
    const float* B; int ldb;
    float* C; int ldc;
    int M, N, K;
    const float* res;
    const float* colscale;
    const int* rowidx;
    const int* blk_expert;
    size_t bstride;
    const int* nrb_ptr;
    int mode;
    int rowblk0;
};

__global__ __launch_bounds__(256) void k_gemm_f32(GemmF p) {
    __shared__ float As[16][132];
    __shared__ float Bs[16][132];
    const int tid = threadIdx.x, tx = tid & 15, ty = tid >> 4;
    const int bm = blockIdx.y * 128, bn = blockIdx.x * 128;
    const int gblk = p.rowblk0 + (bm >> 8);
    if (p.nrb_ptr && gblk >= *p.nrb_ptr) return;
    const float* B = p.B;
    if (p.blk_expert) B += (size_t)p.blk_expert[gblk] * p.bstride;
    const float* arow[2]; int akq[2], arl[2];
#pragma unroll
    for (int i = 0; i < 2; ++i) { const int idx = tid + 256 * i; arl[i] = idx >> 2; akq[i] = idx & 3;
        const int r = bm + arl[i];
        const size_t rr = p.rowidx ? (size_t)p.rowidx[(size_t)p.rowblk0 * 256 + r] : (size_t)r;
        arow[i] = p.A + rr * p.lda + 4 * akq[i]; }
    int bkr[2], bnq[2]; bool bok[2];
#pragma unroll
    for (int i = 0; i < 2; ++i) { const int idx = tid + 256 * i; bkr[i] = idx >> 5; bnq[i] = idx & 31; bok[i] = (bn + 4 * bnq[i]) < p.N; }
    float acc[8][8];
#pragma unroll
    for (int i = 0; i < 8; ++i)
#pragma unroll
        for (int j = 0; j < 8; ++j) acc[i][j] = 0.f;
    for (int k0 = 0; k0 < p.K; k0 += 16) {
        float4 av[2], bv[2];
#pragma unroll
        for (int i = 0; i < 2; ++i) { av[i] = *(const float4*)(arow[i] + k0);
            bv[i] = bok[i] ? *(const float4*)(B + (size_t)(k0 + bkr[i]) * p.ldb + bn + 4 * bnq[i]) : make_float4(0.f, 0.f, 0.f, 0.f); }
        __syncthreads();
#pragma unroll
        for (int i = 0; i < 2; ++i) { As[4 * akq[i] + 0][arl[i]] = av[i].x; As[4 * akq[i] + 1][arl[i]] = av[i].y; As[4 * akq[i] + 2][arl[i]] = av[i].z; As[4 * akq[i] + 3][arl[i]] = av[i].w;
            *(float4*)&Bs[bkr[i]][4 * bnq[i]] = bv[i]; }
        __syncthreads();
#pragma unroll
        for (int kk = 0; kk < 16; ++kk) {
            const float4 a0 = *(const float4*)&As[kk][4 * ty], a1 = *(const float4*)&As[kk][64 + 4 * ty];
            const float4 b0 = *(const float4*)&Bs[kk][4 * tx], b1 = *(const float4*)&Bs[kk][64 + 4 * tx];
            const float a[8] = {a0.x, a0.y, a0.z, a0.w, a1.x, a1.y, a1.z, a1.w};
            const float b[8] = {b0.x, b0.y, b0.z, b0.w, b1.x, b1.y, b1.z, b1.w};
#pragma unroll
            for (int i = 0; i < 8; ++i)
#pragma unroll
                for (int j = 0; j < 8; ++j) acc[i][j] = fmaf(a[i], b[j], acc[i][j]);
        }
    }
#pragma unroll
    for (int i = 0; i < 8; ++i) {
        const int r = bm + (i < 4 ? 4 * ty + i : 64 + 4 * ty + (i - 4));
#pragma unroll
        for (int jh = 0; jh < 2; ++jh) {
            const int c = bn + jh * 64 + 4 * tx;
            if (c < p.N) {
                float4 o = make_float4(acc[i][jh * 4 + 0], acc[i][jh * 4 + 1], acc[i][jh * 4 + 2], acc[i][jh * 4 + 3]);
                float* cp = p.C + (size_t)r * p.ldc + c;
                if (p.colscale) { const float4 s = *(const float4*)(p.colscale + c); o.x *= s.x; o.y *= s.y; o.z *= s.z; o.w *= s.w; }
                if (p.res) { const float4 s = *(const float4*)(p.res + (size_t)r * p.ldc + c); o.x += s.x; o.y += s.y; o.z += s.z; o.w += s.w; }
                if (p.mode == 1) { const float4 g = *(const float4*)cp; o.x *= siluf(g.x); o.y *= siluf(g.y); o.z *= siluf(g.z); o.w *= siluf(g.w); }
                *(float4*)cp = o;
            }
        }
    }
}

__global__ __launch_bounds__(256) void k_pool_d(const float* __restrict__ z, float* __restrict__ d) {
    const size_t i = (size_t)blockIdx.x * 256 + threadIdx.x;
    const int t = (int)(i >> 10), c = (int)(i & 1023);
    const int w = 2 << (c >> 8);
    const int lo = (t + 1 - w) > 0 ? (t + 1 - w) : 0;
    float s = 0.f;
    for (int j = lo; j <= t; ++j) s += z[(size_t)j * ZW + c];
    d[i] = s / (float)(t + 1 - lo) - z[(size_t)t * ZW + c];
}

__global__ __launch_bounds__(256) void k_gate(const float* __restrict__ z, const float* __restrict__ wgu, const float* __restrict__ bg, float* __restrict__ ge) {
    const size_t i = (size_t)blockIdx.x * 256 + threadIdx.x;
    const int t = (int)(i >> 9), j = (int)(i & 511);
    float s = bg[j];
#pragma unroll
    for (int r = 0; r < 16; ++r) s = fmaf(z[(size_t)t * ZW + 3072 + r], wgu[r * 512 + j], s);
    const float ls = fminf(s, 0.f) - log1pf(__expf(-fabsf(s)));
    ge[i] = __expf(ls * (1.0f / 16.0f));
}

__global__ __launch_bounds__(256) void k_gla_rec(const float* __restrict__ z, const float* __restrict__ ge, float* __restrict__ o) {
    const int wv = blockIdx.x * 4 + (threadIdx.x >> 6), lane = threadIdx.x & 63;
    const int h = wv >> 8, v = wv & 255;
    float S0 = 0.f, S1 = 0.f;
    const float* qp = z + 1024 + h * 128 + lane;
    const float* kp = z + 1536 + h * 128 + lane;
    const float* vp = z + 2048 + h * 256 + v;
    const float* gp = ge + h * 128 + lane;
    const float scale = 0.08838834764831845f;
#pragma unroll 4
    for (int t = 0; t < T; ++t) {
        const size_t zo = (size_t)t * ZW;
        const float q0 = qp[zo], q1 = qp[zo + 64], k0 = kp[zo], k1 = kp[zo + 64], vv = vp[zo];
        const float g0 = gp[(size_t)t * 512], g1 = gp[(size_t)t * 512 + 64];
        S0 = fmaf(g0, S0, k0 * vv); S1 = fmaf(g1, S1, k1 * vv);
        const float p = wsum(q0 * S0 + q1 * S1);
        if (lane == 0) o[(size_t)t * 1024 + h * 256 + v] = p * scale;
    }
}

__global__ __launch_bounds__(256) void k_gla_out(const float* __restrict__ o, const float* __restrict__ z, const float* __restrict__ gn, float* __restrict__ mix) {
    const int wv = blockIdx.x * 4 + (threadIdx.x >> 6), lane = threadIdx.x & 63;
    const int t = wv >> 2, h = wv & 3;
    const float4 ov = *(const float4*)(o + (size_t)t * 1024 + h * 256 + 4 * lane);
    const float ss = wsum(ov.x * ov.x + ov.y * ov.y + ov.z * ov.z + ov.w * ov.w);
    const float rstd = rsqrtf(ss * (1.0f / 256.0f) + EPSF);
    const float4 g = *(const float4*)(gn + h * 256 + 4 * lane);
    const float4 r = *(const float4*)(z + (size_t)t * ZW + 3088 + h * 256 + 4 * lane);
    float4 out; out.x = ov.x * rstd * g.x * siluf(r.x); out.y = ov.y * rstd * g.y * siluf(r.y); out.z = ov.z * rstd * g.z * siluf(r.z); out.w = ov.w * rstd * g.w * siluf(r.w);
    *(float4*)(mix + (size_t)t * 2048 + 1024 + h * 256 + 4 * lane) = out;
}

__global__ __launch_bounds__(256) void k_router(const float* __restrict__ hf, const float* __restrict__ wr, int* __restrict__ topi, float* __restrict__ topw) {
    const int t = blockIdx.x * 4 + (threadIdx.x >> 6), lane = threadIdx.x & 63;
    float acc[8];
#pragma unroll
    for (int e = 0; e < 8; ++e) acc[e] = 0.f;
    for (int j = 0; j < 32; ++j) { const int k = lane + 64 * j; const float hv = hf[(size_t)t * DM + k];
        const float4 w0 = *(const float4*)(wr + (size_t)k * 8), w1 = *(const float4*)(wr + (size_t)k * 8 + 4);
        acc[0] = fmaf(hv, w0.x, acc[0]); acc[1] = fmaf(hv, w0.y, acc[1]); acc[2] = fmaf(hv, w0.z, acc[2]); acc[3] = fmaf(hv, w0.w, acc[3]);
        acc[4] = fmaf(hv, w1.x, acc[4]); acc[5] = fmaf(hv, w1.y, acc[5]); acc[6] = fmaf(hv, w1.z, acc[6]); acc[7] = fmaf(hv, w1.w, acc[7]); }
#pragma unroll
    for (int e = 0; e < 8; ++e) acc[e] = wsum(acc[e]);
    if (lane == 0) {
        int i0 = 0; float v0 = acc[0];
#pragma unroll
        for (int e = 1; e < 8; ++e) if (acc[e] > v0) { v0 = acc[e]; i0 = e; }
        int i1 = -1; float v1 = -3.4e38f;
#pragma unroll
        for (int e = 0; e < 8; ++e) if (e != i0 && acc[e] > v1) { v1 = acc[e]; i1 = e; }
        const float e1 = __expf(v1 - v0), inv = 1.0f / (1.0f + e1);
        topi[2 * t] = i0; topi[2 * t + 1] = i1; topw[2 * t] = inv; topw[2 * t + 1] = e1 * inv;
    }
}

__global__ __launch_bounds__(64) void k_hist(const int* __restrict__ topi, int* __restrict__ hist) {
    const int b = blockIdx.x, lane = threadIdx.x;
    const int e0 = topi[2 * (64 * b + lane)], e1 = topi[2 * (64 * b + lane) + 1];
#pragma unroll
    for (int e = 0; e < 8; ++e) { const int c = __popcll(__ballot(e0 == e)) + __popcll(__ballot(e1 == e)); if (lane == 0) hist[b * 8 + e] = c; }
}
__global__ __launch_bounds__(256) void k_slot_init(int* __restrict__ slot_tok, float* __restrict__ slot_w) {
    const int i = blockIdx.x * 256 + threadIdx.x; if (i < LSLOT) { slot_tok[i] = T; slot_w[i] = 0.f; }
}
__global__ __launch_bounds__(64) void k_assign(const int* __restrict__ topi, const float* __restrict__ topw, const int* __restrict__ hist,
                                               int* __restrict__ slot_tok, float* __restrict__ slot_w, int* __restrict__ tok_slot, int* __restrict__ blk_expert, int* __restrict__ nrb) {
    const int b = blockIdx.x, lane = threadIdx.x;
    __shared__ int s_base[8], s_cum[8];
    if (lane < 8) { int tot = 0, before = 0; for (int bb = 0; bb < 256; ++bb) { const int c = hist[bb * 8 + lane]; if (bb < b) before += c; tot += c; }
        s_cum[lane] = ((tot + 255) / 256) * 256; s_base[lane] = before; }
    __syncthreads();
    if (lane == 0) { int run = 0; for (int e = 0; e < 8; ++e) { const int p = s_cum[e]; s_base[e] += run; run += p; s_cum[e] = run; }
        if (b == 0) { *nrb = run / 256; for (int rb = 0; rb < NRB_MAX; ++rb) { int e = 0; while (e < 8 && s_cum[e] <= rb * 256) ++e; blk_expert[rb] = e < 7 ? e : 7; } }
        for (int i = 0; i < 128; ++i) { const int a = 128 * b + i; const int e = topi[a]; const int s = s_base[e]++; slot_tok[s] = a >> 1; slot_w[s] = topw[a]; tok_slot[a] = s; } }
}
__global__ __launch_bounds__(256) void k_combine(float* __restrict__ x, const float* __restrict__ y, const int* __restrict__ tok_slot, const float* __restrict__ topw) {
    const size_t i = (size_t)blockIdx.x * 256 + threadIdx.x;
    const int t = (int)(i >> 9), c4 = (int)(i & 511);
    const int s0 = tok_slot[2 * t], s1 = tok_slot[2 * t + 1]; const float w0 = topw[2 * t], w1 = topw[2 * t + 1];
    float4 xv = ((float4*)x)[i]; const float4 a = ((const float4*)(y + (size_t)s0 * DM))[c4], b = ((const float4*)(y + (size_t)s1 * DM))[c4];
    xv.x += w0 * a.x + w1 * b.x; xv.y += w0 * a.y + w1 * b.y; xv.z += w0 * a.z + w1 * b.z; xv.w += w0 * a.w + w1 * b.w;
    ((float4*)x)[i] = xv;
}

static void gemm(hipStream_t st, GemmF p) {
    dim3 grid((p.N + 127) / 128, p.M / 128);
    hipLaunchKernelGGL(k_gemm_f32, grid, dim3(256), 0, st, p);
}

static void run(void* const* d_in, float* out, unsigned char* ws, hipStream_t st) {
    const float* x = (const float*)d_in[0]; const float* mix_norm = (const float*)d_in[1]; const float* w_in = (const float*)d_in[2];
    const float* w_pool = (const float*)d_in[3]; const float* pool_scale = (const float*)d_in[4]; const float* w_gate_up = (const float*)d_in[5];
    const float* b_gate = (const float*)d_in[6]; const float* gla_norm = (const float*)d_in[7]; const float* w_out = (const float*)d_in[8];
    const float* ffn_norm = (const float*)d_in[9]; const float* dwg = (const float*)d_in[10]; const float* dwu = (const float*)d_in[11];
    const float* dwd = (const float*)d_in[12]; const float* w_router = (const float*)d_in[13]; const float* ewg = (const float*)d_in[14];
    const float* ewu = (const float*)d_in[15]; const float* ewd = (const float*)d_in[16]; const float* final_norm = (const float*)d_in[17];
    size_t off = 0; auto take = [&](size_t bytes) { unsigned char* p = ws + off; off += (bytes + 255) & ~(size_t)255; return p; };
    float* xa = (float*)take((size_t)T * DM * 4);
    float* hf = (float*)take((size_t)(T + 1) * DM * 4);
    float* z = (float*)take((size_t)T * ZW * 4);
    float* dpool = (float*)take((size_t)T * 1024 * 4);
    float* mixf = (float*)take((size_t)T * 2048 * 4);
    float* ge = (float*)take((size_t)T * 512 * 4);
    float* o = (float*)take((size_t)T * 1024 * 4);
    float* gbuf = (float*)take((size_t)T * 5632 * 4);
    int* topi = (int*)take((size_t)T * 2 * 4); float* topw = (float*)take((size_t)T * 2 * 4);
    int* hist = (int*)take(256 * 8 * 4); int* slot_tok = (int*)take((size_t)LSLOT * 4); float* slot_w = (float*)take((size_t)LSLOT * 4);
    int* tok_slot = (int*)take((size_t)T * 2 * 4); int* blk_expert = (int*)take(NRB_MAX * 4); int* nrb = (int*)take(256);
    float* y = z;
    (void)hipMemsetAsync(hf + (size_t)T * DM, 0, DM * 4, st);
    const float* xcur = x;
    for (int l = 0; l < 2; ++l) {
        hipLaunchKernelGGL(k_rmsnorm, dim3(T / 4), dim3(256), 0, st, xcur, mix_norm + l * DM, hf, T);
        { GemmF p{}; p.A = hf; p.lda = DM; p.B = w_in + (size_t)l * DM * ZW; p.ldb = ZW; p.C = z; p.ldc = ZW; p.M = T; p.N = ZW; p.K = DM; gemm(st, p); }
        hipLaunchKernelGGL(k_pool_d, dim3(T * 1024 / 256), dim3(256), 0, st, z, dpool);
        for (int g = 0; g < 4; ++g) { GemmF p{}; p.A = dpool + g * 256; p.lda = 1024; p.B = w_pool + ((size_t)l * 4 + g) * 65536; p.ldb = 256; p.C = mixf + g * 256; p.ldc = 2048;
            p.M = T; p.N = 256; p.K = 256; p.colscale = pool_scale + (l * 4 + g) * 256 - 0;
            gemm(st, p); }
        hipLaunchKernelGGL(k_gate, dim3(T * 512 / 256), dim3(256), 0, st, z, w_gate_up + (size_t)l * 16 * 512, b_gate + l * 512, ge);
        hipLaunchKernelGGL(k_gla_rec, dim3(256), dim3(256), 0, st, z, ge, o);
        hipLaunchKernelGGL(k_gla_out, dim3(T), dim3(256), 0, st, o, z, gla_norm + l * 1024, mixf);
        { GemmF p{}; p.A = mixf; p.lda = 2048; p.B = w_out + (size_t)l * 2048 * 2048; p.ldb = 2048; p.C = xa; p.ldc = DM; p.M = T; p.N = DM; p.K = 2048; p.res = xcur; gemm(st, p); }
        xcur = xa;
        hipLaunchKernelGGL(k_rmsnorm, dim3(T / 4), dim3(256), 0, st, xcur, ffn_norm + l * DM, hf, T);
        if (l == 0) {
            { GemmF p{}; p.A = hf; p.lda = DM; p.B = dwg; p.ldb = 5632; p.C = gbuf; p.ldc = 5632; p.M = T; p.N = 5632; p.K = DM; gemm(st, p); }
            { GemmF p{}; p.A = hf; p.lda = DM; p.B = dwu; p.ldb = 5632; p.C = gbuf; p.ldc = 5632; p.M = T; p.N = 5632; p.K = DM; p.mode = 1; gemm(st, p); }
            { GemmF p{}; p.A = gbuf; p.lda = 5632; p.B = dwd; p.ldb = DM; p.C = xa; p.ldc = DM; p.M = T; p.N = DM; p.K = 5632; p.res = xa; gemm(st, p); }
        } else {
            hipLaunchKernelGGL(k_router, dim3(T / 4), dim3(256), 0, st, hf, w_router, topi, topw);
            hipLaunchKernelGGL(k_hist, dim3(256), dim3(64), 0, st, topi, hist);
            hipLaunchKernelGGL(k_slot_init, dim3((LSLOT + 255) / 256), dim3(256), 0, st, slot_tok, slot_w);
            hipLaunchKernelGGL(k_assign, dim3(256), dim3(64), 0, st, topi, topw, hist, slot_tok, slot_w, tok_slot, blk_expert, nrb);
            const int CH = 4352;
            for (int c = 0; c < LSLOT / CH; ++c) {
                const int rb0 = c * (CH / 256);
                { GemmF p{}; p.A = hf; p.lda = DM; p.B = ewg; p.ldb = 7168; p.C = gbuf; p.ldc = 7168; p.M = CH; p.N = 7168; p.K = DM; p.rowidx = slot_tok; p.blk_expert = blk_expert; p.bstride = (size_t)DM * 7168; p.nrb_ptr = nrb; p.rowblk0 = rb0; gemm(st, p); }
                { GemmF p{}; p.A = hf; p.lda = DM; p.B = ewu; p.ldb = 7168; p.C = gbuf; p.ldc = 7168; p.M = CH; p.N = 7168; p.K = DM; p.rowidx = slot_tok; p.blk_expert = blk_expert; p.bstride = (size_t)DM * 7168; p.nrb_ptr = nrb; p.rowblk0 = rb0; p.mode = 1; gemm(st, p); }
                { GemmF p{}; p.A = gbuf; p.lda = 7168; p.B = ewd; p.ldb = DM; p.C = y + (size_t)c * CH * DM; p.ldc = DM; p.M = CH; p.N = DM; p.K = 7168; p.blk_expert = blk_expert; p.bstride = (size_t)7168 * DM; p.nrb_ptr = nrb; p.rowblk0 = rb0; gemm(st, p); }
            }
            hipLaunchKernelGGL(k_combine, dim3(T * 512 / 256), dim3(256), 0, st, xa, y, tok_slot, topw);
        }
    }
    hipLaunchKernelGGL(k_rmsnorm, dim3(T / 4), dim3(256), 0, st, xcur, final_norm, out, T);
}
}
extern "C" void kernel_launch(void* const* d_in, const int* in_sizes, int n_in, void* d_out, int out_size, void* d_ws, size_t ws_size, hipStream_t stream) {
    ora::run(d_in, (float*)d_out, (unsigned char*)d_ws, stream);
}
```

```cpp
#include <hip/hip_runtime.h>
#include <cstdio>
#include <cstdint>
constexpr int T = 16384, DM = 2048, ZW = 4112;
constexpr float EPSF = 1e-6f;
constexpr int LSLOT = 34816, NRB_MAX = 136;
#define MK_MODE 1
#define DBG_CUT 0
namespace pg8 {
#define PG8_LAS __attribute__((address_space(3)))
typedef unsigned short bf16_t;
typedef short bf16x8 __attribute__((ext_vector_type(8)));
typedef float f32x4 __attribute__((ext_vector_type(4)));
typedef unsigned u32x4 __attribute__((ext_vector_type(4)));
constexpr int BM = 256, BK = 64, HALF = 128, HTB = HALF * BK * 2, STAGE_BYTES = 8 * HTB, NXCD = 8, WGM = 8;

__host__ __device__ __forceinline__ int lds_byte(int r, int c) { const int st = (r >> 4) * 2 + (c >> 5), rr = r & 15, cc = c & 31, ob = rr * 64 + cc * 2; return st * 1024 + (ob ^ (((ob >> 9) & 1) << 5)); }
__host__ __device__ __forceinline__ void stage_rc(int b, int& R, int& C) { const int st = b / 1024, sb = b % 1024, swz = sb ^ (((sb >> 9) & 1) << 5); R = (st >> 1) * 16 + swz / 64; C = (st & 1) * 32 + (swz % 64) / 2; }
__host__ __device__ __forceinline__ int perm32(int rho) { const int n = rho >> 4, i = rho & 15; return 8 * (i >> 2) + 4 * n + (i & 3); }

struct Unit { int pm, pn; const char* a; const char* b; };
struct Gemm { int lda, ldb, K; };

template <bool MOE> struct Order {
    int nM, nN, nwg, G, c;
    const char* A; const char* B; size_t a_pm, a_pn, b_pn, b_e; const int* blk_expert;
    __device__ void init(int nM_, int nN_, int G_, int c_) { nM = nM_; nN = nN_; nwg = nM * nN; G = G_; c = c_; }
    __device__ __forceinline__ bool next(int i, Unit& u) const {
        const long L = (long)i * G + c; if (L >= nwg) return false;
        int wgid = (int)L; { const int q = nwg / NXCD, r = nwg % NXCD, xcd = wgid % NXCD, off = wgid / NXCD; wgid = (xcd < r ? xcd * (q + 1) : r * (q + 1) + (xcd - r) * q) + off; }
        const int nig = WGM * nN, gid = wgid / nig, fm = gid * WGM, gsz = (nM - fm) < WGM ? (nM - fm) : WGM;
        u.pm = fm + ((wgid % nig) % gsz); u.pn = (wgid % nig) / gsz;
        u.a = A + (size_t)u.pm * a_pm + (size_t)u.pn * a_pn;
        u.b = B + (size_t)u.pn * b_pn;
        if (MOE) { const int e = __builtin_amdgcn_readfirstlane(__hip_atomic_load(blk_expert + u.pm, __ATOMIC_RELAXED, __HIP_MEMORY_SCOPE_AGENT)); u.b += (size_t)e * b_e; }
        return true;
    }
    __device__ __forceinline__ void a_ready(const Unit&) const {}
    __device__ __forceinline__ void done(const Unit&) const {}
};

__device__ __forceinline__ unsigned cvt_pk_bf16(float lo, float hi) { unsigned r; asm volatile("v_cvt_pk_bf16_f32 %0, %1, %2" : "=v"(r) : "v"(lo), "v"(hi)); return r; }
__device__ __forceinline__ float silu_f(float x) { return x * __builtin_amdgcn_rcpf(1.0f + __builtin_amdgcn_exp2f(-1.4426950408889634f * x)); }

struct EpiBf16 {
    static constexpr bool PERM = true, AFTER_DRAIN = false;
    bf16_t* O; int ldc; const float* scale;
    __device__ __forceinline__ void operator()(const f32x4 (&acc)[2][2][4][2], const Unit& u, int wr, int wc, int fr, int fq) const {
        const int row0 = u.pm * BM + wr * 64 + fr, col0 = u.pn * BM + wc * 32 + 8 * fq;
        f32x4 sv[2][2];
#pragma unroll
        for (int bj = 0; bj < 2; ++bj)
#pragma unroll
            for (int n = 0; n < 2; ++n) sv[bj][n] = scale ? *(const f32x4*)(scale + col0 + bj * HALF + 4 * n) : (f32x4){1.f, 1.f, 1.f, 1.f};
#pragma unroll
        for (int ai = 0; ai < 2; ++ai)
#pragma unroll
            for (int m = 0; m < 4; ++m) { bf16_t* rowp = O + (size_t)(row0 + ai * HALF + m * 16) * ldc + col0;
#pragma unroll
                for (int bj = 0; bj < 2; ++bj) { const f32x4 v0 = acc[ai][bj][m][0] * sv[bj][0], v1 = acc[ai][bj][m][1] * sv[bj][1];
                    u32x4 w; w.x = cvt_pk_bf16(v0[0], v0[1]); w.y = cvt_pk_bf16(v0[2], v0[3]); w.z = cvt_pk_bf16(v1[0], v1[1]); w.w = cvt_pk_bf16(v1[2], v1[3]);
                    *(u32x4*)(rowp + bj * HALF) = w; } }
    }
};
struct EpiRes {
    static constexpr bool PERM = false, AFTER_DRAIN = false;
    const float* base; float* out; int ldc;
    __device__ __forceinline__ void operator()(const f32x4 (&acc)[2][2][4][2], const Unit& u, int wr, int wc, int fr, int fq) const {
        const int row0 = u.pm * BM + wr * 64 + fr, col0 = u.pn * BM + wc * 32 + 4 * fq;
#pragma unroll
        for (int ai = 0; ai < 2; ++ai)
#pragma unroll
            for (int m = 0; m < 4; ++m) { const size_t off = (size_t)(row0 + ai * HALF + m * 16) * ldc + col0;
                f32x4 bs[2][2];
#pragma unroll
                for (int bj = 0; bj < 2; ++bj)
#pragma unroll
                    for (int n = 0; n < 2; ++n) bs[bj][n] = *(const f32x4*)(base + off + bj * HALF + n * 16);
#pragma unroll
                for (int bj = 0; bj < 2; ++bj)
#pragma unroll
                    for (int n = 0; n < 2; ++n) *(f32x4*)(out + off + bj * HALF + n * 16) = bs[bj][n] + acc[ai][bj][m][n];
                asm volatile("" ::: "memory"); }
    }
};
struct EpiSwiglu {
    static constexpr bool PERM = true, AFTER_DRAIN = false;
    bf16_t* O; int ldc;
    __device__ __forceinline__ void operator()(const f32x4 (&acc)[2][2][4][2], const Unit& u, int wr, int wc, int fr, int fq) const {
        const int row0 = u.pm * BM + wr * 64 + fr, col0 = u.pn * HALF + wc * 32 + 8 * fq;
#pragma unroll
        for (int ai = 0; ai < 2; ++ai)
#pragma unroll
            for (int m = 0; m < 4; ++m) { bf16_t* rowp = O + (size_t)(row0 + ai * HALF + m * 16) * ldc + col0;
                const f32x4 g0 = acc[ai][0][m][0], g1 = acc[ai][0][m][1], u0 = acc[ai][1][m][0], u1 = acc[ai][1][m][1];
                u32x4 w; w.x = cvt_pk_bf16(silu_f(g0[0]) * u0[0], silu_f(g0[1]) * u0[1]); w.y = cvt_pk_bf16(silu_f(g0[2]) * u0[2], silu_f(g0[3]) * u0[3]);
                w.z = cvt_pk_bf16(silu_f(g1[0]) * u1[0], silu_f(g1[1]) * u1[1]); w.w = cvt_pk_bf16(silu_f(g1[2]) * u1[2], silu_f(g1[3]) * u1[3]);
                *(u32x4*)rowp = w; }
    }
};

template <class Epi, class Sched, bool ALIGN_EPI = false, bool SP2 = false>
__device__ __forceinline__ void gemm_phase(PG8_LAS unsigned char* lds, const Gemm g, const Sched& S, const Epi& E) {
    const int tid = threadIdx.x, wid = __builtin_amdgcn_readfirstlane(tid >> 6), lane = tid & 63, wr = wid >> 2, wc = wid & 3, fr = lane & 15, fq = lane >> 4;
    const int K = g.K, nt = K / BK;
    unsigned voffA[2], voffB[2];
#pragma unroll
    for (int i = 0; i < 2; ++i) { int R, C; stage_rc(tid * 16 + i * 8192, R, C); const int Rb = Epi::PERM ? ((R & ~31) + perm32(R & 31)) : R;
        voffA[i] = (unsigned)(R * g.lda + C) * 2u; voffB[i] = (unsigned)(Rb * g.ldb + C) * 2u; }
    const size_t kstep = (size_t)(BK * 2);
    const size_t hstepA = (size_t)HALF * g.lda * 2, hstepB = (size_t)HALF * g.ldb * 2;
    const unsigned ldsw = (unsigned)wid * 1024u;
    const int aoff = lds_byte(wr * 64 + fr, fq * 8), boff = lds_byte(wc * 32 + fr, fq * 8);
#define PG8_SA(b, h) (((b) * 2 + (h)) * HTB)
#define PG8_SB(b, h) ((4 + (b) * 2 + (h)) * HTB)
#define PG8_STAGE(bufoff, gbase, voff) do { _Pragma("unroll") for (int _i = 0; _i < 2; ++_i) \
        __builtin_amdgcn_global_load_lds((const unsigned*)((const char*)(gbase) + (voff)[_i]), (PG8_LAS unsigned*)(lds + (bufoff) + ldsw + _i * 8192), 16, 0, 0); } while (0)
#define PG8_LDA(dst, b, h) do { _Pragma("unroll") for (int m = 0; m < 4; ++m) _Pragma("unroll") for (int k = 0; k < 2; ++k) dst[m][k] = *(const PG8_LAS bf16x8*)(lds + PG8_SA(b, h) + aoff + m * 2048 + k * 1024); } while (0)
#define PG8_LDB(dst, b, h) do { _Pragma("unroll") for (int n = 0; n < 2; ++n) _Pragma("unroll") for (int k = 0; k < 2; ++k) dst[n][k] = *(const PG8_LAS bf16x8*)(lds + PG8_SB(b, h) + boff + n * 2048 + k * 1024); } while (0)
#define PG8_MMA(ai, bj, At, Bt) do { __builtin_amdgcn_s_setprio(1); _Pragma("unroll") for (int m = 0; m < 4; ++m) _Pragma("unroll") for (int n = 0; n < 2; ++n) _Pragma("unroll") for (int k = 0; k < 2; ++k) \
        acc[ai][bj][m][n] = __builtin_amdgcn_mfma_f32_16x16x32_bf16(Bt[n][k], At[m][k], acc[ai][bj][m][n], 0, 0, 0); __builtin_amdgcn_s_setprio(0); } while (0)
#define PG8_WAIT_V(n) asm volatile("s_waitcnt vmcnt(" #n ")" ::: "memory")
#define PG8_WAIT_L(n) asm volatile("s_waitcnt lgkmcnt(" #n ")" ::: "memory")
#define PG8_BAR __builtin_amdgcn_s_barrier()
#define PG8_SCHED __builtin_amdgcn_sched_barrier(0)
    Unit cur, nxt; int ui = 0;
    if (!S.next(0, cur)) return;
    f32x4 acc[2][2][4][2];
#pragma unroll
    for (int a = 0; a < 2; ++a)
#pragma unroll
        for (int b = 0; b < 2; ++b)
#pragma unroll
            for (int m = 0; m < 4; ++m)
#pragma unroll
                for (int n = 0; n < 2; ++n) acc[a][b][m][n] = (f32x4){0.f, 0.f, 0.f, 0.f};
    bf16x8 At[4][2], B0[2][2], B1[2][2];
    const char* cA = cur.a; const char* cB = cur.b;
    S.a_ready(cur);
    if constexpr (SP2) {
        PG8_STAGE(PG8_SB(0, 0), cB, voffB); PG8_STAGE(PG8_SB(0, 1), cB + hstepB, voffB); PG8_STAGE(PG8_SA(0, 0), cA, voffA); PG8_STAGE(PG8_SA(0, 1), cA + hstepA, voffA);
        if (wr == 1) PG8_BAR;
        PG8_WAIT_V(2); PG8_BAR;
        PG8_STAGE(PG8_SB(1, 0), cB + kstep, voffB); PG8_STAGE(PG8_SA(1, 0), cA + kstep, voffA); PG8_STAGE(PG8_SB(1, 1), cB + hstepB + kstep, voffB);
        PG8_WAIT_V(6); PG8_BAR;
    } else {
        PG8_STAGE(PG8_SB(0, 0), cB, voffB); PG8_STAGE(PG8_SA(0, 0), cA, voffA); PG8_STAGE(PG8_SB(0, 1), cB + hstepB, voffB); PG8_STAGE(PG8_SA(0, 1), cA + hstepA, voffA);
        if (wr == 1) PG8_BAR;
        PG8_WAIT_V(4); PG8_BAR;
        PG8_STAGE(PG8_SB(1, 0), cB + kstep, voffB); PG8_STAGE(PG8_SA(1, 0), cA + kstep, voffA); PG8_STAGE(PG8_SB(1, 1), cB + hstepB + kstep, voffB);
        PG8_WAIT_V(6); PG8_BAR;
    }
    for (;;) {
        const bool has_next = S.next(ui + 1, nxt);
        const char* nA = has_next ? nxt.a : cA; const char* nB = has_next ? nxt.b : cB;
        for (int t = 0; t < nt; t += 2) {
            const bool last = (t == nt - 2);
            const char* a1 = cA + (size_t)(t + 1) * kstep;
            const char* a2 = last ? nA : cA + (size_t)(t + 2) * kstep; const char* b2 = last ? nB : cB + (size_t)(t + 2) * kstep;
            const char* a3 = a2 + kstep; const char* b3 = b2 + kstep;
            if (last && has_next) S.a_ready(nxt);
            if constexpr (SP2) {
            PG8_LDB(B0, 0, 0); PG8_LDB(B1, 0, 1); PG8_SCHED; PG8_LDA(At, 0, 0); PG8_STAGE(PG8_SA(1, 1), a1 + hstepA, voffA);
            PG8_WAIT_V(8); PG8_WAIT_L(0); PG8_BAR; PG8_MMA(0, 0, At, B0); PG8_MMA(0, 1, At, B1); PG8_BAR; PG8_SCHED;
            PG8_LDA(At, 0, 1); PG8_STAGE(PG8_SB(0, 0), b2, voffB); PG8_STAGE(PG8_SB(0, 1), b2 + hstepB, voffB); PG8_STAGE(PG8_SA(0, 0), a2, voffA);
            PG8_WAIT_V(8); PG8_WAIT_L(0); PG8_BAR; PG8_MMA(1, 0, At, B0); PG8_MMA(1, 1, At, B1); PG8_BAR; PG8_SCHED;
            PG8_LDB(B0, 1, 0); PG8_LDB(B1, 1, 1); PG8_SCHED; PG8_LDA(At, 1, 0); PG8_STAGE(PG8_SA(0, 1), a2 + hstepA, voffA);
            PG8_WAIT_V(8); PG8_WAIT_L(0); PG8_BAR; PG8_MMA(0, 0, At, B0); PG8_MMA(0, 1, At, B1); PG8_BAR; PG8_SCHED;
            PG8_LDA(At, 1, 1); PG8_STAGE(PG8_SB(1, 0), b3, voffB); PG8_STAGE(PG8_SB(1, 1), b3 + hstepB, voffB); PG8_STAGE(PG8_SA(1, 0), a3, voffA);
            PG8_WAIT_V(8); PG8_WAIT_L(0); PG8_BAR; PG8_MMA(1, 0, At, B0); PG8_MMA(1, 1, At, B1); PG8_BAR; PG8_SCHED;
            } else {
            PG8_LDB(B0, 0, 0); PG8_SCHED; PG8_LDA(At, 0, 0); PG8_STAGE(PG8_SA(1, 1), a1 + hstepA, voffA);
            PG8_WAIT_L(8); PG8_BAR; PG8_WAIT_L(0); PG8_MMA(0, 0, At, B0); PG8_BAR; PG8_SCHED;
            PG8_LDB(B1, 0, 1); PG8_STAGE(PG8_SB(0, 0), b2, voffB);
            PG8_BAR; PG8_WAIT_L(0); PG8_MMA(0, 1, At, B1); PG8_BAR;
            PG8_LDA(At, 0, 1); PG8_STAGE(PG8_SA(0, 0), a2, voffA);
            PG8_BAR; PG8_WAIT_L(0); PG8_MMA(1, 0, At, B0); PG8_BAR; PG8_SCHED;
            PG8_STAGE(PG8_SB(0, 1), b2 + hstepB, voffB);
            PG8_WAIT_V(6); PG8_BAR; PG8_MMA(1, 1, At, B1); PG8_BAR;
            PG8_LDB(B0, 1, 0); PG8_SCHED; PG8_LDA(At, 1, 0); PG8_STAGE(PG8_SA(0, 1), a2 + hstepA, voffA);
            PG8_WAIT_L(8); PG8_BAR; PG8_WAIT_L(0); PG8_MMA(0, 0, At, B0); PG8_BAR; PG8_SCHED;
            PG8_LDB(B1, 1, 1); PG8_STAGE(PG8_SB(1, 0), b3, voffB);
            PG8_BAR; PG8_WAIT_L(0); PG8_MMA(0, 1, At, B1); PG8_BAR;
            PG8_LDA(At, 1, 1); PG8_STAGE(PG8_SA(1, 0), a3, voffA);
            PG8_BAR; PG8_WAIT_L(0); PG8_MMA(1, 0, At, B0); PG8_BAR; PG8_SCHED;
            PG8_STAGE(PG8_SB(1, 1), b3 + hstepB, voffB);
            PG8_WAIT_V(6); PG8_BAR; PG8_MMA(1, 1, At, B1); PG8_BAR;
            }
        }
        if constexpr (ALIGN_EPI) { if (wr == 0) PG8_BAR; }
        if constexpr (!Epi::AFTER_DRAIN) { E(acc, cur, wr, wc, fr, fq); S.done(cur); }
        if (!has_next) break;
#pragma unroll
        for (int a = 0; a < 2; ++a)
#pragma unroll
            for (int b = 0; b < 2; ++b)
#pragma unroll
                for (int m = 0; m < 4; ++m)
#pragma unroll
                    for (int n = 0; n < 2; ++n) acc[a][b][m][n] = (f32x4){0.f, 0.f, 0.f, 0.f};
        cur = nxt; cA = nA; cB = nB; ++ui;
        if constexpr (ALIGN_EPI) { if (wr == 1) PG8_BAR; }
    }
    PG8_WAIT_V(0);
    if constexpr (!ALIGN_EPI) { if (wr == 0) PG8_BAR; }
    PG8_BAR;
    if constexpr (Epi::AFTER_DRAIN) { E.fused(acc, cur, wr, wc, fr, fq, lds, wid, lane); S.done(cur); }
#undef PG8_SA
#undef PG8_SB
#undef PG8_STAGE
#undef PG8_LDA
#undef PG8_LDB
#undef PG8_MMA
#undef PG8_WAIT_V
#undef PG8_WAIT_L
#undef PG8_BAR
#undef PG8_SCHED
}}
namespace fz {
#define LAS __attribute__((address_space(3)))
typedef unsigned short bf16_t;
typedef short bf16x8 __attribute__((ext_vector_type(8)));
typedef float f32x4 __attribute__((ext_vector_type(4)));
typedef float f32x2 __attribute__((ext_vector_type(2)));
typedef unsigned u32x4 __attribute__((ext_vector_type(4)));
typedef unsigned u32x2 __attribute__((ext_vector_type(2)));
constexpr int NTHR = 512;
constexpr int LDS_BYTES = 163840, MISC_OFF = LDS_BYTES - 256;

constexpr size_t MiB = 1u << 20;
constexpr size_t WS_CTL = 0, CTL_ZERO_BYTES = 1 * MiB;
constexpr size_t WS_WIN = 1 * MiB;
constexpr size_t WS_WPOOL = WS_WIN + 32 * MiB;
constexpr size_t WS_WOUT = WS_WPOOL + 1 * MiB;
constexpr size_t WS_WGU = WS_WOUT + 16 * MiB;
constexpr size_t WS_WD = WS_WGU + 44 * MiB;
constexpr size_t WS_EWGU = WS_WD + 22 * MiB;
constexpr size_t WS_EWD = WS_EWGU + 448 * MiB;
constexpr size_t WS_XS = WS_EWD + 224 * MiB;
constexpr size_t WS_H = WS_XS + 128 * MiB;
constexpr size_t WS_GLR = WS_H + 65 * MiB;
constexpr size_t WS_ROUTE = WS_GLR + 1 * MiB;
constexpr size_t WS_U = WS_ROUTE + 2 * MiB;
constexpr size_t WS_Z = WS_U;
constexpr size_t WS_DP = WS_Z + 128 * MiB;
constexpr size_t WS_MIX = WS_DP + 32 * MiB;
constexpr size_t WS_CS = WS_MIX + 64 * MiB;
constexpr size_t WS_SP = WS_CS + 128 * MiB;
constexpr size_t WS_DEC = WS_SP + 64 * MiB;
constexpr size_t WS_ACT = WS_U;
constexpr size_t WS_HS = WS_U;
constexpr size_t WS_ACT2 = WS_HS + 136 * MiB;
constexpr size_t WS_Y = WS_ACT2 + 476 * MiB;
constexpr size_t WS_END = WS_Y + 136 * MiB;
static_assert(WS_END <= 1792 * MiB, "workspace map");
static_assert(WS_DEC + 1 * MiB <= WS_END, "mixer view inside U");
constexpr size_t RT_TOPI = 0, RT_TOPW = 128 * 1024, RT_TOKSLOT = 256 * 1024, RT_HIST = 384 * 1024, RT_BLKE = 400 * 1024, RT_NRB = 404 * 1024;

constexpr int CW_BAR = 4096;

constexpr int PH_PRO = 0, PH_PER_LAYER = 10, NPH = 1 + 2 * PH_PER_LAYER;
constexpr int PK_INPROJ = 0, PK_PRE = 1, PK_POOLSCAN = 2, PK_GLAOUT = 3, PK_OUTPROJ = 4, PK_NORM2 = 5, PK_ASSIGN = 6, PK_UP = 7, PK_DOWN = 8, PK_TAIL = 9;

#define VM_WAIT() asm volatile("s_waitcnt vmcnt(0)" ::: "memory")
#define LDS_WAIT() asm volatile("s_waitcnt lgkmcnt(0)" ::: "memory")
#define RLX_AGENT __ATOMIC_RELAXED, __HIP_MEMORY_SCOPE_AGENT

__device__ __forceinline__ unsigned pk_bf16(float lo, float hi) { unsigned r; asm volatile("v_cvt_pk_bf16_f32 %0, %1, %2" : "=v"(r) : "v"(lo), "v"(hi)); return r; }
__device__ __forceinline__ float bf_lo(unsigned w) { return __uint_as_float(w << 16); }
__device__ __forceinline__ float bf_hi(unsigned w) { return __uint_as_float(w & 0xffff0000u); }
__device__ __forceinline__ float bf2f(bf16_t b) { return __uint_as_float(((unsigned)b) << 16); }
__device__ __forceinline__ bf16_t f2bf(float f) { return (bf16_t)(pk_bf16(f, 0.f) & 0xffffu); }
__device__ __forceinline__ float wave_sum(float v) {
#pragma unroll
    for (int o = 1; o < 64; o <<= 1) v += __shfl_xor(v, o);
    return v;
}
__device__ __forceinline__ float silu_f(float x) { return x * __builtin_amdgcn_rcpf(1.0f + __builtin_amdgcn_exp2f(-1.4426950408889634f * x)); }
__device__ __forceinline__ bf16x8 mk8(u32x2 lo, u32x2 hi) { u32x4 t; t.x = lo.x; t.y = lo.y; t.z = hi.x; t.w = hi.y; return __builtin_bit_cast(bf16x8, t); }
__device__ __forceinline__ bf16x8 tr_frag(unsigned a0, unsigned a1) {
    u32x2 lo, hi;
    asm volatile("ds_read_b64_tr_b16 %0, %2\n\tds_read_b64_tr_b16 %1, %3\n\ts_waitcnt lgkmcnt(0)" : "=&v"(lo), "=&v"(hi) : "v"(a0), "v"(a1) : "memory");
    return mk8(lo, hi);
}
__device__ __forceinline__ f32x4 mma16(bf16x8 a, bf16x8 b, f32x4 c) { return __builtin_amdgcn_mfma_f32_16x16x32_bf16(a, b, c, 0, 0, 0); }

#define XB_TMO      128
#define XB_XCNT(j)  (256  + 64 * (j))
#define XB_XSUB(j)  (1280 + 64 * (j))
#define XB_XGEN(j)  (2304 + 64 * (j))
#define XB_TOP      3328
#define XB_TOPGEN   3392
#define XCD_BAR_WORDS 3456
#define XB_SPIN_CAP (1u << 18)
__device__ __forceinline__ unsigned xb_ld(unsigned* p)              { return __hip_atomic_load(p, __ATOMIC_RELAXED, __HIP_MEMORY_SCOPE_AGENT); }
__device__ __forceinline__ unsigned xb_add(unsigned* p, unsigned v) { return __hip_atomic_fetch_add(p, v, __ATOMIC_RELAXED, __HIP_MEMORY_SCOPE_AGENT); }
__device__ __forceinline__ unsigned xb_xcc_id() { return (unsigned)__builtin_amdgcn_s_getreg((3 << 11) | 20) & 0xFu; }
#define XB_SPIN(cond, bar) do { unsigned _sp = 0; while (cond) { __builtin_amdgcn_s_sleep(1); \
    if ((++_sp & 255u) == 0u) { if (xb_ld(&(bar)[XB_TMO])) break; if (_sp > XB_SPIN_CAP) { atomicAdd(&(bar)[XB_TMO], 1u); break; } } } } while (0)
struct XcdBarrier { unsigned* bar; unsigned x; volatile LAS unsigned* st; };
__device__ __forceinline__ XcdBarrier xcd_barrier_post(unsigned* bar, volatile LAS unsigned* st) {
    XcdBarrier b; b.bar = bar; b.x = xb_xcc_id(); b.st = st;
    if (threadIdx.x == 0) (void)xb_add(&bar[XB_XCNT(b.x)], 1u);
    return b;
}
__device__ __forceinline__ void xcd_barrier_complete(unsigned* bar, unsigned x, unsigned& nloc, unsigned& nx) {
    const unsigned G = gridDim.x * gridDim.y * gridDim.z;
    unsigned sum, cnt, mine, sp = 0u;
    for (;;) {
        sum = 0u; cnt = 0u; mine = 0u;
#pragma unroll
        for (unsigned j = 0; j < 16; ++j) { const unsigned c = xb_ld(&bar[XB_XCNT(j)]); sum += c; cnt += (c > 0u) ? 1u : 0u; mine = (j == x) ? c : mine; }
        if (sum == G) break;
        __builtin_amdgcn_s_sleep(1);
        if ((++sp & 255u) == 0u) { if (xb_ld(&bar[XB_TMO])) break; if (sp > XB_SPIN_CAP) { atomicAdd(&bar[XB_TMO], 1u); break; } }
    }
    nloc = mine > 0u ? mine : 1u; nx = cnt > 0u ? cnt : 1u;
}
__device__ __forceinline__ void xcd_barrier(const XcdBarrier& b) {
    asm volatile("s_waitcnt vmcnt(0)" ::: "memory");
    __syncthreads();
    if (threadIdx.x == 0) {
        unsigned* bar = b.bar;
        __builtin_amdgcn_s_waitcnt(0);
        unsigned nloc = b.st[0], nx = b.st[1];
        if (nloc == 0u) { xcd_barrier_complete(bar, b.x, nloc, nx); b.st[0] = nloc; b.st[1] = nx; }
        const unsigned old = xb_add(&bar[XB_XSUB(b.x)], 1u);
        const unsigned gen = old / nloc;
        if (old + 1u == (gen + 1u) * nloc) {
            __builtin_amdgcn_fence(__ATOMIC_RELEASE, "agent");
            asm volatile("s_waitcnt vmcnt(0)" ::: "memory");
            const unsigned og = xb_add(&bar[XB_TOP], 1u);
            const unsigned tg = og / nx;
            if (og + 1u == (tg + 1u) * nx) xb_add(&bar[XB_TOPGEN], 1u);
            else XB_SPIN(xb_ld(&bar[XB_TOPGEN]) == tg, bar);
            __builtin_amdgcn_fence(__ATOMIC_ACQUIRE, "agent");
            xb_add(&bar[XB_XGEN(b.x)], 1u);
            asm volatile("s_waitcnt vmcnt(0)" ::: "memory");
        } else {
            XB_SPIN(xb_ld(&bar[XB_XGEN(b.x)]) == gen, bar);
            __builtin_amdgcn_fence(__ATOMIC_ACQUIRE, "agent");
            asm volatile("s_waitcnt vmcnt(0)" ::: "memory");
        }
    }
    __syncthreads();
}

struct CvtJob { const float* src; int ld_src; int k0; int n0; bf16_t* dst; int ld_dst; int row0; };
__device__ __forceinline__ void cvt_item(const CvtJob j, LAS float* scr, int lane) {
    const int kr = lane >> 4, nq = lane & 15;
    f32x4 v[16];
#pragma unroll
    for (int i = 0; i < 16; ++i) v[i] = *(const f32x4*)(j.src + (size_t)(j.k0 + 4 * i + kr) * j.ld_src + j.n0 + 4 * nq);
#pragma unroll
    for (int i = 0; i < 16; ++i) *(LAS f32x4*)(scr + (4 * i + kr) * 68 + 4 * nq) = v[i];
    LDS_WAIT(); asm volatile("" ::: "memory");
    const int nn = lane & 31, kcl = lane >> 5;
#pragma unroll
    for (int jn = 0; jn < 2; ++jn)
#pragma unroll
        for (int kq = 0; kq < 4; ++kq) {
            const int n = nn + 32 * jn, kc = 2 * kq + kcl;
            const LAS float* s = scr + (8 * kc) * 68 + n;
            u32x4 o; o.x = pk_bf16(s[0 * 68], s[1 * 68]); o.y = pk_bf16(s[2 * 68], s[3 * 68]); o.z = pk_bf16(s[4 * 68], s[5 * 68]); o.w = pk_bf16(s[6 * 68], s[7 * 68]);
            *(u32x4*)(j.dst + (size_t)(j.row0 + n) * j.ld_dst + j.k0 + 8 * kc) = o;
        }
    LDS_WAIT(); asm volatile("" ::: "memory");
}
struct CvtPtrs { const float *w_in, *w_pool, *w_out, *dwg, *dwu, *dwd, *ewg, *ewu, *ewd; unsigned char* ws; };
constexpr int CI_WIN = 32 * 64, CI_WPOOL = 16, CI_WOUT = 32 * 32, CI_DGU = 32 * 88, CI_DD = 88 * 32, CI_EGU = 32 * 112, CI_ED = 112 * 32;
constexpr int CI_NONEXP = 2 * CI_WIN + 8 * CI_WPOOL + 2 * CI_WOUT + 2 * CI_DGU + CI_DD;
constexpr int CI_TOTAL = CI_NONEXP + 8 * (2 * CI_EGU + CI_ED);
__device__ __forceinline__ CvtJob cvt_decode(const CvtPtrs& P, int r) {
    CvtJob j;
    if (r < 2 * CI_WIN) { const int l = r / CI_WIN, q = r % CI_WIN, kb = q / 64, ng = q % 64; const int c0 = 64 * ng;
        j.src = P.w_in + (size_t)l * DM * ZW; j.ld_src = ZW; j.k0 = 64 * kb; j.n0 = c0 < 3072 ? c0 : c0 + 16;
        j.dst = (bf16_t*)(P.ws + WS_WIN) + (size_t)l * 4096 * 2048; j.ld_dst = 2048; j.row0 = c0; return j; }
    r -= 2 * CI_WIN;
    if (r < 8 * CI_WPOOL) { const int m = r / CI_WPOOL, q = r % CI_WPOOL, kb = q / 4, ng = q % 4;
        j.src = P.w_pool + (size_t)m * 65536; j.ld_src = 256; j.k0 = 64 * kb; j.n0 = 64 * ng;
        j.dst = (bf16_t*)(P.ws + WS_WPOOL) + (size_t)m * 65536; j.ld_dst = 256; j.row0 = 64 * ng; return j; }
    r -= 8 * CI_WPOOL;
    if (r < 2 * CI_WOUT) { const int l = r / CI_WOUT, q = r % CI_WOUT, kb = q / 32, ng = q % 32;
        j.src = P.w_out + (size_t)l * 2048 * 2048; j.ld_src = 2048; j.k0 = 64 * kb; j.n0 = 64 * ng;
        j.dst = (bf16_t*)(P.ws + WS_WOUT) + (size_t)l * 2048 * 2048; j.ld_dst = 2048; j.row0 = 64 * ng; return j; }
    r -= 2 * CI_WOUT;
    if (r < 2 * CI_DGU) { const int up = r / CI_DGU, q = r % CI_DGU, kb = q / 88, ng = q % 88; const int c0 = 64 * ng;
        j.src = up ? P.dwu : P.dwg; j.ld_src = 5632; j.k0 = 64 * kb; j.n0 = c0;
        j.dst = (bf16_t*)(P.ws + WS_WGU); j.ld_dst = 2048; j.row0 = 256 * (c0 >> 7) + (c0 & 127) + 128 * up; return j; }
    r -= 2 * CI_DGU;
    if (r < CI_DD) { const int kb = r / 32, ng = r % 32;
        j.src = P.dwd; j.ld_src = 2048; j.k0 = 64 * kb; j.n0 = 64 * ng;
        j.dst = (bf16_t*)(P.ws + WS_WD); j.ld_dst = 5632; j.row0 = 64 * ng; return j; }
    r -= CI_DD;
    { const int e = r / (2 * CI_EGU + CI_ED); int q = r % (2 * CI_EGU + CI_ED);
        if (q < 2 * CI_EGU) { const int up = q / CI_EGU; q %= CI_EGU; const int kb = q / 112, ng = q % 112, c0 = 64 * ng;
            j.src = (up ? P.ewu : P.ewg) + (size_t)e * 2048 * 7168; j.ld_src = 7168; j.k0 = 64 * kb; j.n0 = c0;
            j.dst = (bf16_t*)(P.ws + WS_EWGU) + (size_t)e * 14336 * 2048; j.ld_dst = 2048; j.row0 = 256 * (c0 >> 7) + (c0 & 127) + 128 * up; return j; }
        q -= 2 * CI_EGU; { const int kb = q / 32, ng = q % 32;
            j.src = P.ewd + (size_t)e * 7168 * 2048; j.ld_src = 2048; j.k0 = 64 * kb; j.n0 = 64 * ng;
            j.dst = (bf16_t*)(P.ws + WS_EWD) + (size_t)e * 2048 * 7168; j.ld_dst = 7168; j.row0 = 64 * ng; return j; } }
}

template <int MODE>
__device__ __forceinline__ void norm_phase(LAS unsigned char* lds, const float* xin, const float* gain, bf16_t* H, const float* Wp, int ldw,
                                           float* glr, int* topi, float* topw, int* hist, int tid, int lane, int wave, int G) {
    constexpr int NP = MODE == 0 ? 16 : (MODE == 2 ? 8 : 0);
    LAS float* Wl = (LAS float*)lds;
    LAS int* cnt = (LAS int*)(lds + 135168);
    if (NP > 0) {
#pragma unroll
        for (int i = 0; i < 4; ++i) { const int k = tid + 512 * i;
#pragma unroll
            for (int p4 = 0; p4 < NP / 4; ++p4) { const f32x4 w = *(const f32x4*)(Wp + (size_t)k * ldw + 4 * p4);
                Wl[(4 * p4 + 0) * 2048 + k] = w.x; Wl[(4 * p4 + 1) * 2048 + k] = w.y; Wl[(4 * p4 + 2) * 2048 + k] = w.z; Wl[(4 * p4 + 3) * 2048 + k] = w.w; } }
    }
    f32x4 gv[8];
#pragma unroll
    for (int j = 0; j < 8; ++j) gv[j] = *(const f32x4*)(gain + 4 * lane + 256 * j);
#pragma unroll 1
    for (int rb = blockIdx.x; rb < T / 64; rb += G) {
        if (MODE == 2) { if (tid < 8) cnt[tid] = 0; }
        __syncthreads();
#pragma unroll 1
        for (int r = 0; r < 8; ++r) {
            const int row = 64 * rb + 8 * wave + r;
            const f32x4* xr = (const f32x4*)(xin + (size_t)row * DM) + lane;
            f32x4 v[8]; float ss = 0.f;
#pragma unroll
            for (int j = 0; j < 8; ++j) { v[j] = xr[64 * j]; ss += (v[j].x * v[j].x + v[j].y * v[j].y) + (v[j].z * v[j].z + v[j].w * v[j].w); }
            const float rstd = rsqrtf(wave_sum(ss) * (1.0f / DM) + EPSF);
            u32x2* ho = (u32x2*)(H + (size_t)row * DM) + lane;
#pragma unroll
            for (int j = 0; j < 8; ++j) { v[j] = v[j] * rstd * gv[j]; u32x2 o; o.x = pk_bf16(v[j].x, v[j].y); o.y = pk_bf16(v[j].z, v[j].w); ho[64 * j] = o; }
            if (NP > 0) {
                float pr[NP > 0 ? NP : 1];
#pragma unroll
                for (int p = 0; p < NP; ++p) { float s = 0.f;
#pragma unroll
                    for (int j = 0; j < 8; ++j) { const f32x4 w = *(const LAS f32x4*)(Wl + p * 2048 + 4 * lane + 256 * j); s += (v[j].x * w.x + v[j].y * w.y) + (v[j].z * w.z + v[j].w * w.w); }
                    pr[p] = wave_sum(s); }
                if (MODE == 0) { float o = 0.f;
#pragma unroll
                    for (int p = 0; p < NP; ++p) o = (lane == p) ? pr[p] : o;
                    if (lane < 16) glr[(size_t)row * 16 + lane] = o; }
                if (MODE == 2) {
                    int i0 = 0; float v0 = pr[0];
#pragma unroll
                    for (int e = 1; e < NP; ++e) if (pr[e] > v0) { v0 = pr[e]; i0 = e; }
                    int i1 = 0; float v1 = -3.4e38f;
#pragma unroll
                    for (int e = 0; e < NP; ++e) if (e != i0 && pr[e] > v1) { v1 = pr[e]; i1 = e; }
                    if (lane == 0) { const float e1 = __expf(v1 - v0), inv = 1.0f / (1.0f + e1);
                        topi[2 * row] = i0; topi[2 * row + 1] = i1; topw[2 * row] = inv; topw[2 * row + 1] = e1 * inv;
                        atomicAdd((int*)(cnt + i0), 1); atomicAdd((int*)(cnt + i1), 1); }
                }
            }
        }
        if (MODE == 2) { __syncthreads(); if (tid < 8) hist[rb * 8 + tid] = cnt[tid]; }
    }
}
__device__ __forceinline__ void pool_d_phase(const bf16_t* Z, bf16_t* DP, int tid, int G) {
#pragma unroll 1
    for (int item = blockIdx.x * NTHR + tid; item < T * 128; item += G * NTHR) {
        const int t = item >> 7, c = (item & 127) * 8;
        const int w = 2 << (c >> 8);
        const int lo = (t + 1 - w) > 0 ? (t + 1 - w) : 0;
        float s[8];
#pragma unroll
        for (int e = 0; e < 8; ++e) s[e] = 0.f;
        u32x4 q = (u32x4){0u, 0u, 0u, 0u};
#pragma unroll 1
        for (int j = lo; j <= t; ++j) { q = *(const u32x4*)(Z + (size_t)j * 4096 + c);
            s[0] += bf_lo(q.x); s[1] += bf_hi(q.x); s[2] += bf_lo(q.y); s[3] += bf_hi(q.y); s[4] += bf_lo(q.z); s[5] += bf_hi(q.z); s[6] += bf_lo(q.w); s[7] += bf_hi(q.w); }
        const float inv = 1.0f / (float)(t + 1 - lo);
        u32x4 o;
        o.x = pk_bf16(s[0] * inv - bf_lo(q.x), s[1] * inv - bf_hi(q.x)); o.y = pk_bf16(s[2] * inv - bf_lo(q.y), s[3] * inv - bf_hi(q.y));
        o.z = pk_bf16(s[4] * inv - bf_lo(q.z), s[5] * inv - bf_hi(q.z)); o.w = pk_bf16(s[6] * inv - bf_lo(q.w), s[7] * inv - bf_hi(q.w));
        *(u32x4*)(DP + (size_t)t * 1024 + c) = o;
    }
}

constexpr int G1_LR = 0, G1_SEG = 4096, G1_KTE = 8192, KTE_PITCH = 272, G1_V = G1_KTE + 64 * KTE_PITCH, V_PITCH = 528;
__device__ __forceinline__ void gla_state_phase(LAS unsigned char* lds, bf16_t* Z, const float* GLR, const float* wgu, const float* bgate, float* CS, float* DEC,
                                                int tid, int lane, int wave, int G) {
    LAS float* lr = (LAS float*)(lds + G1_LR);
    LAS float* seg = (LAS float*)(lds + G1_SEG);
    const unsigned kte_a = (unsigned)(size_t)(lds + G1_KTE), v_a = (unsigned)(size_t)(lds + G1_V);
    const int k = tid & 127, sg = tid >> 7;
    const int g4 = lane >> 4, q4 = (lane & 15) >> 2, p4 = lane & 3;
#pragma unroll 1
    for (int n = blockIdx.x; n < T / 64; n += G) {
        __syncthreads();
        if (tid < 256) *(LAS f32x4*)(lr + 4 * tid) = *(const f32x4*)(GLR + (size_t)n * 1024 + 4 * tid);
#pragma unroll 1
        for (int h = 0; h < 4; ++h) {
            float W[16];
#pragma unroll
            for (int r = 0; r < 16; ++r) W[r] = wgu[r * 512 + h * 128 + k];
            const float bg = bgate[h * 128 + k];
            __syncthreads();
#pragma unroll
            for (int i = 0; i < 4; ++i) { const int idx = tid + 512 * i, c = idx >> 5, ch = idx & 31;
                *(LAS u32x4*)(lds + G1_V + c * V_PITCH + ch * 16) = *(const u32x4*)(Z + (size_t)(64 * n + c) * 4096 + 2048 + h * 256 + 8 * ch); }
            float bcl[16]; float run = 0.f;
#pragma unroll
            for (int i = 0; i < 16; ++i) { const int c = 16 * sg + i; float s = bg;
#pragma unroll
                for (int r4 = 0; r4 < 4; ++r4) { const f32x4 a = *(const LAS f32x4*)(lr + c * 16 + 4 * r4); s += (a.x * W[4 * r4] + a.y * W[4 * r4 + 1]) + (a.z * W[4 * r4 + 2] + a.w * W[4 * r4 + 3]); }
                const float ls = fminf(s, 0.f) - log1pf(__expf(-fabsf(s)));
                run += ls * (1.0f / 16.0f); bcl[i] = run; }
            seg[sg * 128 + k] = run;
            __syncthreads();
            float off = 0.f, blast = 0.f;
#pragma unroll
            for (int s2 = 0; s2 < 4; ++s2) { const float x = seg[s2 * 128 + k]; blast += x; off += (s2 < sg) ? x : 0.f; }
#pragma unroll
            for (int i = 0; i < 16; ++i) { const int c = 16 * sg + i; const float bc = off + bcl[i];
                bf16_t* zr = Z + (size_t)(64 * n + c) * 4096 + h * 128 + k;
                const float qv = bf2f(zr[1024]), kv = bf2f(zr[1536]);
                zr[1024] = f2bf(qv * 0.08838834764831845f * __expf(bc));
                zr[1536] = f2bf(kv * __expf(-bc));
                *(LAS bf16_t*)(lds + G1_KTE + c * KTE_PITCH + 2 * k) = f2bf(kv * __expf(blast - bc)); }
            if (sg == 0) DEC[(size_t)n * 512 + h * 128 + k] = __expf(blast);
            __syncthreads();
            f32x4 acc[8][2];
#pragma unroll
            for (int mb = 0; mb < 8; ++mb) { acc[mb][0] = (f32x4){0.f, 0.f, 0.f, 0.f}; acc[mb][1] = (f32x4){0.f, 0.f, 0.f, 0.f}; }
#pragma unroll
            for (int ks = 0; ks < 2; ++ks) {
                bf16x8 bfr[2];
#pragma unroll
                for (int nb = 0; nb < 2; ++nb) { const unsigned a0 = v_a + (32 * ks + 8 * g4 + q4) * V_PITCH + (32 * wave + 16 * nb + 4 * p4) * 2; bfr[nb] = tr_frag(a0, a0 + 4 * V_PITCH); }
#pragma unroll
                for (int mb = 0; mb < 8; ++mb) { const unsigned a0 = kte_a + (32 * ks + 8 * g4 + q4) * KTE_PITCH + (16 * mb + 4 * p4) * 2; const bf16x8 af = tr_frag(a0, a0 + 4 * KTE_PITCH);
                    acc[mb][0] = mma16(af, bfr[0], acc[mb][0]); acc[mb][1] = mma16(af, bfr[1], acc[mb][1]); }
            }
            float* cs = CS + ((size_t)(n * 4 + h) * 256) * 128;
#pragma unroll
            for (int mb = 0; mb < 8; ++mb)
#pragma unroll
                for (int nb = 0; nb < 2; ++nb) *(f32x4*)(cs + (size_t)(32 * wave + 16 * nb + (lane & 15)) * 128 + 16 * mb + 4 * g4) = acc[mb][nb];
        }
    }
}

__device__ __forceinline__ void gla_scan_phase(const float* CS, const float* DEC, bf16_t* SP, int tid, int G) {
#pragma unroll 1
    for (int e = blockIdx.x * NTHR + tid; e < 4 * 256 * 128; e += G * NTHR) {
        const int h = e >> 15, k = e & 127;
        float S = 0.f;
        const float* cp = CS + e; const float* dp = DEC + h * 128 + k; bf16_t* sp = SP + e;
#pragma unroll 1
        for (int n0 = 0; n0 < 256; n0 += 16) {
            float c[16], d[16];
#pragma unroll
            for (int i = 0; i < 16; ++i) { c[i] = cp[(size_t)(n0 + i) * 131072]; d[i] = dp[(size_t)(n0 + i) * 512]; }
#pragma unroll
            for (int i = 0; i < 16; ++i) { sp[(size_t)(n0 + i) * 131072] = f2bf(S); S = fmaf(d[i], S, c[i]); }
        }
    }
}

constexpr int G3_QD = 0, QK_PITCH = 272, G3_KD = 64 * QK_PITCH, G3_V = 2 * 64 * QK_PITCH, G3_ATT = G3_V + 64 * V_PITCH, ATT_PITCH = 144,
              G3_SSQ = G3_ATT + 64 * ATT_PITCH, G3_RSTD = G3_SSQ + 2048, G3_STG = 0, STG_PITCH = 260;
static_assert(64 * STG_PITCH * 4 <= G3_ATT, "o staging aliases the q/k/v images only");
__device__ __forceinline__ void gla_out_phase(LAS unsigned char* lds, const bf16_t* Z, const bf16_t* SP, const float* gnorm, bf16_t* MIX, int tid, int lane, int wave, int G) {
    const unsigned v_a = (unsigned)(size_t)(lds + G3_V);
    const int g4 = lane >> 4, l15 = lane & 15, q4 = l15 >> 2, p4 = lane & 3;
    LAS float* ssq = (LAS float*)(lds + G3_SSQ); LAS float* rstd = (LAS float*)(lds + G3_RSTD); LAS float* stg = (LAS float*)(lds + G3_STG);
#pragma unroll 1
    for (int n = blockIdx.x; n < T / 64; n += G) {
#pragma unroll 1
        for (int h = 0; h < 4; ++h) {
            __syncthreads();
#pragma unroll
            for (int i = 0; i < 2; ++i) { const int idx = tid + 512 * i, row = idx >> 4, ch = idx & 15; const bf16_t* zr = Z + (size_t)(64 * n + row) * 4096 + h * 128 + 8 * ch;
                *(LAS u32x4*)(lds + G3_QD + row * QK_PITCH + ch * 16) = *(const u32x4*)(zr + 1024);
                *(LAS u32x4*)(lds + G3_KD + row * QK_PITCH + ch * 16) = *(const u32x4*)(zr + 1536); }
#pragma unroll
            for (int i = 0; i < 4; ++i) { const int idx = tid + 512 * i, c = idx >> 5, ch = idx & 31;
                *(LAS u32x4*)(lds + G3_V + c * V_PITCH + ch * 16) = *(const u32x4*)(Z + (size_t)(64 * n + c) * 4096 + 2048 + h * 256 + 8 * ch); }
            bf16x8 sp[2][4];
            const bf16_t* spb = SP + ((size_t)(n * 4 + h) * 256) * 128;
#pragma unroll
            for (int nb = 0; nb < 2; ++nb)
#pragma unroll
                for (int ks = 0; ks < 4; ++ks) sp[nb][ks] = *(const bf16x8*)(spb + (size_t)(32 * wave + 16 * nb + l15) * 128 + 32 * ks + 8 * g4);
            __syncthreads();
            f32x4 acc[4][2];
#pragma unroll
            for (int mb = 0; mb < 4; ++mb) { acc[mb][0] = (f32x4){0.f, 0.f, 0.f, 0.f}; acc[mb][1] = (f32x4){0.f, 0.f, 0.f, 0.f}; }
#pragma unroll
            for (int ks = 0; ks < 4; ++ks)
#pragma unroll
                for (int mb = 0; mb < 4; ++mb) { const bf16x8 a = *(const LAS bf16x8*)(lds + G3_QD + (16 * mb + l15) * QK_PITCH + (32 * ks + 8 * g4) * 2);
                    acc[mb][0] = mma16(a, sp[0][ks], acc[mb][0]); acc[mb][1] = mma16(a, sp[1][ks], acc[mb][1]); }
            { const int jb = wave >> 1;
#pragma unroll
                for (int ib2 = 0; ib2 < 2; ++ib2) { const int ib = 2 * (wave & 1) + ib2; f32x4 at = (f32x4){0.f, 0.f, 0.f, 0.f};
                    if (jb <= ib) {
#pragma unroll
                        for (int ks = 0; ks < 4; ++ks) { const bf16x8 a = *(const LAS bf16x8*)(lds + G3_KD + (16 * jb + l15) * QK_PITCH + (32 * ks + 8 * g4) * 2);
                            const bf16x8 b = *(const LAS bf16x8*)(lds + G3_QD + (16 * ib + l15) * QK_PITCH + (32 * ks + 8 * g4) * 2); at = mma16(a, b, at); } }
                    const int i = 16 * ib + l15, j0 = 16 * jb + 4 * g4;
                    u32x2 w; w.x = pk_bf16(j0 + 0 <= i ? at[0] : 0.f, j0 + 1 <= i ? at[1] : 0.f); w.y = pk_bf16(j0 + 2 <= i ? at[2] : 0.f, j0 + 3 <= i ? at[3] : 0.f);
                    *(LAS u32x2*)(lds + G3_ATT + i * ATT_PITCH + j0 * 2) = w; } }
            __syncthreads();
#pragma unroll
            for (int ks = 0; ks < 2; ++ks) {
                bf16x8 bfr[2];
#pragma unroll
                for (int nb = 0; nb < 2; ++nb) { const unsigned a0 = v_a + (32 * ks + 8 * g4 + q4) * V_PITCH + (32 * wave + 16 * nb + 4 * p4) * 2; bfr[nb] = tr_frag(a0, a0 + 4 * V_PITCH); }
#pragma unroll
                for (int mb = 0; mb < 4; ++mb) { const bf16x8 a = *(const LAS bf16x8*)(lds + G3_ATT + (16 * mb + l15) * ATT_PITCH + (32 * ks + 8 * g4) * 2);
                    acc[mb][0] = mma16(a, bfr[0], acc[mb][0]); acc[mb][1] = mma16(a, bfr[1], acc[mb][1]); }
            }
#pragma unroll
            for (int mb = 0; mb < 4; ++mb)
#pragma unroll
                for (int r = 0; r < 4; ++r) { float p = acc[mb][0][r] * acc[mb][0][r] + acc[mb][1][r] * acc[mb][1][r];
                    p += __shfl_xor(p, 1); p += __shfl_xor(p, 2); p += __shfl_xor(p, 4); p += __shfl_xor(p, 8);
                    if (l15 == 0) ssq[wave * 64 + 16 * mb + 4 * g4 + r] = p; }
            __syncthreads();
            if (tid < 64) { float s = 0.f;
#pragma unroll
                for (int w = 0; w < 8; ++w) s += ssq[w * 64 + tid];
                rstd[tid] = rsqrtf(s * (1.0f / 256.0f) + EPSF); }
#pragma unroll
            for (int mb = 0; mb < 4; ++mb)
#pragma unroll
                for (int nb = 0; nb < 2; ++nb)
#pragma unroll
                    for (int r = 0; r < 4; ++r) stg[(16 * mb + 4 * g4 + r) * STG_PITCH + 32 * wave + 16 * nb + l15] = acc[mb][nb][r];
            __syncthreads();
#pragma unroll
            for (int i = 0; i < 4; ++i) { const int item = tid + 512 * i, row = item >> 5, c8 = (item & 31) * 8;
                const f32x4 o0 = *(const LAS f32x4*)(stg + row * STG_PITCH + c8), o1 = *(const LAS f32x4*)(stg + row * STG_PITCH + c8 + 4);
                const float rs = rstd[row];
                const f32x4 g0 = *(const f32x4*)(gnorm + h * 256 + c8), g1 = *(const f32x4*)(gnorm + h * 256 + c8 + 4);
                const u32x4 rr = *(const u32x4*)(Z + (size_t)(64 * n + row) * 4096 + 3072 + h * 256 + c8);
                u32x4 w;
                w.x = pk_bf16(o0.x * rs * g0.x * silu_f(bf_lo(rr.x)), o0.y * rs * g0.y * silu_f(bf_hi(rr.x)));
                w.y = pk_bf16(o0.z * rs * g0.z * silu_f(bf_lo(rr.y)), o0.w * rs * g0.w * silu_f(bf_hi(rr.y)));
                w.z = pk_bf16(o1.x * rs * g1.x * silu_f(bf_lo(rr.z)), o1.y * rs * g1.y * silu_f(bf_hi(rr.z)));
                w.w = pk_bf16(o1.z * rs * g1.z * silu_f(bf_lo(rr.w)), o1.w * rs * g1.w * silu_f(bf_hi(rr.w)));
                *(u32x4*)(MIX + (size_t)(64 * n + row) * 2048 + 1024 + h * 256 + c8) = w; }
        }
    }
}

__device__ __forceinline__ void assign_phase(LAS unsigned char* lds, const int* topi, const int* hist, int* tok_slot, int* blk_expert, int* nrb_out,
                                             const bf16_t* H, bf16_t* HS, int tid, int lane, int wave, int G) {
    LAS int* lh = (LAS int*)lds;
    LAS int* tot = (LAS int*)(lds + 8192);
    LAS int* myslot = (LAS int*)(lds + 8192 + 256);
#pragma unroll
    for (int i = 0; i < 4; ++i) lh[tid + 512 * i] = __hip_atomic_load(hist + tid + 512 * i, RLX_AGENT);
    __syncthreads();
#pragma unroll 1
    for (int rb = blockIdx.x; rb < T / 64; rb += G) {
        if (tid < 8) { int t_ = 0, b_ = 0; for (int bb = 0; bb < 256; ++bb) { const int c = lh[bb * 8 + tid]; b_ += (bb < rb) ? c : 0; t_ += c; }
            tot[tid] = t_; tot[8 + tid] = ((t_ + 255) >> 8) << 8; tot[16 + tid] = b_; }
        __syncthreads();
        if (tid == 0) { int run = 0; int cum[8];
#pragma unroll
            for (int e = 0; e < 8; ++e) { tot[24 + e] = run + tot[16 + e]; run += tot[8 + e]; cum[e] = run; }
            if (rb == 0) { *nrb_out = run >> 8;
                for (int b = 0; b < NRB_MAX; ++b) { int e = 0;
#pragma unroll
                    for (int q = 0; q < 8; ++q) e += (cum[q] <= b * 256) ? 1 : 0;
                    blk_expert[b] = e < 7 ? e : 7; } } }
        int my_e = 0, my_rank = 0;
        if (wave < 2) { my_e = topi[128 * rb + tid];
#pragma unroll
            for (int e = 0; e < 8; ++e) { const unsigned long long m = __ballot(my_e == e);
                if (my_e == e) my_rank = __popcll(m & ((1ull << lane) - 1ull));
                if (wave == 0 && lane == 0) tot[32 + e] = __popcll(m); } }
        __syncthreads();
        if (wave < 2) { const int s = tot[24 + my_e] + my_rank + (wave == 1 ? tot[32 + my_e] : 0); myslot[tid] = s; tok_slot[128 * rb + tid] = s; }
        __syncthreads();
#pragma unroll 1
        for (int i = wave; i < 128; i += 8) { const int t = 64 * rb + (i >> 1), s = myslot[i];
            const u32x4* src = (const u32x4*)(H + (size_t)t * DM); u32x4* dst = (u32x4*)(HS + (size_t)s * DM);
#pragma unroll
            for (int q = 0; q < 4; ++q) dst[lane + 64 * q] = src[lane + 64 * q]; }
        __syncthreads();
    }
}

__device__ __forceinline__ void final_phase(const float* XS, const bf16_t* Y, const int* tok_slot, const float* topw, const float* gain, float* out, int lane, int wave, int G) {
    f32x4 gv[8];
#pragma unroll
    for (int j = 0; j < 8; ++j) gv[j] = *(const f32x4*)(gain + 4 * lane + 256 * j);
#pragma unroll 1
    for (int row = blockIdx.x * 8 + wave; row < T; row += G * 8) {
        const int s0 = tok_slot[2 * row], s1 = tok_slot[2 * row + 1]; const float w0 = topw[2 * row], w1 = topw[2 * row + 1];
        const f32x4* xr = (const f32x4*)(XS + (size_t)row * DM) + lane;
        const u32x2* y0 = (const u32x2*)(Y + (size_t)s0 * DM) + lane; const u32x2* y1 = (const u32x2*)(Y + (size_t)s1 * DM) + lane;
        f32x4 v[8]; float ss = 0.f;
#pragma unroll
        for (int j = 0; j < 8; ++j) { v[j] = xr[64 * j]; const u32x2 a = y0[64 * j], b = y1[64 * j];
            v[j].x += w0 * bf_lo(a.x) + w1 * bf_lo(b.x); v[j].y += w0 * bf_hi(a.x) + w1 * bf_hi(b.x); v[j].z += w0 * bf_lo(a.y) + w1 * bf_lo(b.y); v[j].w += w0 * bf_hi(a.y) + w1 * bf_hi(b.y);
            ss += (v[j].x * v[j].x + v[j].y * v[j].y) + (v[j].z * v[j].z + v[j].w * v[j].w); }
        const float rstd = rsqrtf(wave_sum(ss) * (1.0f / DM) + EPSF);
        f32x4* orow = (f32x4*)(out + (size_t)row * DM) + lane;
#pragma unroll
        for (int j = 0; j < 8; ++j) orow[64 * j] = v[j] * rstd * gv[j];
    }
}
#ifdef NO_GEMM
#define GEMMCALL(...) ;
#else
#define GEMMCALL(...) __VA_ARGS__
#endif
#ifdef NO_CVT
#define CVTCALL(...) ;
#else
#define CVTCALL(...) __VA_ARGS__
#endif
#ifdef NO_NORM
#define NORMCALL(...) ;
#else
#define NORMCALL(...) __VA_ARGS__
#endif
#ifdef NO_PRE
#define PRECALL(...) ;
#else
#define PRECALL(...) __VA_ARGS__
#endif
#ifdef NO_SCAN
#define SCANCALL(...) ;
#else
#define SCANCALL(...) __VA_ARGS__
#endif
#ifdef NO_OUT
#define OUTCALL(...) ;
#else
#define OUTCALL(...) __VA_ARGS__
#endif
#ifdef NO_ASG
#define ASGCALL(...) ;
#else
#define ASGCALL(...) __VA_ARGS__
#endif
#ifdef NO_FIN
#define FINCALL(...) ;
#else
#define FINCALL(...) __VA_ARGS__
#endif
struct Args { const float* in[18]; float* out; unsigned char* ws; int ph_lo, ph_hi, cvt_items, pad; };

__global__ void __launch_bounds__(NTHR, 2) fwd(Args args) {
    extern __shared__ __attribute__((aligned(16))) unsigned char lds_raw[];
    LAS unsigned char* lds = (LAS unsigned char*)lds_raw;
    volatile LAS unsigned* MISC = (volatile LAS unsigned*)(lds + MISC_OFF);
    const int tid = threadIdx.x, lane = tid & 63, wave = __builtin_amdgcn_readfirstlane(tid >> 6);
    const int G = gridDim.x;
    unsigned char* ws = args.ws;
    unsigned* ctl = (unsigned*)(ws + WS_CTL);
    const int lo = args.ph_lo, hi = args.ph_hi;
    if (tid < 64) MISC[tid] = 0u;
    __syncthreads();
    XcdBarrier bar; bar.bar = ctl + CW_BAR; bar.x = 0; bar.st = nullptr;
    if (hi - lo > 1) bar = xcd_barrier_post(ctl + CW_BAR, MISC + 8);
#define IN(k) (lo <= (k) && (k) < hi)
#define SEAM(k) do { if (IN(k) && IN((k) + 1)) xcd_barrier(bar); } while (0)

    const float* x = args.in[0]; const float* mix_norm = args.in[1]; const float* w_in = args.in[2]; const float* pool_scale = args.in[4];
    const float* w_gate_up = args.in[5]; const float* b_gate = args.in[6]; const float* gla_norm = args.in[7]; const float* ffn_norm = args.in[9];
    const float* w_router = args.in[13]; const float* final_norm = args.in[17];
    bf16_t* H = (bf16_t*)(ws + WS_H); float* XS = (float*)(ws + WS_XS); float* GLR = (float*)(ws + WS_GLR);
    bf16_t* Z = (bf16_t*)(ws + WS_Z); bf16_t* DP = (bf16_t*)(ws + WS_DP); bf16_t* MIX = (bf16_t*)(ws + WS_MIX);
    float* CS = (float*)(ws + WS_CS); bf16_t* SP = (bf16_t*)(ws + WS_SP); float* DEC = (float*)(ws + WS_DEC);
    bf16_t* ACT = (bf16_t*)(ws + WS_ACT); bf16_t* HS = (bf16_t*)(ws + WS_HS); bf16_t* ACT2 = (bf16_t*)(ws + WS_ACT2); bf16_t* Y = (bf16_t*)(ws + WS_Y);
    int* topi = (int*)(ws + WS_ROUTE + RT_TOPI); float* topw = (float*)(ws + WS_ROUTE + RT_TOPW); int* tok_slot = (int*)(ws + WS_ROUTE + RT_TOKSLOT);
    int* hist = (int*)(ws + WS_ROUTE + RT_HIST); int* blk_expert = (int*)(ws + WS_ROUTE + RT_BLKE); int* nrb_p = (int*)(ws + WS_ROUTE + RT_NRB);

    if (IN(PH_PRO)) {
        CvtPtrs P; P.w_in = w_in; P.w_pool = args.in[3]; P.w_out = args.in[8]; P.dwg = args.in[10]; P.dwu = args.in[11]; P.dwd = args.in[12];
        P.ewg = args.in[14]; P.ewu = args.in[15]; P.ewd = args.in[16]; P.ws = ws;
        LAS float* scr = (LAS float*)(lds + wave * 17408);
        const int gw = blockIdx.x * 8 + wave, NGW = G * 8;
        CVTCALL(for (int it = gw; it < args.cvt_items; it += NGW) cvt_item(cvt_decode(P, it), scr, lane);)
        if (blockIdx.x == 0) { for (int i = tid; i < DM / 2; i += NTHR) ((unsigned*)(H + (size_t)T * DM))[i] = 0u; }
        __syncthreads();
        NORMCALL(norm_phase<0>(lds, x, mix_norm, H, w_in + 3072, ZW, GLR, nullptr, nullptr, nullptr, tid, lane, wave, G);)
    }
    SEAM(PH_PRO);

    { constexpr int l = 0;
        const int pb = 1 + PH_PER_LAYER * l;
        if (IN(pb + PK_INPROJ)) {
            pg8::Gemm g{2048, 2048, 2048}; pg8::Order<false> S; S.init(T / 256, 16, G, (int)blockIdx.x);
            S.A = (const char*)H; S.B = (const char*)(ws + WS_WIN) + (size_t)l * 4096 * 2048 * 2; S.a_pm = (size_t)256 * 2048 * 2; S.a_pn = 0; S.b_pn = (size_t)256 * 2048 * 2; S.b_e = 0; S.blk_expert = nullptr;
            pg8::EpiBf16 E{Z, 4096, nullptr};
            GEMMCALL(pg8::gemm_phase<pg8::EpiBf16, pg8::Order<false>, true, true>(lds, g, S, E);)
        }
        SEAM(pb + PK_INPROJ);
        if (IN(pb + PK_PRE)) {
            PRECALL(pool_d_phase(Z, DP, tid, G);)
            PRECALL(gla_state_phase(lds, Z, GLR, w_gate_up + (size_t)l * 16 * 512, b_gate + l * 512, CS, DEC, tid, lane, wave, G);)
        }
        SEAM(pb + PK_PRE);
        if (IN(pb + PK_POOLSCAN)) {
            SCANCALL(gla_scan_phase(CS, DEC, SP, tid, G);)
            __syncthreads();
            pg8::Gemm g{1024, 256, 256}; pg8::Order<false> S; S.init(T / 256, 4, G, (int)blockIdx.x);
            S.A = (const char*)DP; S.B = (const char*)(ws + WS_WPOOL) + (size_t)l * 4 * 65536 * 2; S.a_pm = (size_t)256 * 1024 * 2; S.a_pn = 256 * 2; S.b_pn = (size_t)65536 * 2; S.b_e = 0; S.blk_expert = nullptr;
            pg8::EpiBf16 E{MIX, 2048, pool_scale + l * 1024};
            GEMMCALL(pg8::gemm_phase<pg8::EpiBf16, pg8::Order<false>, true, true>(lds, g, S, E);)
        }
        SEAM(pb + PK_POOLSCAN);
        if (IN(pb + PK_GLAOUT)) OUTCALL(gla_out_phase(lds, Z, SP, gla_norm + l * 1024, MIX, tid, lane, wave, G);)
        SEAM(pb + PK_GLAOUT);
        if (IN(pb + PK_OUTPROJ)) {
            pg8::Gemm g{2048, 2048, 2048}; pg8::Order<false> S; S.init(T / 256, 8, G, (int)blockIdx.x);
            S.A = (const char*)MIX; S.B = (const char*)(ws + WS_WOUT) + (size_t)l * 2048 * 2048 * 2; S.a_pm = (size_t)256 * 2048 * 2; S.a_pn = 0; S.b_pn = (size_t)256 * 2048 * 2; S.b_e = 0; S.blk_expert = nullptr;
            pg8::EpiRes E{l == 0 ? x : XS, XS, 2048};
            GEMMCALL(pg8::gemm_phase<pg8::EpiRes, pg8::Order<false>, true, true>(lds, g, S, E);)
        }
        SEAM(pb + PK_OUTPROJ);
        if (IN(pb + PK_NORM2)) {
            if (l == 0) NORMCALL(norm_phase<1>(lds, XS, ffn_norm, H, nullptr, 0, nullptr, nullptr, nullptr, nullptr, tid, lane, wave, G);)
            else NORMCALL(norm_phase<2>(lds, XS, ffn_norm + DM, H, w_router, 8, nullptr, topi, topw, hist, tid, lane, wave, G);)
        }
        SEAM(pb + PK_NORM2);
        if (l == 1) { if (IN(pb + PK_ASSIGN)) ASGCALL(assign_phase(lds, topi, hist, tok_slot, blk_expert, nrb_p, H, HS, tid, lane, wave, G);)
            SEAM(pb + PK_ASSIGN); }
        if (IN(pb + PK_UP)) {
            if (l == 0) {
                pg8::Gemm g{2048, 2048, 2048}; pg8::Order<false> S; S.init(T / 256, 44, G, (int)blockIdx.x);
                S.A = (const char*)H; S.B = (const char*)(ws + WS_WGU); S.a_pm = (size_t)256 * 2048 * 2; S.a_pn = 0; S.b_pn = (size_t)256 * 2048 * 2; S.b_e = 0; S.blk_expert = nullptr;
                pg8::EpiSwiglu E{ACT, 5632};
                GEMMCALL(pg8::gemm_phase<pg8::EpiSwiglu, pg8::Order<false>, true, true>(lds, g, S, E);)
            } else {
                const int nrb = __builtin_amdgcn_readfirstlane(__hip_atomic_load(nrb_p, RLX_AGENT));
                pg8::Gemm g{2048, 2048, 2048}; pg8::Order<true> S; S.init(nrb, 56, G, (int)blockIdx.x);
                S.A = (const char*)HS; S.B = (const char*)(ws + WS_EWGU); S.a_pm = (size_t)256 * 2048 * 2; S.a_pn = 0; S.b_pn = (size_t)256 * 2048 * 2; S.b_e = (size_t)14336 * 2048 * 2; S.blk_expert = blk_expert;
                pg8::EpiSwiglu E{ACT2, 7168};
                GEMMCALL(pg8::gemm_phase<pg8::EpiSwiglu, pg8::Order<true>, true, true>(lds, g, S, E);)
            }
        }
        SEAM(pb + PK_UP);
        if (IN(pb + PK_DOWN)) {
            if (l == 0) {
                pg8::Gemm g{5632, 5632, 5632}; pg8::Order<false> S; S.init(T / 256, 8, G, (int)blockIdx.x);
                S.A = (const char*)ACT; S.B = (const char*)(ws + WS_WD); S.a_pm = (size_t)256 * 5632 * 2; S.a_pn = 0; S.b_pn = (size_t)256 * 5632 * 2; S.b_e = 0; S.blk_expert = nullptr;
                pg8::EpiRes E{XS, XS, 2048};
                GEMMCALL(pg8::gemm_phase<pg8::EpiRes, pg8::Order<false>, true, true>(lds, g, S, E);)
            } else {
                const int nrb = __builtin_amdgcn_readfirstlane(__hip_atomic_load(nrb_p, RLX_AGENT));
                pg8::Gemm g{7168, 7168, 7168}; pg8::Order<true> S; S.init(nrb, 8, G, (int)blockIdx.x);
                S.A = (const char*)ACT2; S.B = (const char*)(ws + WS_EWD); S.a_pm = (size_t)256 * 7168 * 2; S.a_pn = 0; S.b_pn = (size_t)256 * 7168 * 2; S.b_e = (size_t)2048 * 7168 * 2; S.blk_expert = blk_expert;
                pg8::EpiBf16 E{Y, 2048, nullptr};
                GEMMCALL(pg8::gemm_phase<pg8::EpiBf16, pg8::Order<true>, true, true>(lds, g, S, E);)
            }
        }
        SEAM(pb + PK_DOWN);
        if (IN(pb + PK_TAIL)) {
            if (l == 0) NORMCALL(norm_phase<0>(lds, XS, mix_norm + DM, H, w_in + (size_t)DM * ZW + 3072, ZW, GLR, nullptr, nullptr, nullptr, tid, lane, wave, G);)
            else FINCALL(final_phase(XS, Y, tok_slot, topw, final_norm, args.out, lane, wave, G);)
        }
        if (l == 0) SEAM(pb + PK_TAIL);
    }
    { constexpr int l = 1;
        const int pb = 1 + PH_PER_LAYER * l;
        if (IN(pb + PK_INPROJ)) {
            pg8::Gemm g{2048, 2048, 2048}; pg8::Order<false> S; S.init(T / 256, 16, G, (int)blockIdx.x);
            S.A = (const char*)H; S.B = (const char*)(ws + WS_WIN) + (size_t)l * 4096 * 2048 * 2; S.a_pm = (size_t)256 * 2048 * 2; S.a_pn = 0; S.b_pn = (size_t)256 * 2048 * 2; S.b_e = 0; S.blk_expert = nullptr;
            pg8::EpiBf16 E{Z, 4096, nullptr};
            GEMMCALL(pg8::gemm_phase<pg8::EpiBf16, pg8::Order<false>, true, true>(lds, g, S, E);)
        }
        SEAM(pb + PK_INPROJ);
        if (IN(pb + PK_PRE)) {
            PRECALL(pool_d_phase(Z, DP, tid, G);)
            PRECALL(gla_state_phase(lds, Z, GLR, w_gate_up + (size_t)l * 16 * 512, b_gate + l * 512, CS, DEC, tid, lane, wave, G);)
        }
        SEAM(pb + PK_PRE);
        if (IN(pb + PK_POOLSCAN)) {
            SCANCALL(gla_scan_phase(CS, DEC, SP, tid, G);)
            __syncthreads();
            pg8::Gemm g{1024, 256, 256}; pg8::Order<false> S; S.init(T / 256, 4, G, (int)blockIdx.x);
            S.A = (const char*)DP; S.B = (const char*)(ws + WS_WPOOL) + (size_t)l * 4 * 65536 * 2; S.a_pm = (size_t)256 * 1024 * 2; S.a_pn = 256 * 2; S.b_pn = (size_t)65536 * 2; S.b_e = 0; S.blk_expert = nullptr;
            pg8::EpiBf16 E{MIX, 2048, pool_scale + l * 1024};
            GEMMCALL(pg8::gemm_phase<pg8::EpiBf16, pg8::Order<false>, true, true>(lds, g, S, E);)
        }
        SEAM(pb + PK_POOLSCAN);
        if (IN(pb + PK_GLAOUT)) OUTCALL(gla_out_phase(lds, Z, SP, gla_norm + l * 1024, MIX, tid, lane, wave, G);)
        SEAM(pb + PK_GLAOUT);
        if (IN(pb + PK_OUTPROJ)) {
            pg8::Gemm g{2048, 2048, 2048}; pg8::Order<false> S; S.init(T / 256, 8, G, (int)blockIdx.x);
            S.A = (const char*)MIX; S.B = (const char*)(ws + WS_WOUT) + (size_t)l * 2048 * 2048 * 2; S.a_pm = (size_t)256 * 2048 * 2; S.a_pn = 0; S.b_pn = (size_t)256 * 2048 * 2; S.b_e = 0; S.blk_expert = nullptr;
            pg8::EpiRes E{l == 0 ? x : XS, XS, 2048};
            GEMMCALL(pg8::gemm_phase<pg8::EpiRes, pg8::Order<false>, true, true>(lds, g, S, E);)
        }
        SEAM(pb + PK_OUTPROJ);
        if (IN(pb + PK_NORM2)) {
            if (l == 0) NORMCALL(norm_phase<1>(lds, XS, ffn_norm, H, nullptr, 0, nullptr, nullptr, nullptr, nullptr, tid, lane, wave, G);)
            else NORMCALL(norm_phase<2>(lds, XS, ffn_norm + DM, H, w_router, 8, nullptr, topi, topw, hist, tid, lane, wave, G);)
        }
        SEAM(pb + PK_NORM2);
        if (l == 1) { if (IN(pb + PK_ASSIGN)) ASGCALL(assign_phase(lds, topi, hist, tok_slot, blk_expert, nrb_p, H, HS, tid, lane, wave, G);)
            SEAM(pb + PK_ASSIGN); }
        if (IN(pb + PK_UP)) {
            if (l == 0) {
                pg8::Gemm g{2048, 2048, 2048}; pg8::Order<false> S; S.init(T / 256, 44, G, (int)blockIdx.x);
                S.A = (const char*)H; S.B = (const char*)(ws + WS_WGU); S.a_pm = (size_t)256 * 2048 * 2; S.a_pn = 0; S.b_pn = (size_t)256 * 2048 * 2; S.b_e = 0; S.blk_expert = nullptr;
                pg8::EpiSwiglu E{ACT, 5632};
                GEMMCALL(pg8::gemm_phase<pg8::EpiSwiglu, pg8::Order<false>, true, true>(lds, g, S, E);)
            } else {
                const int nrb = __builtin_amdgcn_readfirstlane(__hip_atomic_load(nrb_p, RLX_AGENT));
                pg8::Gemm g{2048, 2048, 2048}; pg8::Order<true> S; S.init(nrb, 56, G, (int)blockIdx.x);
                S.A = (const char*)HS; S.B = (const char*)(ws + WS_EWGU); S.a_pm = (size_t)256 * 2048 * 2; S.a_pn = 0; S.b_pn = (size_t)256 * 2048 * 2; S.b_e = (size_t)14336 * 2048 * 2; S.blk_expert = blk_expert;
                pg8::EpiSwiglu E{ACT2, 7168};
                GEMMCALL(pg8::gemm_phase<pg8::EpiSwiglu, pg8::Order<true>, true, true>(lds, g, S, E);)
            }
        }
        SEAM(pb + PK_UP);
        if (IN(pb + PK_DOWN)) {
            if (l == 0) {
                pg8::Gemm g{5632, 5632, 5632}; pg8::Order<false> S; S.init(T / 256, 8, G, (int)blockIdx.x);
                S.A = (const char*)ACT; S.B = (const char*)(ws + WS_WD); S.a_pm = (size_t)256 * 5632 * 2; S.a_pn = 0; S.b_pn = (size_t)256 * 5632 * 2; S.b_e = 0; S.blk_expert = nullptr;
                pg8::EpiRes E{XS, XS, 2048};
                GEMMCALL(pg8::gemm_phase<pg8::EpiRes, pg8::Order<false>, true, true>(lds, g, S, E);)
            } else {
                const int nrb = __builtin_amdgcn_readfirstlane(__hip_atomic_load(nrb_p, RLX_AGENT));
                pg8::Gemm g{7168, 7168, 7168}; pg8::Order<true> S; S.init(nrb, 8, G, (int)blockIdx.x);
                S.A = (const char*)ACT2; S.B = (const char*)(ws + WS_EWD); S.a_pm = (size_t)256 * 7168 * 2; S.a_pn = 0; S.b_pn = (size_t)256 * 7168 * 2; S.b_e = (size_t)2048 * 7168 * 2; S.blk_expert = blk_expert;
                pg8::EpiBf16 E{Y, 2048, nullptr};
                GEMMCALL(pg8::gemm_phase<pg8::EpiBf16, pg8::Order<true>, true, true>(lds, g, S, E);)
            }
        }
        SEAM(pb + PK_DOWN);
        if (IN(pb + PK_TAIL)) {
            if (l == 0) NORMCALL(norm_phase<0>(lds, XS, mix_norm + DM, H, w_in + (size_t)DM * ZW + 3072, ZW, GLR, nullptr, nullptr, nullptr, tid, lane, wave, G);)
            else FINCALL(final_phase(XS, Y, tok_slot, topw, final_norm, args.out, lane, wave, G);)
        }
        if (l == 0) SEAM(pb + PK_TAIL);
    }
#undef IN
#undef SEAM
}
}
#ifndef MK_MODE
#define MK_MODE 0
#endif
#ifndef DBG_CUT
#define DBG_CUT 0
#endif
namespace dbg {
using fz::bf16_t;
__global__ __launch_bounds__(256) void k_cvt_z(const bf16_t* Z, const float* GLR, float* z) {
    const size_t i = (size_t)blockIdx.x * 256 + threadIdx.x; if (i >= (size_t)T * ZW) return;
    const int t = (int)(i / ZW), c = (int)(i % ZW);
    float v;
    if (c < 3072) v = fz::bf2f(Z[(size_t)t * 4096 + c]); else if (c < 3088) v = GLR[(size_t)t * 16 + (c - 3072)]; else v = fz::bf2f(Z[(size_t)t * 4096 + c - 16]);
    z[i] = v;
}
__global__ __launch_bounds__(256) void k_cvt_bf(const bf16_t* in, float* out, size_t n) {
    const size_t i = (size_t)blockIdx.x * 256 + threadIdx.x; if (i < n) out[i] = fz::bf2f(in[i]);
}
}

static void launch_fused(const fz::Args& base, int lo, int hi, int grid, hipStream_t stream) {
    fz::Args a = base; a.ph_lo = lo; a.ph_hi = hi;
    hipLaunchKernelGGL(fz::fwd, dim3(grid), dim3(fz::NTHR), fz::LDS_BYTES, stream, a);
}

extern "C" void kernel_launch(void* const* d_in, const int* in_sizes, int n_in, void* d_out, int out_size, void* d_ws, size_t ws_size, hipStream_t stream) {
    static int grid = 0;
    if (grid == 0) {
        int dev = 0, cus = 0;
        if (hipGetDevice(&dev) != hipSuccess || hipDeviceGetAttribute(&cus, hipDeviceAttributeMultiprocessorCount, dev) != hipSuccess) { grid = -1; return; }
        if (hipFuncSetAttribute((const void*)fz::fwd, hipFuncAttributeMaxDynamicSharedMemorySize, fz::LDS_BYTES) != hipSuccess) { fprintf(stderr, "hipFuncSetAttribute failed\n"); grid = -1; return; }
        int per_cu = 0;
        if (hipOccupancyMaxActiveBlocksPerMultiprocessor(&per_cu, (const void*)fz::fwd, fz::NTHR, fz::LDS_BYTES) != hipSuccess || per_cu < 1) fprintf(stderr, "occupancy query: %d\n", per_cu);
        (void)hipGetLastError();
        grid = cus;
        if (ws_size < fz::WS_END) { fprintf(stderr, "workspace too small\n"); grid = -1; return; }
    }
    if (grid < 0) return;
    unsigned char* ws = (unsigned char*)d_ws;
    (void)hipMemsetAsync(ws + fz::WS_CTL, 0, fz::CTL_ZERO_BYTES, stream);
    fz::Args a{};
    for (int i = 0; i < 18; ++i) a.in[i] = (const float*)d_in[i];
    a.out = (float*)d_out; a.ws = ws; a.cvt_items = fz::CI_TOTAL;
#if MK_MODE == 0
    launch_fused(a, 0, fz::NPH, grid, stream);
#elif MK_MODE == 1
    for (int p = 0; p < fz::NPH; ++p) { if (p == 1 + fz::PK_ASSIGN) continue; launch_fused(a, p, p + 1, grid, stream); }
#elif MK_MODE == 2
    {
        const int l = DBG_CUT / 10, kind = DBG_CUT % 10; const int pb = 1 + fz::PH_PER_LAYER * l;
        const int pcut = kind == 1 ? pb + 1 : kind == 2 ? pb + 4 : kind == 3 ? pb + 5 : kind == 4 ? pb + 6 : pb + 9;
        const int scut = kind == 1 ? 7 * l + 2 : kind == 2 ? 7 * l + 4 : kind == 3 ? 7 * l + 5 : kind == 4 ? 7 * l + 6 : 7 * l + 7;
        a.cvt_items = fz::CI_NONEXP;
        for (int p = 0; p < pcut; ++p) { if (p == 1 + fz::PK_ASSIGN) continue; launch_fused(a, p, p + 1, grid, stream); }
        ora::Bufs B = ora::make_bufs(ws + fz::WS_EWGU, (float*)(ws + fz::WS_XS));
        if (kind == 1) hipLaunchKernelGGL(dbg::k_cvt_z, dim3((unsigned)(((size_t)T * ZW + 255) / 256)), dim3(256), 0, stream, (const fz::bf16_t*)(ws + fz::WS_Z), (const float*)(ws + fz::WS_GLR), B.z);
        if (kind == 2) hipLaunchKernelGGL(dbg::k_cvt_bf, dim3((unsigned)(((size_t)T * 2048 + 255) / 256)), dim3(256), 0, stream, (const fz::bf16_t*)(ws + fz::WS_MIX), B.mixf, (size_t)T * 2048);
        if (kind == 4) hipLaunchKernelGGL(dbg::k_cvt_bf, dim3((unsigned)(((size_t)T * 2048 + 255) / 256)), dim3(256), 0, stream, (const fz::bf16_t*)(ws + fz::WS_H), B.hf, (size_t)T * 2048);
        ora::run_range(d_in, (float*)d_out, B, scut, 15, stream);
    }
#elif MK_MODE == 3
    {
        const int scut = DBG_CUT; const int pcut = scut == 5 ? 1 + fz::PK_NORM2 : scut == 7 ? 1 + fz::PK_TAIL : 1 + fz::PH_PER_LAYER + fz::PK_NORM2;
        ora::Bufs B = ora::make_bufs(ws + fz::WS_EWGU, (float*)(ws + fz::WS_XS));
        ora::run_range(d_in, (float*)d_out, B, 0, scut, stream);
        launch_fused(a, 0, 1, grid, stream);
        for (int p = pcut; p < fz::NPH; ++p) { if (p == 1 + fz::PK_ASSIGN) continue; launch_fused(a, p, p + 1, grid, stream); }
    }
#endif
}
```

```cpp
#include <hip/hip_runtime.h>
#include <cstdio>
#include <cstdint>
constexpr int T = 16384, DM = 2048, ZW = 4112;
constexpr float EPSF = 1e-6f;
constexpr int LSLOT = 34816, NRB_MAX = 136;
#ifndef DENSE_FP8
#define DENSE_FP8 2
#endif
#ifndef GEMM_SP2
#define GEMM_SP2 true
#endif
#ifndef GEMM_KM
#define GEMM_KM 0x240000
#endif
#ifndef GEMM_FP6_NOPRIO
#define GEMM_FP6_NOPRIO 0
#endif
#ifndef GEMM_SADDR
#define GEMM_SADDR 4
#endif
#ifndef GEMM_BPF
#define GEMM_BPF 0
#endif
#ifndef GEMM_ALIGN
#define GEMM_ALIGN false
#endif
#ifndef TILE_EWGU
#define TILE_EWGU 1
#endif
#ifndef TILE_ACT2
#define TILE_ACT2 1
#endif
#ifndef TILE_H
#define TILE_H 0
#endif
#ifndef TILE_ACT
#define TILE_ACT 1
#endif
#ifndef TILE_HS
#define TILE_HS 1
#endif
#ifndef MOE_UP_FMT
#define MOE_UP_FMT 2
#endif
#define MK_MODE 0
#define DBG_CUT 0
namespace pg8 {
#define PG8_LAS __attribute__((address_space(3)))
typedef unsigned short bf16_t;
typedef short bf16x8 __attribute__((ext_vector_type(8)));
typedef float f32x4 __attribute__((ext_vector_type(4)));
typedef unsigned u32x4 __attribute__((ext_vector_type(4)));
constexpr int BM = 256, BK = 64, HALF = 128, HTB = HALF * BK * 2, STAGE_BYTES = 8 * HTB, NXCD = 8, WGM = 8;

__host__ __device__ __forceinline__ int lds_byte(int r, int c) { const int st = (r >> 4) * 2 + (c >> 5), rr = r & 15, cc = c & 31, ob = rr * 64 + cc * 2; return st * 1024 + (ob ^ (((ob >> 9) & 1) << 5)); }
__host__ __device__ __forceinline__ void stage_rc(int b, int& R, int& C) { const int st = b / 1024, sb = b % 1024, swz = sb ^ (((sb >> 9) & 1) << 5); R = (st >> 1) * 16 + swz / 64; C = (st & 1) * 32 + (swz % 64) / 2; }
__host__ __device__ __forceinline__ int perm32(int rho) { const int n = rho >> 4, i = rho & 15; return 8 * (i >> 2) + 4 * n + (i & 3); }

struct Unit { int pm, pn; const char* a; const char* b; };
struct Gemm { int lda, ldb, K; int sA, sB; int kstepA, kstepB; };
typedef int i32x8 __attribute__((ext_vector_type(8)));
typedef int i32x4 __attribute__((ext_vector_type(4)));
typedef int i32x6 __attribute__((ext_vector_type(6)));
typedef int i32x2 __attribute__((ext_vector_type(2)));

__device__ __forceinline__ void unit_map(long L, int nM, int nN, int& pm, int& pn) {
    const int nwg = nM * nN; int wgid = (int)L; { const int q = nwg / NXCD, r = nwg % NXCD, xcd = wgid % NXCD, off = wgid / NXCD; wgid = (xcd < r ? xcd * (q + 1) : r * (q + 1) + (xcd - r) * q) + off; }
    const int nig = WGM * nN, gid = wgid / nig, fm = gid * WGM, gsz = (nM - fm) < WGM ? (nM - fm) : WGM;
    pm = fm + ((wgid % nig) % gsz); pn = (wgid % nig) / gsz;
}
template <bool MOE> struct Order {
    int nM, nN, nwg, G, c; long Lend;
    const char* A; const char* B; size_t a_pm, a_pn, b_pn, b_e; const int* blk_expert;
    __device__ void init(int nM_, int nN_, int G_, int c_) { nM = nM_; nN = nN_; nwg = nM * nN; G = G_; c = c_; Lend = nwg; }
    __device__ __forceinline__ bool next(int i, Unit& u) const {
        const long L = (long)i * G + c; if (L >= Lend) return false;
        unit_map(L, nM, nN, u.pm, u.pn);
        u.a = A + (size_t)u.pm * a_pm + (size_t)u.pn * a_pn;
        u.b = B + (size_t)u.pn * b_pn;
        if (MOE) { const int e = __builtin_amdgcn_readfirstlane(__hip_atomic_load(blk_expert + u.pm, __ATOMIC_RELAXED, __HIP_MEMORY_SCOPE_AGENT)); u.b += (size_t)e * b_e; }
        return true;
    }
    __device__ __forceinline__ void a_ready(const Unit&) const {}
    __device__ __forceinline__ void done(const Unit&) const {}
};
struct TailOrder {
    int nM, nN, c, full, tail, s; size_t ksliceA, ksliceB;
    const char* A; const char* B; size_t a_pm, b_pn, b_e; const int* blk_expert;
    __device__ __forceinline__ bool next(int i, Unit& u) const {
        if (i > 0 || c >= tail * s) return false;
        const int t = c / s, sl = c % s; int pm, pn; unit_map((long)full + t, nM, nN, pm, pn);
        const int e = __builtin_amdgcn_readfirstlane(__hip_atomic_load(blk_expert + pm, __ATOMIC_RELAXED, __HIP_MEMORY_SCOPE_AGENT));
        u.pm = c; u.pn = 0; u.a = A + (size_t)pm * a_pm + (size_t)sl * ksliceA; u.b = B + (size_t)pn * b_pn + (size_t)e * b_e + (size_t)sl * ksliceB;
        return true;
    }
    __device__ __forceinline__ void a_ready(const Unit&) const {}
    __device__ __forceinline__ void done(const Unit&) const {}
};

__device__ __forceinline__ unsigned cvt_pk_bf16(float lo, float hi) { unsigned r; asm volatile("v_cvt_pk_bf16_f32 %0, %1, %2" : "=v"(r) : "v"(lo), "v"(hi)); return r; }
__device__ __forceinline__ float silu_f(float x) { return x * __builtin_amdgcn_rcpf(1.0f + __builtin_amdgcn_exp2f(-1.4426950408889634f * x)); }

struct EpiBf16 {
    static constexpr bool PERM = true, AFTER_DRAIN = false;
    bf16_t* O; int ldc; const float* scale;
    __device__ __forceinline__ void operator()(const f32x4 (&acc)[2][2][4][2], const Unit& u, int wr, int wc, int fr, int fq) const {
        const int row0 = u.pm * BM + wr * 64 + fr, col0 = u.pn * BM + wc * 32 + 8 * fq;
        f32x4 sv[2][2];
#pragma unroll
        for (int bj = 0; bj < 2; ++bj)
#pragma unroll
            for (int n = 0; n < 2; ++n) sv[bj][n] = scale ? *(const f32x4*)(scale + col0 + bj * HALF + 4 * n) : (f32x4){1.f, 1.f, 1.f, 1.f};
#pragma unroll
        for (int ai = 0; ai < 2; ++ai)
#pragma unroll
            for (int m = 0; m < 4; ++m) { bf16_t* rowp = O + (size_t)(row0 + ai * HALF + m * 16) * ldc + col0;
#pragma unroll
                for (int bj = 0; bj < 2; ++bj) { const f32x4 v0 = acc[ai][bj][m][0] * sv[bj][0], v1 = acc[ai][bj][m][1] * sv[bj][1];
                    u32x4 w; w.x = cvt_pk_bf16(v0[0], v0[1]); w.y = cvt_pk_bf16(v0[2], v0[3]); w.z = cvt_pk_bf16(v1[0], v1[1]); w.w = cvt_pk_bf16(v1[2], v1[3]);
                    *(u32x4*)(rowp + bj * HALF) = w; } }
    }
};
template <bool F32IN> struct EpiRes {
    static constexpr bool PERM = true, AFTER_DRAIN = false;
    const void* base; bf16_t* out; int ldc;
    __device__ __forceinline__ void operator()(const f32x4 (&acc)[2][2][4][2], const Unit& u, int wr, int wc, int fr, int fq) const {
        const int row0 = u.pm * BM + wr * 64 + fr, col0 = u.pn * BM + wc * 32 + 8 * fq;
        if constexpr (!F32IN) {
            u32x4 q[2][4][2];
#pragma unroll
            for (int ai = 0; ai < 2; ++ai)
#pragma unroll
                for (int m = 0; m < 4; ++m)
#pragma unroll
                    for (int bj = 0; bj < 2; ++bj) q[ai][m][bj] = *(const u32x4*)((const bf16_t*)base + (size_t)(row0 + ai * HALF + m * 16) * ldc + col0 + bj * HALF);
#pragma unroll
            for (int ai = 0; ai < 2; ++ai)
#pragma unroll
                for (int m = 0; m < 4; ++m)
#pragma unroll
                    for (int bj = 0; bj < 2; ++bj) { const u32x4 t = q[ai][m][bj];
                        const f32x4 v0 = (f32x4){__uint_as_float(t.x << 16), __uint_as_float(t.x & 0xffff0000u), __uint_as_float(t.y << 16), __uint_as_float(t.y & 0xffff0000u)} + acc[ai][bj][m][0];
                        const f32x4 v1 = (f32x4){__uint_as_float(t.z << 16), __uint_as_float(t.z & 0xffff0000u), __uint_as_float(t.w << 16), __uint_as_float(t.w & 0xffff0000u)} + acc[ai][bj][m][1];
                        u32x4 w; w.x = cvt_pk_bf16(v0[0], v0[1]); w.y = cvt_pk_bf16(v0[2], v0[3]); w.z = cvt_pk_bf16(v1[0], v1[1]); w.w = cvt_pk_bf16(v1[2], v1[3]);
                        *(u32x4*)(out + (size_t)(row0 + ai * HALF + m * 16) * ldc + col0 + bj * HALF) = w; }
        } else {
#pragma unroll
            for (int ai = 0; ai < 2; ++ai) {
                f32x4 b0[4][2], b1[4][2];
#pragma unroll
                for (int m = 0; m < 4; ++m)
#pragma unroll
                    for (int bj = 0; bj < 2; ++bj) { const float* bp = (const float*)base + (size_t)(row0 + ai * HALF + m * 16) * ldc + col0 + bj * HALF; b0[m][bj] = *(const f32x4*)bp; b1[m][bj] = *(const f32x4*)(bp + 4); }
#pragma unroll
                for (int m = 0; m < 4; ++m)
#pragma unroll
                    for (int bj = 0; bj < 2; ++bj) { const f32x4 v0 = b0[m][bj] + acc[ai][bj][m][0], v1 = b1[m][bj] + acc[ai][bj][m][1];
                        u32x4 w; w.x = cvt_pk_bf16(v0[0], v0[1]); w.y = cvt_pk_bf16(v0[2], v0[3]); w.z = cvt_pk_bf16(v1[0], v1[1]); w.w = cvt_pk_bf16(v1[2], v1[3]);
                        *(u32x4*)(out + (size_t)(row0 + ai * HALF + m * 16) * ldc + col0 + bj * HALF) = w; }
                asm volatile("" ::: "memory"); }
        }
    }
};
struct EpiPart {
    static constexpr bool PERM = false, AFTER_DRAIN = false;
    float* P;
    __device__ __forceinline__ void operator()(const f32x4 (&acc)[2][2][4][2], const Unit& u, int wr, int wc, int fr, int fq) const {
        float* base = P + (size_t)u.pm * 65536 + (size_t)(wr * 64 + fr) * 256 + wc * 32 + 4 * fq;
#pragma unroll
        for (int ai = 0; ai < 2; ++ai)
#pragma unroll
            for (int m = 0; m < 4; ++m)
#pragma unroll
                for (int bj = 0; bj < 2; ++bj)
#pragma unroll
                    for (int n = 0; n < 2; ++n) *(f32x4*)(base + (size_t)(ai * HALF + m * 16) * 256 + bj * HALF + n * 16) = acc[ai][bj][m][n];
    }
};
struct EpiSwiglu {
    static constexpr bool PERM = true, AFTER_DRAIN = false;
    bf16_t* O; int kt_per_panel;
    __device__ __forceinline__ void operator()(const f32x4 (&acc)[2][2][4][2], const Unit& u, int wr, int wc, int fr, int fq) const {
        const size_t rp = kt_per_panel > 0 ? (size_t)128 : (size_t)(-kt_per_panel);
        unsigned char* blk = kt_per_panel > 0 ? (unsigned char*)O + ((size_t)u.pm * kt_per_panel + u.pn * 2 + (wc >> 1)) * 32768 + (size_t)(wr * 64 + fr) * 128 + ((wc & 1) * 32 + 8 * fq) * 2
                                              : (unsigned char*)O + (size_t)(u.pm * BM + wr * 64 + fr) * rp + (u.pn * HALF + wc * 32 + 8 * fq) * 2;
#pragma unroll
        for (int ai = 0; ai < 2; ++ai)
#pragma unroll
            for (int m = 0; m < 4; ++m) { unsigned char* rowp = blk + (size_t)(ai * HALF + m * 16) * rp;
                const f32x4 g0 = acc[ai][0][m][0], g1 = acc[ai][0][m][1], u0 = acc[ai][1][m][0], u1 = acc[ai][1][m][1];
                u32x4 w; w.x = cvt_pk_bf16(silu_f(g0[0]) * u0[0], silu_f(g0[1]) * u0[1]); w.y = cvt_pk_bf16(silu_f(g0[2]) * u0[2], silu_f(g0[3]) * u0[3]);
                w.z = cvt_pk_bf16(silu_f(g1[0]) * u1[0], silu_f(g1[1]) * u1[1]); w.w = cvt_pk_bf16(silu_f(g1[2]) * u1[2], silu_f(g1[3]) * u1[3]);
                *(u32x4*)rowp = w; }
    }
};
struct EpiSwigluF8 {
    static constexpr bool PERM = true, AFTER_DRAIN = false;
    unsigned char* O; int kt_per_panel; float osc;
    __device__ __forceinline__ static float cl(float v) { return __builtin_fminf(__builtin_fmaxf(v, -448.f), 448.f); }
    __device__ __forceinline__ void operator()(const f32x4 (&acc)[2][2][4][2], const Unit& u, int wr, int wc, int fr, int fq) const {
        const size_t rp = kt_per_panel > 0 ? (size_t)128 : (size_t)(-kt_per_panel);
        unsigned char* blk = kt_per_panel > 0 ? O + ((size_t)u.pm * kt_per_panel + u.pn) * 32768 + (size_t)(wr * 64 + fr) * 128 + wc * 32 + 8 * fq
                                              : O + (size_t)(u.pm * BM + wr * 64 + fr) * rp + u.pn * HALF + wc * 32 + 8 * fq;
#pragma unroll
        for (int ai = 0; ai < 2; ++ai)
#pragma unroll
            for (int m = 0; m < 4; ++m) { unsigned char* rowp = blk + (size_t)(ai * HALF + m * 16) * rp;
                const f32x4 g0 = acc[ai][0][m][0], g1 = acc[ai][0][m][1], u0 = acc[ai][1][m][0], u1 = acc[ai][1][m][1];
                float v[8];
#pragma unroll
                for (int i = 0; i < 4; ++i) { v[i] = cl(silu_f(g0[i]) * u0[i] * osc); v[4 + i] = cl(silu_f(g1[i]) * u1[i] * osc); }
                int w0 = 0, w1 = 0;
                w0 = __builtin_amdgcn_cvt_pk_fp8_f32(v[0], v[1], w0, false); w0 = __builtin_amdgcn_cvt_pk_fp8_f32(v[2], v[3], w0, true);
                w1 = __builtin_amdgcn_cvt_pk_fp8_f32(v[4], v[5], w1, false); w1 = __builtin_amdgcn_cvt_pk_fp8_f32(v[6], v[7], w1, true);
                typedef int i32x2v __attribute__((ext_vector_type(2)));
                *(i32x2v*)rowp = (i32x2v){w0, w1}; }
    }
};

struct EpiSwigluF8S {
    static constexpr bool PERM = true, AFTER_DRAIN = false, STAGED = true;
    unsigned char* O; int kt_per_panel; float osc;
    __device__ __forceinline__ static float cl(float v) { return __builtin_fminf(__builtin_fmaxf(v, -448.f), 448.f); }
    __device__ __forceinline__ void staged(const f32x4 (&acc)[2][2][4][2], const Unit& u, int wr, int wc, int fr, int fq, PG8_LAS unsigned char* stg, int wid, int lane) const {
        constexpr int SP = 144;
        unsigned char* blk = O + ((size_t)u.pm * kt_per_panel + u.pn) * 32768;
        typedef int i32x2v __attribute__((ext_vector_type(2)));
#pragma unroll
        for (int ai = 0; ai < 2; ++ai) {
#pragma unroll
            for (int m = 0; m < 4; ++m) {
                const f32x4 g0 = acc[ai][0][m][0], g1 = acc[ai][0][m][1], u0 = acc[ai][1][m][0], u1 = acc[ai][1][m][1];
                float v[8];
#pragma unroll
                for (int i = 0; i < 4; ++i) { v[i] = cl(silu_f(g0[i]) * u0[i] * osc); v[4 + i] = cl(silu_f(g1[i]) * u1[i] * osc); }
                int w0 = 0, w1 = 0;
                w0 = __builtin_amdgcn_cvt_pk_fp8_f32(v[0], v[1], w0, false); w0 = __builtin_amdgcn_cvt_pk_fp8_f32(v[2], v[3], w0, true);
                w1 = __builtin_amdgcn_cvt_pk_fp8_f32(v[4], v[5], w1, false); w1 = __builtin_amdgcn_cvt_pk_fp8_f32(v[6], v[7], w1, true);
                *(PG8_LAS i32x2v*)(stg + (wr * 64 + m * 16 + fr) * SP + wc * 32 + 8 * fq) = (i32x2v){w0, w1}; }
            asm volatile("s_waitcnt lgkmcnt(0)" ::: "memory"); __builtin_amdgcn_s_barrier(); asm volatile("" ::: "memory");
            u32x4 t[2];
#pragma unroll
            for (int i = 0; i < 2; ++i) t[i] = *(const PG8_LAS u32x4*)(stg + (wid * 16 + (lane >> 3) + 8 * i) * SP + 16 * (lane & 7));
#pragma unroll
            for (int i = 0; i < 2; ++i) *(u32x4*)(blk + (size_t)(ai * HALF + wid * 16 + (lane >> 3) + 8 * i) * 128 + 16 * (lane & 7)) = t[i];
            asm volatile("s_waitcnt lgkmcnt(0)" ::: "memory"); __builtin_amdgcn_s_barrier(); asm volatile("" ::: "memory");
        }
    }
};
template <class E, class = void> struct epi_staged { static constexpr bool value = false; };
template <class E> struct epi_staged<E, decltype((void)E::STAGED)> { static constexpr bool value = E::STAGED; };

template <int N> __device__ __forceinline__ void waitv() { asm volatile("s_waitcnt vmcnt(%0)" :: "n"(N) : "memory"); }
template <class Epi, class Sched, bool ALIGN_EPI = false, bool SP2 = false, int FMT = 0, int KP = 0>
__device__ __forceinline__ void gemm_phase(PG8_LAS unsigned char* lds, const Gemm g, const Sched& S, const Epi& E) {
    const int tid = threadIdx.x, wid = __builtin_amdgcn_readfirstlane(tid >> 6), lane = tid & 63, wr = wid >> 2, wc = wid & 3, fr = lane & 15, fq = lane >> 4;
    const int K = g.K, nt = K / BK;
    constexpr bool FP8 = FMT != 0;
    constexpr bool BPF = SP2 && FMT == 2 && GEMM_BPF && KP == 0;
#define KP_RD if constexpr (!(KP & 1))
#define KP_ST if constexpr (!(KP & 2))
#define KP_MM if constexpr (!(KP & 4))
    constexpr int KM1 = ((GEMM_KM) >> (8 * FMT + 4)) & 15, KM2 = ((GEMM_KM) >> (8 * FMT)) & 15, GS1 = KM1 <= 1 ? 4 : 2, GS2 = KM2 <= 2 ? 3 : KM2 <= 3 ? 2 : 1;
    int f8sc = g.sB; if constexpr (FP8) { asm volatile("" : "+v"(f8sc)); }
    unsigned voffA[2], voffB[2];
#pragma unroll
    for (int i = 0; i < 2; ++i) { int R, C; stage_rc(tid * 16 + i * 8192, R, C); const int Rb = Epi::PERM ? ((R & ~31) + perm32(R & 31)) : R;
        voffA[i] = (unsigned)(R * g.lda + C) * 2u; voffB[i] = (unsigned)(Rb * g.ldb + C) * 2u; }
    const size_t kstepA = (size_t)g.kstepA, kstepB = (size_t)g.kstepB;
    const size_t hstepA = (size_t)HALF * g.lda * 2, hstepB = (size_t)HALF * g.ldb * 2;
    const unsigned ldsbase = __builtin_amdgcn_readfirstlane((unsigned)(size_t)lds + (unsigned)wid * 1024u);
    const unsigned ldsw = (unsigned)wid * 1024u;
    const int aoff = lds_byte(wr * 64 + fr, fq * 8), boff = lds_byte(wc * 32 + fr, fq * 8);
#define PG8_SA(b, h) (((b) * 2 + (h)) * HTB)
#define PG8_SB(b, h) ((4 + (b) * 2 + (h)) * HTB)
#define PG8_STAGE(bufoff, gbase, voff) do { _Pragma("unroll") for (int _i = 0; _i < 2; ++_i) \
        __builtin_amdgcn_global_load_lds((const unsigned*)((const char*)(gbase) + (voff)[_i]), (PG8_LAS unsigned*)(lds + (bufoff) + ldsw + _i * 8192), 16, 0, 0); } while (0)
#define PG8_LDA(dst, b, h) do { _Pragma("unroll") for (int m = 0; m < 4; ++m) { dst[m][0] = *(const PG8_LAS bf16x8*)(lds + PG8_SA(b, h) + aoff + m * 2048); \
        if constexpr (FMT == 2) { dst##H[m] = *(const PG8_LAS i32x2*)(lds + PG8_SA(b, h) + aoff + m * 2048 + 1024); asm volatile("" ::: "memory"); } else dst[m][1] = *(const PG8_LAS bf16x8*)(lds + PG8_SA(b, h) + aoff + m * 2048 + 1024); } } while (0)
#define PG8_LDB(dst, b, h) do { _Pragma("unroll") for (int n = 0; n < 2; ++n) { dst[n][0] = *(const PG8_LAS bf16x8*)(lds + PG8_SB(b, h) + boff + n * 2048); \
        if constexpr (FMT == 2) { dst##H[n] = *(const PG8_LAS i32x2*)(lds + PG8_SB(b, h) + boff + n * 2048 + 1024); asm volatile("" ::: "memory"); } else dst[n][1] = *(const PG8_LAS bf16x8*)(lds + PG8_SB(b, h) + boff + n * 2048 + 1024); } } while (0)
#define PG8_STAGE1(bufoff, gbase, voff, i) do { if constexpr ((GEMM_SADDR >> FMT) & 1) { \
        asm volatile("s_mov_b32 m0, %0\n\ts_nop 0\n\tglobal_load_lds_dwordx4 %1, %2" :: "s"(ldsbase + (unsigned)((bufoff) + (i) * 8192)), "v"((voff)[i]), "s"((const char*)(gbase)) : "m0", "memory"); } \
        else __builtin_amdgcn_global_load_lds((const unsigned*)((const char*)(gbase) + (voff)[i]), (PG8_LAS unsigned*)(lds + (bufoff) + ldsw + (i) * 8192), 16, 0, 0); } while (0)
#define PG8_MMA1(ai, bj, At, Bt, m) do { _Pragma("unroll") for (int n = 0; n < 2; ++n) { \
        if constexpr (FMT == 2) { const i32x4 w0_ = __builtin_bit_cast(i32x4, Bt[n][0]), a0_ = __builtin_bit_cast(i32x4, At[m][0]); \
            const i32x6 wf_ = (i32x6){w0_[0], w0_[1], w0_[2], w0_[3], Bt##H[n][0], Bt##H[n][1]}, af_ = (i32x6){a0_[0], a0_[1], a0_[2], a0_[3], At##H[m][0], At##H[m][1]}; \
            asm volatile("v_mfma_scale_f32_16x16x128_f8f6f4 %0, %1, %2, %0, %3, %3 op_sel:[0,1,0] op_sel_hi:[0,0,0] cbsz:2 blgp:2" : "+v"(acc[ai][bj][m][n]) : "v"(wf_), "v"(af_), "v"(f8sc)); } \
        else if constexpr (FMT == 1) { const i32x8 wf_ = __builtin_shufflevector(__builtin_bit_cast(i32x4, Bt[n][0]), __builtin_bit_cast(i32x4, Bt[n][1]), 0, 1, 2, 3, 4, 5, 6, 7); \
            const i32x8 af_ = __builtin_shufflevector(__builtin_bit_cast(i32x4, At[m][0]), __builtin_bit_cast(i32x4, At[m][1]), 0, 1, 2, 3, 4, 5, 6, 7); \
            asm volatile("v_mfma_scale_f32_16x16x128_f8f6f4 %0, %1, %2, %0, %3, %3 op_sel:[0,1,0] op_sel_hi:[0,0,0]" : "+v"(acc[ai][bj][m][n]) : "v"(wf_), "v"(af_), "v"(f8sc)); } \
        else { _Pragma("unroll") for (int k = 0; k < 2; ++k) acc[ai][bj][m][n] = __builtin_amdgcn_mfma_f32_16x16x32_bf16(Bt[n][k], At[m][k], acc[ai][bj][m][n], 0, 0, 0); } } } while (0)
#define PG8_MMA(ai, bj, At, Bt) do { __builtin_amdgcn_s_setprio(1); _Pragma("unroll") for (int m = 0; m < 4; ++m) PG8_MMA1(ai, bj, At, Bt, m); \
        __builtin_amdgcn_s_setprio(0); } while (0)
#define PG8_ST(bufoff, gbase, voff, i) do { PG8_SCHED; PG8_STAGE1(bufoff, gbase, voff, i); PG8_SCHED; } while (0)
#define PG8_PIECE2(j, bb, pb, pa) do { KP_ST if ((j) < 2) PG8_STAGE1(PG8_SB(bb, 0), pb, voffB, (j) & 1); else if ((j) < 4) PG8_STAGE1(PG8_SB(bb, 1), (pb) + hstepB, voffB, (j) & 1); else PG8_STAGE1(PG8_SA(bb, 0), pa, voffA, (j) & 1); } while (0)
#define PG8_GROUP(ai, g) do { KP_MM if ((g) < 4) PG8_MMA1(ai, 0, At, B0, (g) & 3); else PG8_MMA1(ai, 1, At, B1, (g) & 3); } while (0)
#define PG8_PRIO1 do { if constexpr (!(FMT == 2 && GEMM_FP6_NOPRIO)) __builtin_amdgcn_s_setprio(1); } while (0)
#define PG8_SP1X(bb, sb, ps) do { \
        _Pragma("unroll") for (int j_ = 0; j_ < 2 - KM1; ++j_) KP_ST PG8_STAGE1(PG8_SA(sb, 1), ps, voffA, j_); \
        KP_RD { PG8_LDB(B0, bb, 0); PG8_LDB(B1, bb, 1); PG8_SCHED; PG8_LDA(At, bb, 0); } \
        waitv<8 - KM1>(); PG8_WAIT_L(0); PG8_BAR; PG8_PRIO1; \
        _Pragma("unroll") for (int g_ = 0; g_ < 8; ++g_) { PG8_GROUP(0, g_); \
            if (g_ % GS1 == 0 && g_ / GS1 < KM1) { PG8_SCHED; KP_ST PG8_STAGE1(PG8_SA(sb, 1), ps, voffA, 2 - KM1 + g_ / GS1); PG8_SCHED; } } \
        __builtin_amdgcn_s_setprio(0); PG8_BAR; PG8_SCHED; } while (0)
#define PG8_SP2X(bb, pb, pa) do { \
        _Pragma("unroll") for (int j_ = 0; j_ < 6 - KM2; ++j_) PG8_PIECE2(j_, bb, pb, pa); \
        KP_RD { PG8_LDA(At, bb, 1); } \
        waitv<8 - KM2>(); PG8_WAIT_L(0); PG8_BAR; PG8_PRIO1; \
        _Pragma("unroll") for (int g_ = 0; g_ < 8; ++g_) { PG8_GROUP(1, g_); \
            if (g_ % GS2 == 0 && g_ / GS2 < KM2) { PG8_SCHED; PG8_PIECE2(6 - KM2 + g_ / GS2, bb, pb, pa); PG8_SCHED; } } \
        __builtin_amdgcn_s_setprio(0); PG8_BAR; PG8_SCHED; } while (0)
#define PG8_SP1B(bb, sb, ps, Bc) do { \
        _Pragma("unroll") for (int j_ = 0; j_ < 2 - KM1; ++j_) PG8_STAGE1(PG8_SA(sb, 1), ps, voffA, j_); \
        PG8_LDB(B1, bb, 1); PG8_SCHED; PG8_LDA(At, bb, 0); \
        waitv<6 - KM1>(); PG8_WAIT_L(0); PG8_BAR; __builtin_amdgcn_s_setprio(1); \
        _Pragma("unroll") for (int g_ = 0; g_ < 8; ++g_) { if (g_ < 4) PG8_MMA1(0, 0, At, Bc, g_ & 3); else PG8_MMA1(0, 1, At, B1, g_ & 3); \
            if (g_ % GS1 == 0 && g_ / GS1 < KM1) { PG8_SCHED; PG8_STAGE1(PG8_SA(sb, 1), ps, voffA, 2 - KM1 + g_ / GS1); PG8_SCHED; } } \
        __builtin_amdgcn_s_setprio(0); PG8_BAR; PG8_SCHED; } while (0)
#define PG8_SP2B(bb, pb, pa, Bc, Bn) do { \
        _Pragma("unroll") for (int j_ = 0; j_ < 6 - KM2; ++j_) PG8_PIECE2(j_, bb, pb, pa); \
        PG8_LDA(At, bb, 1); PG8_SCHED; PG8_LDB(Bn, 1 - (bb), 0); \
        waitv<8 - KM2>(); PG8_WAIT_L(0); PG8_BAR; __builtin_amdgcn_s_setprio(1); \
        _Pragma("unroll") for (int g_ = 0; g_ < 8; ++g_) { if (g_ < 4) PG8_MMA1(1, 0, At, Bc, g_ & 3); else PG8_MMA1(1, 1, At, B1, g_ & 3); \
            if (g_ % GS2 == 0 && g_ / GS2 < KM2) { PG8_SCHED; PG8_PIECE2(6 - KM2 + g_ / GS2, bb, pb, pa); PG8_SCHED; } } \
        __builtin_amdgcn_s_setprio(0); PG8_BAR; PG8_SCHED; } while (0)
#define PG8_WAIT_V(n) asm volatile("s_waitcnt vmcnt(" #n ")" ::: "memory")
#define PG8_WAIT_L(n) asm volatile("s_waitcnt lgkmcnt(" #n ")" ::: "memory")
#define PG8_BAR __builtin_amdgcn_s_barrier()
#define PG8_SCHED __builtin_amdgcn_sched_barrier(0)
    Unit cur, nxt; int ui = 0;
    if (!S.next(0, cur)) return;
    f32x4 acc[2][2][4][2];
#pragma unroll
    for (int a = 0; a < 2; ++a)
#pragma unroll
        for (int b = 0; b < 2; ++b)
#pragma unroll
            for (int m = 0; m < 4; ++m)
#pragma unroll
                for (int n = 0; n < 2; ++n) acc[a][b][m][n] = (f32x4){0.f, 0.f, 0.f, 0.f};
    bf16x8 At[4][2] = {}, B0[2][2] = {}, B1[2][2] = {}, B2[2][2] = {}; i32x2 AtH[4] = {}, B0H[2] = {}, B1H[2] = {}, B2H[2] = {};
    const char* cA = cur.a; const char* cB = cur.b;
    S.a_ready(cur);
    if constexpr (SP2) {
        PG8_STAGE(PG8_SB(0, 0), cB, voffB); PG8_STAGE(PG8_SB(0, 1), cB + hstepB, voffB); PG8_STAGE(PG8_SA(0, 0), cA, voffA); PG8_STAGE(PG8_SA(0, 1), cA + hstepA, voffA);
        if (wr == 1) PG8_BAR;
        PG8_WAIT_V(2); PG8_BAR;
        PG8_STAGE(PG8_SB(1, 0), cB + kstepB, voffB); PG8_STAGE(PG8_SA(1, 0), cA + kstepA, voffA); PG8_STAGE(PG8_SB(1, 1), cB + hstepB + kstepB, voffB);
        PG8_WAIT_V(6); PG8_BAR;
    } else {
        PG8_STAGE(PG8_SB(0, 0), cB, voffB); PG8_STAGE(PG8_SA(0, 0), cA, voffA); PG8_STAGE(PG8_SB(0, 1), cB + hstepB, voffB); PG8_STAGE(PG8_SA(0, 1), cA + hstepA, voffA);
        if (wr == 1) PG8_BAR;
        PG8_WAIT_V(4); PG8_BAR;
        PG8_STAGE(PG8_SB(1, 0), cB + kstepB, voffB); PG8_STAGE(PG8_SA(1, 0), cA + kstepA, voffA); PG8_STAGE(PG8_SB(1, 1), cB + hstepB + kstepB, voffB);
        PG8_WAIT_V(6); PG8_BAR;
    }
    if constexpr (BPF) { PG8_LDB(B0, 0, 0); }
    for (;;) {
        const bool has_next = S.next(ui + 1, nxt);
        const char* nA = has_next ? nxt.a : cA; const char* nB = has_next ? nxt.b : cB;
        for (int t = 0; t < nt; t += 2) {
            const bool last = (t == nt - 2);
            const char* a1 = cA + (size_t)(t + 1) * kstepA;
            const char* a2 = last ? nA : cA + (size_t)(t + 2) * kstepA; const char* b2 = last ? nB : cB + (size_t)(t + 2) * kstepB;
            const char* a3 = a2 + kstepA; const char* b3 = b2 + kstepB;
            if (last && has_next) S.a_ready(nxt);
            if constexpr (BPF) {
            PG8_SP1B(0, 1, a1 + hstepA, B0); PG8_SP2B(0, b2, a2, B0, B2); PG8_SP1B(1, 0, a2 + hstepA, B2); PG8_SP2B(1, b3, a3, B2, B0);
            } else if constexpr (SP2 && (KM1 | KM2) != 0) {
            PG8_SP1X(0, 1, a1 + hstepA); PG8_SP2X(0, b2, a2); PG8_SP1X(1, 0, a2 + hstepA); PG8_SP2X(1, b3, a3);
            } else if constexpr (SP2) {
            PG8_STAGE(PG8_SA(1, 1), a1 + hstepA, voffA); PG8_LDB(B0, 0, 0); PG8_LDB(B1, 0, 1); PG8_SCHED; PG8_LDA(At, 0, 0);
            PG8_WAIT_V(8); PG8_WAIT_L(0); PG8_BAR; PG8_MMA(0, 0, At, B0); PG8_MMA(0, 1, At, B1); PG8_BAR; PG8_SCHED;
            PG8_STAGE(PG8_SB(0, 0), b2, voffB); PG8_STAGE(PG8_SB(0, 1), b2 + hstepB, voffB); PG8_STAGE(PG8_SA(0, 0), a2, voffA); PG8_LDA(At, 0, 1);
            PG8_WAIT_V(8); PG8_WAIT_L(0); PG8_BAR; PG8_MMA(1, 0, At, B0); PG8_MMA(1, 1, At, B1); PG8_BAR; PG8_SCHED;
            PG8_STAGE(PG8_SA(0, 1), a2 + hstepA, voffA); PG8_LDB(B0, 1, 0); PG8_LDB(B1, 1, 1); PG8_SCHED; PG8_LDA(At, 1, 0);
            PG8_WAIT_V(8); PG8_WAIT_L(0); PG8_BAR; PG8_MMA(0, 0, At, B0); PG8_MMA(0, 1, At, B1); PG8_BAR; PG8_SCHED;
            PG8_STAGE(PG8_SB(1, 0), b3, voffB); PG8_STAGE(PG8_SB(1, 1), b3 + hstepB, voffB); PG8_STAGE(PG8_SA(1, 0), a3, voffA); PG8_LDA(At, 1, 1);
            PG8_WAIT_V(8); PG8_WAIT_L(0); PG8_BAR; PG8_MMA(1, 0, At, B0); PG8_MMA(1, 1, At, B1); PG8_BAR; PG8_SCHED;
            } else {
            PG8_LDB(B0, 0, 0); PG8_SCHED; PG8_LDA(At, 0, 0); PG8_STAGE(PG8_SA(1, 1), a1 + hstepA, voffA);
            PG8_WAIT_L(8); PG8_BAR; PG8_WAIT_L(0); PG8_MMA(0, 0, At, B0); PG8_BAR; PG8_SCHED;
            PG8_LDB(B1, 0, 1); PG8_STAGE(PG8_SB(0, 0), b2, voffB);
            PG8_BAR; PG8_WAIT_L(0); PG8_MMA(0, 1, At, B1); PG8_BAR;
            PG8_LDA(At, 0, 1); PG8_STAGE(PG8_SA(0, 0), a2, voffA);
            PG8_BAR; PG8_WAIT_L(0); PG8_MMA(1, 0, At, B0); PG8_BAR; PG8_SCHED;
            PG8_STAGE(PG8_SB(0, 1), b2 + hstepB, voffB);
            PG8_WAIT_V(6); PG8_BAR; PG8_MMA(1, 1, At, B1); PG8_BAR;
            PG8_LDB(B0, 1, 0); PG8_SCHED; PG8_LDA(At, 1, 0); PG8_STAGE(PG8_SA(0, 1), a2 + hstepA, voffA);
            PG8_WAIT_L(8); PG8_BAR; PG8_WAIT_L(0); PG8_MMA(0, 0, At, B0); PG8_BAR; PG8_SCHED;
            PG8_LDB(B1, 1, 1); PG8_STAGE(PG8_SB(1, 0), b3, voffB);
            PG8_BAR; PG8_WAIT_L(0); PG8_MMA(0, 1, At, B1); PG8_BAR;
            PG8_LDA(At, 1, 1); PG8_STAGE(PG8_SA(1, 0), a3, voffA);
            PG8_BAR; PG8_WAIT_L(0); PG8_MMA(1, 0, At, B0); PG8_BAR; PG8_SCHED;
            PG8_STAGE(PG8_SB(1, 1), b3 + hstepB, voffB);
            PG8_WAIT_V(6); PG8_BAR; PG8_MMA(1, 1, At, B1); PG8_BAR;
            }
        }
        if constexpr (ALIGN_EPI) { if (wr == 0) PG8_BAR; }
        if constexpr (FP8) { asm volatile("s_nop 15\n\ts_nop 15" ::: "memory"); }
        if constexpr (epi_staged<Epi>::value) { static_assert(ALIGN_EPI, "a staged epilogue uses workgroup barriers: both halves must run it together"); E.staged(acc, cur, wr, wc, fr, fq, lds + STAGE_BYTES, wid, lane); S.done(cur); }
        else if constexpr (!Epi::AFTER_DRAIN) { E(acc, cur, wr, wc, fr, fq); S.done(cur); }
        if (!has_next) break;
#pragma unroll
        for (int a = 0; a < 2; ++a)
#pragma unroll
            for (int b = 0; b < 2; ++b)
#pragma unroll
                for (int m = 0; m < 4; ++m)
#pragma unroll
                    for (int n = 0; n < 2; ++n) acc[a][b][m][n] = (f32x4){0.f, 0.f, 0.f, 0.f};
        cur = nxt; cA = nA; cB = nB; ++ui;
        if constexpr (ALIGN_EPI) { if (wr == 1) PG8_BAR; }
    }
    PG8_WAIT_V(0);
    if constexpr (!ALIGN_EPI) { if (wr == 0) PG8_BAR; }
    PG8_BAR;
    if constexpr (Epi::AFTER_DRAIN) { E.fused(acc, cur, wr, wc, fr, fq, lds, wid, lane); S.done(cur); }
#undef PG8_SA
#undef PG8_SB
#undef PG8_STAGE
#undef PG8_LDA
#undef PG8_LDB
#undef PG8_MMA
#undef PG8_MMA1
#undef PG8_STAGE1
#undef PG8_ST
#undef KP_RD
#undef KP_ST
#undef KP_MM
#undef PG8_PIECE2
#undef PG8_GROUP
#undef PG8_SP1X
#undef PG8_SP2X
#undef PG8_PRIO1
#undef PG8_SP1B
#undef PG8_SP2B
#undef PG8_WAIT_V
#undef PG8_WAIT_L
#undef PG8_BAR
#undef PG8_SCHED
}}
namespace fz {
#define LAS __attribute__((address_space(3)))
typedef unsigned short bf16_t;
typedef short bf16x8 __attribute__((ext_vector_type(8)));
typedef float f32x4 __attribute__((ext_vector_type(4)));
typedef float f32x2 __attribute__((ext_vector_type(2)));
typedef unsigned u32x4 __attribute__((ext_vector_type(4)));
typedef unsigned u32x2 __attribute__((ext_vector_type(2)));
typedef unsigned u32x6 __attribute__((ext_vector_type(6)));
typedef float f32x16 __attribute__((ext_vector_type(16)));
constexpr int NTHR = 512;
constexpr int LDS_BYTES = 163840, MISC_OFF = LDS_BYTES - 256;

constexpr size_t MiB = 1u << 20;
constexpr size_t WS_CTL = 0, CTL_ZERO_BYTES = 1 * MiB;
constexpr size_t WS_WIN = 1 * MiB;
constexpr size_t WS_WPOOL = WS_WIN + 32 * MiB;
constexpr size_t WS_WOUT = WS_WPOOL + 1 * MiB;
constexpr size_t WS_WGU = WS_WOUT + 16 * MiB;
constexpr size_t WS_WD = WS_WGU + 44 * MiB;
constexpr size_t WS_EWGU = WS_WD + 22 * MiB;
constexpr size_t WS_EWD = WS_EWGU + 448 * MiB;
constexpr size_t WS_XS = WS_EWD + 224 * MiB;
constexpr size_t WS_H = WS_XS + 128 * MiB;
constexpr size_t WS_GLR = WS_H + 65 * MiB;
constexpr size_t WS_ROUTE = WS_GLR + 1 * MiB;
constexpr size_t WS_U = WS_ROUTE + 2 * MiB;
constexpr size_t WS_Z = WS_U;
constexpr size_t WS_DP = WS_Z + 128 * MiB;
constexpr size_t WS_MIX = WS_DP + 32 * MiB;
constexpr size_t WS_CS = WS_MIX + 64 * MiB;
constexpr size_t WS_SP = WS_CS + 128 * MiB;
constexpr size_t WS_DEC = WS_SP + 64 * MiB;
constexpr size_t WS_ACT = WS_U;
constexpr size_t WS_HS = WS_U;
constexpr size_t WS_ACT2 = WS_HS + 136 * MiB;
constexpr size_t WS_Y = WS_ACT2 + 476 * MiB;
constexpr size_t WS_PART = WS_ACT2 + 240 * MiB;
constexpr size_t WS_END = WS_Y + 136 * MiB;
static_assert(WS_END <= 1792 * MiB, "workspace map");
static_assert(WS_DEC + 1 * MiB <= WS_END, "mixer view inside U");
constexpr size_t RT_TOPI = 0, RT_TOPW = 128 * 1024, RT_TOKSLOT = 256 * 1024, RT_HIST = 384 * 1024, RT_BLKE = 400 * 1024, RT_NRB = 404 * 1024;

constexpr int CW_BAR = 4096;

constexpr int PH_PRO = 0, PH_PER_LAYER = 10, NPH = 1 + 2 * PH_PER_LAYER;
constexpr int PK_INPROJ = 0, PK_PRE = 1, PK_POOLSCAN = 2, PK_GLAOUT = 3, PK_OUTPROJ = 4, PK_NORM2 = 5, PK_ASSIGN = 6, PK_UP = 7, PK_DOWN = 8, PK_TAIL = 9;

#define VM_WAIT() asm volatile("s_waitcnt vmcnt(0)" ::: "memory")
#define LDS_WAIT() asm volatile("s_waitcnt lgkmcnt(0)" ::: "memory")
#define RLX_AGENT __ATOMIC_RELAXED, __HIP_MEMORY_SCOPE_AGENT

__device__ __forceinline__ unsigned pk_bf16(float lo, float hi) { unsigned r; asm volatile("v_cvt_pk_bf16_f32 %0, %1, %2" : "=v"(r) : "v"(lo), "v"(hi)); return r; }
__device__ __forceinline__ float bf_lo(unsigned w) { return __uint_as_float(w << 16); }
__device__ __forceinline__ float bf_hi(unsigned w) { return __uint_as_float(w & 0xffff0000u); }
__device__ __forceinline__ float bf2f(bf16_t b) { return __uint_as_float(((unsigned)b) << 16); }
__device__ __forceinline__ bf16_t f2bf(float f) { return (bf16_t)(pk_bf16(f, 0.f) & 0xffffu); }
__device__ __forceinline__ float wave_sum(float v) {
#pragma unroll
    for (int o = 1; o < 64; o <<= 1) v += __shfl_xor(v, o);
    return v;
}
__device__ __forceinline__ float silu_f(float x) { return x * __builtin_amdgcn_rcpf(1.0f + __builtin_amdgcn_exp2f(-1.4426950408889634f * x)); }
__device__ __forceinline__ bf16x8 mk8(u32x2 lo, u32x2 hi) { u32x4 t; t.x = lo.x; t.y = lo.y; t.z = hi.x; t.w = hi.y; return __builtin_bit_cast(bf16x8, t); }
__device__ __forceinline__ bf16x8 tr_frag(unsigned a0, unsigned a1) {
    u32x2 lo, hi;
    asm volatile("ds_read_b64_tr_b16 %0, %2\n\tds_read_b64_tr_b16 %1, %3\n\ts_waitcnt lgkmcnt(0)" : "=&v"(lo), "=&v"(hi) : "v"(a0), "v"(a1) : "memory");
    return mk8(lo, hi);
}
__device__ __forceinline__ void moe_tail_split(int nrb, int G, int& full, int& tail, int& s) {
    const int nwg = nrb * 8; full = (nwg / G) * G; tail = nwg - full;
    s = tail == 0 ? 0 : (tail * 7 <= G ? 7 : (tail * 4 <= G ? 4 : (tail * 2 <= G ? 2 : 0)));
    if (s == 0) { full = nwg; tail = 0; }
}
__device__ __forceinline__ f32x4 mma16(bf16x8 a, bf16x8 b, f32x4 c) { return __builtin_amdgcn_mfma_f32_16x16x32_bf16(a, b, c, 0, 0, 0); }

#define XB_TMO      128
#define XB_XCNT(j)  (256  + 64 * (j))
#define XB_XSUB(j)  (1280 + 64 * (j))
#define XB_XGEN(j)  (2304 + 64 * (j))
#define XB_TOP      3328
#define XB_TOPGEN   3392
#define XCD_BAR_WORDS 3456
#define XB_SPIN_CAP (1u << 18)
__device__ __forceinline__ unsigned xb_ld(unsigned* p)              { return __hip_atomic_load(p, __ATOMIC_RELAXED, __HIP_MEMORY_SCOPE_AGENT); }
__device__ __forceinline__ unsigned xb_add(unsigned* p, unsigned v) { return __hip_atomic_fetch_add(p, v, __ATOMIC_RELAXED, __HIP_MEMORY_SCOPE_AGENT); }
__device__ __forceinline__ unsigned xb_xcc_id() { return (unsigned)__builtin_amdgcn_s_getreg((3 << 11) | 20) & 0xFu; }
#define XB_SPIN(cond, bar) do { unsigned _sp = 0; while (cond) { __builtin_amdgcn_s_sleep(1); \
    if ((++_sp & 255u) == 0u) { if (xb_ld(&(bar)[XB_TMO])) break; if (_sp > XB_SPIN_CAP) { atomicAdd(&(bar)[XB_TMO], 1u); break; } } } } while (0)
struct XcdBarrier { unsigned* bar; unsigned x; volatile LAS unsigned* st; };
__device__ __forceinline__ XcdBarrier xcd_barrier_post(unsigned* bar, volatile LAS unsigned* st) {
    XcdBarrier b; b.bar = bar; b.x = xb_xcc_id(); b.st = st;
    if (threadIdx.x == 0) (void)xb_add(&bar[XB_XCNT(b.x)], 1u);
    return b;
}
__device__ __forceinline__ void xcd_barrier_complete(unsigned* bar, unsigned x, unsigned& nloc, unsigned& nx) {
    const unsigned G = gridDim.x * gridDim.y * gridDim.z;
    unsigned sum, cnt, mine, sp = 0u;
    for (;;) {
        sum = 0u; cnt = 0u; mine = 0u;
#pragma unroll
        for (unsigned j = 0; j < 16; ++j) { const unsigned c = xb_ld(&bar[XB_XCNT(j)]); sum += c; cnt += (c > 0u) ? 1u : 0u; mine = (j == x) ? c : mine; }
        if (sum == G) break;
        __builtin_amdgcn_s_sleep(1);
        if ((++sp & 255u) == 0u) { if (xb_ld(&bar[XB_TMO])) break; if (sp > XB_SPIN_CAP) { atomicAdd(&bar[XB_TMO], 1u); break; } }
    }
    nloc = mine > 0u ? mine : 1u; nx = cnt > 0u ? cnt : 1u;
}
__device__ __forceinline__ void xcd_barrier(const XcdBarrier& b) {
    asm volatile("s_waitcnt vmcnt(0)" ::: "memory");
    __syncthreads();
    if (threadIdx.x == 0) {
        unsigned* bar = b.bar;
        __builtin_amdgcn_s_waitcnt(0);
        unsigned nloc = b.st[0], nx = b.st[1];
        if (nloc == 0u) { xcd_barrier_complete(bar, b.x, nloc, nx); b.st[0] = nloc; b.st[1] = nx; }
        const unsigned old = xb_add(&bar[XB_XSUB(b.x)], 1u);
        const unsigned gen = old / nloc;
        if (old + 1u == (gen + 1u) * nloc) {
            __builtin_amdgcn_fence(__ATOMIC_RELEASE, "agent");
            asm volatile("s_waitcnt vmcnt(0)" ::: "memory");
            const unsigned og = xb_add(&bar[XB_TOP], 1u);
            const unsigned tg = og / nx;
            if (og + 1u == (tg + 1u) * nx) xb_add(&bar[XB_TOPGEN], 1u);
            else XB_SPIN(xb_ld(&bar[XB_TOPGEN]) == tg, bar);
            __builtin_amdgcn_fence(__ATOMIC_ACQUIRE, "agent");
            xb_add(&bar[XB_XGEN(b.x)], 1u);
            asm volatile("s_waitcnt vmcnt(0)" ::: "memory");
        } else {
            XB_SPIN(xb_ld(&bar[XB_XGEN(b.x)]) == gen, bar);
            __builtin_amdgcn_fence(__ATOMIC_ACQUIRE, "agent");
            asm volatile("s_waitcnt vmcnt(0)" ::: "memory");
        }
    }
    __syncthreads();
}

struct CvtJob { const float* src; int ld_src; int k0; int n0; unsigned char* dstb; int dpitch; float f8scale; int fmt6; };
__device__ __forceinline__ void cvt_load(const CvtJob& j, f32x4 (&v)[16], int lane) {
    if (j.f8scale != 0.f) { const int kr = lane >> 3, nq = lane & 7;
#pragma unroll
        for (int i = 0; i < 16; ++i) v[i] = *(const f32x4*)(j.src + (size_t)(j.k0 + 8 * i + kr) * j.ld_src + j.n0 + 4 * nq);
    } else { const int kr = lane >> 4, nq = lane & 15;
#pragma unroll
        for (int i = 0; i < 16; ++i) v[i] = *(const f32x4*)(j.src + (size_t)(j.k0 + 4 * i + kr) * j.ld_src + j.n0 + 4 * nq); }
}
__device__ __forceinline__ float f8cl(float v) { return __builtin_fminf(__builtin_fmaxf(v, -448.f), 448.f); }
__device__ __forceinline__ void cvt_finish(const CvtJob& j, const f32x4 (&v)[16], LAS float* scr, int lane) {
    const int nlo = lane & 7, kq = lane >> 3;
    if (j.f8scale != 0.f) { const int kr = lane >> 3, nq = lane & 7;
#pragma unroll
        for (int i = 0; i < 16; ++i) { LAS float* w = scr + (8 * i + kr) * 33 + 4 * nq; w[0] = v[i].x; w[1] = v[i].y; w[2] = v[i].z; w[3] = v[i].w; }
        LDS_WAIT(); asm volatile("" ::: "memory");
        const float sc = j.f8scale;
        if (j.fmt6) {
            const int n = lane & 31;
#pragma unroll
            for (int gi = 0; gi < 2; ++gi) { const int g = 2 * (lane >> 5) + gi; const LAS float* s = scr + (32 * g) * 33 + n; f32x16 lo, hi;
#pragma unroll
                for (int i = 0; i < 16; ++i) { lo[i] = __builtin_fminf(__builtin_fmaxf(s[i * 33] * sc, -7.5f), 7.5f); hi[i] = __builtin_fminf(__builtin_fmaxf(s[(16 + i) * 33] * sc, -7.5f), 7.5f); }
                const u32x6 w = __builtin_amdgcn_cvt_scalef32_2xpk16_fp6_f32(lo, hi, 1.0f);
                unsigned char* d = j.dstb + (size_t)n * j.dpitch + 16 * g;
                *(u32x4*)d = (u32x4){w[0], w[1], w[2], w[3]}; *(u32x4*)(d + 64) = (u32x4){w[4], w[5], 0u, 0u};     }
        } else
#pragma unroll
        for (int jn = 0; jn < 4; ++jn) { const int n = 8 * jn + nlo; const LAS float* s = scr + (16 * kq) * 33 + n; int w[4];
#pragma unroll
            for (int d = 0; d < 4; ++d) { int x = 0;
                x = __builtin_amdgcn_cvt_pk_fp8_f32(f8cl(s[(4 * d + 0) * 33] * sc), f8cl(s[(4 * d + 1) * 33] * sc), x, false);
                x = __builtin_amdgcn_cvt_pk_fp8_f32(f8cl(s[(4 * d + 2) * 33] * sc), f8cl(s[(4 * d + 3) * 33] * sc), x, true); w[d] = x; }
            *(u32x4*)(j.dstb + (size_t)n * j.dpitch + 16 * kq) = (u32x4){(unsigned)w[0], (unsigned)w[1], (unsigned)w[2], (unsigned)w[3]}; }
    } else { const int kr = lane >> 4, nq = lane & 15;
#pragma unroll
        for (int i = 0; i < 16; ++i) { LAS float* w = scr + (4 * i + kr) * 65 + 4 * nq; w[0] = v[i].x; w[1] = v[i].y; w[2] = v[i].z; w[3] = v[i].w; }
        LDS_WAIT(); asm volatile("" ::: "memory");
#pragma unroll
        for (int jn = 0; jn < 8; ++jn) { const int n = 8 * jn + nlo; const LAS float* s = scr + (8 * kq) * 65 + n;
            u32x4 o; o.x = pk_bf16(s[0 * 65], s[1 * 65]); o.y = pk_bf16(s[2 * 65], s[3 * 65]); o.z = pk_bf16(s[4 * 65], s[5 * 65]); o.w = pk_bf16(s[6 * 65], s[7 * 65]);
            *(u32x4*)(j.dstb + (size_t)n * j.dpitch + 16 * kq) = o; }
    }
    LDS_WAIT(); asm volatile("" ::: "memory");
}
struct CvtPtrs { const float *w_in, *w_pool, *w_out, *dwg, *dwu, *dwd, *ewg, *ewu, *ewd; unsigned char* ws; };
constexpr int CI_WIN = 32 * 64, CI_WPOOL = 16, CI_WOUT = 32 * 32, CI_DGU = 32 * 88, CI_DD = 88 * 32, CI_EGU = 16 * 224, CI_ED = 56 * 64;
constexpr int CI_NONEXP = 2 * CI_WIN + 8 * CI_WPOOL + 2 * CI_WOUT + 2 * CI_DGU + CI_DD;
constexpr int CI_TOTAL = CI_NONEXP + 8 * (2 * CI_EGU + CI_ED);
__device__ __forceinline__ unsigned char* cvt_dst(unsigned char* base, int KT, int row0, int kt) { return base + ((size_t)((row0 >> 8) * KT + kt) * 256 + (row0 & 255)) * 128; }
__device__ __forceinline__ CvtJob cvt_decode(const CvtPtrs& P, int r) {
    CvtJob j; j.f8scale = 0.f; j.dpitch = 128; j.fmt6 = 0;
    if (r < 2 * CI_WIN) { const int l = r / CI_WIN, q = r % CI_WIN, kb = q / 64, ng = q % 64; const int c0 = 64 * ng;
        j.src = P.w_in + (size_t)l * DM * ZW; j.ld_src = ZW; j.k0 = 64 * kb; j.n0 = c0 < 3072 ? c0 : c0 + 16;
        j.dstb = cvt_dst(P.ws + WS_WIN + (size_t)l * 4096 * 2048 * 2, 32, c0, kb); return j; }
    r -= 2 * CI_WIN;
    if (r < 8 * CI_WPOOL) { const int m = r / CI_WPOOL, q = r % CI_WPOOL, kb = q / 4, ng = q % 4;
        j.src = P.w_pool + (size_t)m * 65536; j.ld_src = 256; j.k0 = 64 * kb; j.n0 = 64 * ng;
        j.dstb = cvt_dst(P.ws + WS_WPOOL + (size_t)m * 65536 * 2, 4, 64 * ng, kb); return j; }
    r -= 8 * CI_WPOOL;
    if (r < 2 * CI_WOUT) { const int l = r / CI_WOUT, q = r % CI_WOUT, kb = q / 32, ng = q % 32;
        j.src = P.w_out + (size_t)l * 2048 * 2048; j.ld_src = 2048; j.k0 = 64 * kb; j.n0 = 64 * ng;
        j.dstb = cvt_dst(P.ws + WS_WOUT + (size_t)l * 2048 * 2048 * 2, 32, 64 * ng, kb); return j; }
    r -= 2 * CI_WOUT;
#if DENSE_FP8 == 1
    if (r < 2 * CI_DGU) { const int up = r / CI_DGU, q = r % CI_DGU, kb = q / 176, ng = q % 176; const int c0 = 32 * ng;
        j.src = up ? P.dwu : P.dwg; j.ld_src = 5632; j.k0 = 128 * kb; j.n0 = c0;
        j.dstb = cvt_dst(P.ws + WS_WGU, 16, 256 * (c0 >> 7) + (c0 & 127) + 128 * up, kb); j.f8scale = 64.f; return j; }
#else
    if (r < 2 * CI_DGU) { const int up = r / CI_DGU, q = r % CI_DGU, kb = q / 88, ng = q % 88; const int c0 = 64 * ng;
        j.src = up ? P.dwu : P.dwg; j.ld_src = 5632; j.k0 = 64 * kb; j.n0 = c0;
        j.dstb = cvt_dst(P.ws + WS_WGU, 32, 256 * (c0 >> 7) + (c0 & 127) + 128 * up, kb); return j; }
#endif
    r -= 2 * CI_DGU;
#if DENSE_FP8 >= 1
    if (r < CI_DD) { const int kb = r / 64, ng = r % 64;
        j.src = P.dwd; j.ld_src = 2048; j.k0 = 128 * kb; j.n0 = 32 * ng;
        j.dstb = cvt_dst(P.ws + WS_WD, 44, 32 * ng, kb); j.f8scale = 128.f; return j; }
#else
    if (r < CI_DD) { const int kb = r / 32, ng = r % 32;
        j.src = P.dwd; j.ld_src = 2048; j.k0 = 64 * kb; j.n0 = 64 * ng;
        j.dstb = cvt_dst(P.ws + WS_WD, 88, 64 * ng, kb); return j; }
#endif
    r -= CI_DD;
    { const int e = r / (2 * CI_EGU + CI_ED); int q = r % (2 * CI_EGU + CI_ED);
        if (q < 2 * CI_EGU) { const int up = q / CI_EGU; q %= CI_EGU; const int kb = q / 224, ng = q % 224, c0 = 32 * ng;
            j.src = (up ? P.ewu : P.ewg) + (size_t)e * 2048 * 7168; j.ld_src = 7168; j.k0 = 128 * kb; j.n0 = c0;
            const int row0 = 256 * (c0 >> 7) + (c0 & 127) + 128 * up;
            if (TILE_EWGU) j.dstb = cvt_dst(P.ws + WS_EWGU + (size_t)e * 14336 * 2048, 16, row0, kb);
            else { j.dstb = P.ws + WS_EWGU + (size_t)e * 14336 * 2048 + (size_t)row0 * 2048 + 128 * kb; j.dpitch = 2048; }
            j.f8scale = 64.f; j.fmt6 = (MOE_UP_FMT == 2); return j; }
        q -= 2 * CI_EGU; { const int kb = q / 64, ng = q % 64;
            j.src = P.ewd + (size_t)e * 7168 * 2048; j.ld_src = 2048; j.k0 = 128 * kb; j.n0 = 32 * ng;
            j.dstb = cvt_dst(P.ws + WS_EWD + (size_t)e * 2048 * 7168, 56, 32 * ng, kb); j.f8scale = 128.f; return j; } }
}

constexpr int NP_PITCH = 4112;
template <int MODE, bool OUT8 = false, bool INBF = true>
__device__ __forceinline__ void norm_phase(LAS unsigned char* lds, const void* xin, const float* gain, bf16_t* H, const float* Wp, int ldw,
                                           float* glr, int* topi, float* topw, int* hist, int tid, int lane, int wave, int G) {
    LAS float* Wl = (LAS float*)lds;
    LAS unsigned char* Wt = lds;
    LAS unsigned char* Ht = lds + 16 * NP_PITCH;
    LAS float* part = (LAS float*)(lds + 32 * NP_PITCH);
    LAS int* cnt = (LAS int*)(lds + 135168);
    if (MODE == 2) {
#pragma unroll
        for (int i = 0; i < 4; ++i) { const int k = tid + 512 * i;
#pragma unroll
            for (int p4 = 0; p4 < 2; ++p4) { const f32x4 w = *(const f32x4*)(Wp + (size_t)k * ldw + 4 * p4);
                Wl[(4 * p4 + 0) * 2048 + k] = w.x; Wl[(4 * p4 + 1) * 2048 + k] = w.y; Wl[(4 * p4 + 2) * 2048 + k] = w.z; Wl[(4 * p4 + 3) * 2048 + k] = w.w; } }
    }
    if (MODE == 0) {
#pragma unroll
        for (int i = 0; i < 4; ++i) { const int k = tid + 512 * i;
#pragma unroll
            for (int p4 = 0; p4 < 4; ++p4) { const f32x4 w = *(const f32x4*)(Wp + (size_t)k * ldw + 4 * p4);
                *(LAS bf16_t*)(Wt + (4 * p4 + 0) * NP_PITCH + 2 * k) = f2bf(w.x); *(LAS bf16_t*)(Wt + (4 * p4 + 1) * NP_PITCH + 2 * k) = f2bf(w.y);
                *(LAS bf16_t*)(Wt + (4 * p4 + 2) * NP_PITCH + 2 * k) = f2bf(w.z); *(LAS bf16_t*)(Wt + (4 * p4 + 3) * NP_PITCH + 2 * k) = f2bf(w.w); } }
    }
    f32x4 gv[8];
#pragma unroll
    for (int j = 0; j < 8; ++j) gv[j] = *(const f32x4*)(gain + 4 * lane + 256 * j);
#pragma unroll 1
    for (int rb = blockIdx.x; rb < T / 64; rb += G) {
        if (MODE == 2) { if (tid < 8) cnt[tid] = 0; }
        __syncthreads();
        u32x2 rawb[8]; f32x4 rawf[8];
        { const int lr0 = MODE == 0 ? 2 * wave : 8 * wave; const int row0 = 64 * rb + lr0;
#pragma unroll
            for (int j = 0; j < 8; ++j) {
                if (INBF) rawb[j] = ((const u32x2*)((const bf16_t*)xin + (size_t)row0 * DM) + lane)[64 * j];
                else rawf[j] = ((const f32x4*)((const float*)xin + (size_t)row0 * DM) + lane)[64 * j]; } }
#pragma unroll 1
        for (int r = 0; r < 8; ++r) {
            const int lrow = MODE == 0 ? 16 * (r >> 1) + 2 * wave + (r & 1) : 8 * wave + r;
            const int row = 64 * rb + lrow;
            f32x4 v[8]; float ss = 0.f;
#pragma unroll
            for (int j = 0; j < 8; ++j) {
                if (INBF) { const u32x2 q = (u32x2){rawb[j].x, rawb[j].y}; v[j] = (f32x4){bf_lo(q.x), bf_hi(q.x), bf_lo(q.y), bf_hi(q.y)}; }
                else v[j] = rawf[j];
                ss += (v[j].x * v[j].x + v[j].y * v[j].y) + (v[j].z * v[j].z + v[j].w * v[j].w); }
            { const int rn = r + 1 < 8 ? r + 1 : r;
                const int lrn = MODE == 0 ? 16 * (rn >> 1) + 2 * wave + (rn & 1) : 8 * wave + rn; const int rown = 64 * rb + lrn;
#pragma unroll
                for (int j = 0; j < 8; ++j) {
                    if (INBF) rawb[j] = ((const u32x2*)((const bf16_t*)xin + (size_t)rown * DM) + lane)[64 * j];
                    else rawf[j] = ((const f32x4*)((const float*)xin + (size_t)rown * DM) + lane)[64 * j]; } }
            const float rstd = rsqrtf(wave_sum(ss) * (1.0f / DM) + EPSF);
            u32x2* ho = TILE_H ? (u32x2*)(H + ((size_t)(row >> 8) * 32 + (lane >> 4)) * 16384 + (size_t)(row & 255) * 64 + 4 * (lane & 15)) : (u32x2*)(H + (size_t)row * DM) + lane;
            constexpr int HJ = TILE_H ? 4 * 16384 / 4 : 64;
#pragma unroll
            for (int j = 0; j < 8; ++j) { v[j] = v[j] * rstd * gv[j];
                if (OUT8) { int w = 0; w = __builtin_amdgcn_cvt_pk_fp8_f32(f8cl(4.f * v[j].x), f8cl(4.f * v[j].y), w, false); w = __builtin_amdgcn_cvt_pk_fp8_f32(f8cl(4.f * v[j].z), f8cl(4.f * v[j].w), w, true);
                    ((unsigned*)((unsigned char*)H + (size_t)row * DM))[lane + 64 * j] = (unsigned)w; }
                else { u32x2 o; o.x = pk_bf16(v[j].x, v[j].y); o.y = pk_bf16(v[j].z, v[j].w); ho[HJ * j] = o;
                    if (MODE == 0) *(LAS u32x2*)(Ht + (lrow & 15) * NP_PITCH + (4 * lane + 256 * j) * 2) = o; } }
            if (MODE == 0 && (r & 1)) {
                __syncthreads();
                f32x4 acc = (f32x4){0.f, 0.f, 0.f, 0.f};
#pragma unroll
                for (int q = 0; q < 8; ++q) { const int ks = 8 * wave + q;
                    const bf16x8 a = *(const LAS bf16x8*)(Ht + (lane & 15) * NP_PITCH + (32 * ks + 8 * (lane >> 4)) * 2);
                    const bf16x8 b = *(const LAS bf16x8*)(Wt + (lane & 15) * NP_PITCH + (32 * ks + 8 * (lane >> 4)) * 2);
                    acc = mma16(a, b, acc); }
#pragma unroll
                for (int i = 0; i < 4; ++i) part[wave * 256 + (4 * (lane >> 4) + i) * 16 + (lane & 15)] = acc[i];
                __syncthreads();
                if (tid < 256) { float s = 0.f;
#pragma unroll
                    for (int w = 0; w < 8; ++w) s += part[w * 256 + tid];
                    glr[(size_t)(64 * rb + 16 * (r >> 1) + (tid >> 4)) * 16 + (tid & 15)] = s; }
            }
            if (MODE == 2) {
                float pr[8];
#pragma unroll
                for (int p = 0; p < 8; ++p) { float s = 0.f;
#pragma unroll
                    for (int j = 0; j < 8; ++j) { const f32x4 w = *(const LAS f32x4*)(Wl + p * 2048 + 4 * lane + 256 * j); s += (v[j].x * w.x + v[j].y * w.y) + (v[j].z * w.z + v[j].w * w.w); }
                    pr[p] = s; }
                float q4[4], q2[2], q1;
#pragma unroll
                for (int e = 0; e < 4; ++e) { const bool hi = (lane & 32) != 0; const float snd = hi ? pr[e] : pr[e + 4], kp = hi ? pr[e + 4] : pr[e]; q4[e] = kp + __shfl_xor(snd, 32); }
#pragma unroll
                for (int e = 0; e < 2; ++e) { const bool hi = (lane & 16) != 0; const float snd = hi ? q4[e] : q4[e + 2], kp = hi ? q4[e + 2] : q4[e]; q2[e] = kp + __shfl_xor(snd, 16); }
                { const bool hi = (lane & 8) != 0; const float snd = hi ? q2[0] : q2[1], kp = hi ? q2[1] : q2[0]; q1 = kp + __shfl_xor(snd, 8); }
                q1 += __shfl_xor(q1, 4); q1 += __shfl_xor(q1, 2); q1 += __shfl_xor(q1, 1);
                float lg[8];
#pragma unroll
                for (int e = 0; e < 8; ++e) lg[e] = __int_as_float(__builtin_amdgcn_readlane(__float_as_int(q1), 8 * e));
                int i0 = 0; float v0 = lg[0];
#pragma unroll
                for (int e = 1; e < 8; ++e) if (lg[e] > v0) { v0 = lg[e]; i0 = e; }
                int i1 = 0; float v1 = -3.4e38f;
#pragma unroll
                for (int e = 0; e < 8; ++e) if (e != i0 && lg[e] > v1) { v1 = lg[e]; i1 = e; }
                if (lane == 0) { const float e1 = __expf(v1 - v0), inv = 1.0f / (1.0f + e1);
                    topi[2 * row] = i0; topi[2 * row + 1] = i1; topw[2 * row] = inv; topw[2 * row + 1] = e1 * inv;
                    __hip_atomic_fetch_add(cnt + i0, 1, __ATOMIC_RELAXED, __HIP_MEMORY_SCOPE_WORKGROUP); __hip_atomic_fetch_add(cnt + i1, 1, __ATOMIC_RELAXED, __HIP_MEMORY_SCOPE_WORKGROUP); }
            }
        }
        if (MODE == 2) { __syncthreads(); if (tid < 8) hist[rb * 8 + tid] = cnt[tid]; }
    }
}
template <int W> __device__ __forceinline__ void pool_d_item(const bf16_t* Z, bf16_t* DP, int t, int c) {
    float s[8];
#pragma unroll
    for (int e = 0; e < 8; ++e) s[e] = 0.f;
    u32x4 q[W];
#pragma unroll
    for (int j = 0; j < W; ++j) { const int tt = t - j; q[j] = tt >= 0 ? *(const u32x4*)(Z + (size_t)tt * 4096 + c) : (u32x4){0u, 0u, 0u, 0u}; }
#pragma unroll
    for (int j = 0; j < W; ++j) { s[0] += bf_lo(q[j].x); s[1] += bf_hi(q[j].x); s[2] += bf_lo(q[j].y); s[3] += bf_hi(q[j].y); s[4] += bf_lo(q[j].z); s[5] += bf_hi(q[j].z); s[6] += bf_lo(q[j].w); s[7] += bf_hi(q[j].w); }
    const int cnt = (t + 1) < W ? (t + 1) : W; const float inv = 1.0f / (float)cnt;
    u32x4 o;
    o.x = pk_bf16(s[0] * inv - bf_lo(q[0].x), s[1] * inv - bf_hi(q[0].x)); o.y = pk_bf16(s[2] * inv - bf_lo(q[0].y), s[3] * inv - bf_hi(q[0].y));
    o.z = pk_bf16(s[4] * inv - bf_lo(q[0].z), s[5] * inv - bf_hi(q[0].z)); o.w = pk_bf16(s[6] * inv - bf_lo(q[0].w), s[7] * inv - bf_hi(q[0].w));
    *(u32x4*)(DP + (size_t)t * 1024 + c) = o;
}
__device__ __forceinline__ void pool_d_phase(const bf16_t* Z, bf16_t* DP, int tid, int G) {
#pragma unroll 1
    for (int item = blockIdx.x * NTHR + tid; item < T * 128; item += G * NTHR) {
        const int g = item / (T * 32), r = item % (T * 32), t = r >> 5, c = g * 256 + (r & 31) * 8;
        if (g == 0) pool_d_item<2>(Z, DP, t, c); else if (g == 1) pool_d_item<4>(Z, DP, t, c); else if (g == 2) pool_d_item<8>(Z, DP, t, c); else pool_d_item<16>(Z, DP, t, c);
    }
}

constexpr int G1_LR = 0, G1_EB = 4096, G1_KD = 6144, KD_PITCH = 1040, G1_V = G1_KD + 64 * KD_PITCH, V_PITCH = 528;
__device__ __forceinline__ void gla_state_phase(LAS unsigned char* lds, bf16_t* Z, const float* GLR, const float* wgu, const float* bgate, bf16_t* CS, float* DEC,
                                                int tid, int lane, int wave, int G) {
    LAS float* lr = (LAS float*)(lds + G1_LR);
    LAS float* eb = (LAS float*)(lds + G1_EB);
    const unsigned kd_a = (unsigned)(size_t)(lds + G1_KD), v_a = (unsigned)(size_t)(lds + G1_V);
    const int g4 = lane >> 4, q4 = (lane & 15) >> 2, p4 = lane & 3;
    float W[16];
#pragma unroll
    for (int r = 0; r < 16; ++r) W[r] = wgu[r * 512 + tid];
    const float bg = bgate[tid];
#pragma unroll 1
    for (int n = blockIdx.x; n < T / 64; n += G) {
        __syncthreads();
        if (tid < 256) *(LAS f32x4*)(lr + 4 * tid) = *(const f32x4*)(GLR + (size_t)n * 1024 + 4 * tid);
#pragma unroll
        for (int i = 0; i < 8; ++i) { const int idx = tid + 512 * i, c = idx >> 6, ch = idx & 63;
            *(LAS u32x4*)(lds + G1_KD + c * KD_PITCH + ch * 16) = *(const u32x4*)(Z + (size_t)(64 * n + c) * 4096 + 1536 + 8 * ch); }
        __syncthreads();
        float bc = 0.f;
        bf16_t* zq = Z + (size_t)(64 * n) * 4096 + 1024 + tid;
#pragma unroll 1
        for (int c0 = 0; c0 < 64; c0 += 16) {
            bf16_t qv[16];
#pragma unroll
            for (int i = 0; i < 16; ++i) qv[i] = zq[(size_t)(c0 + i) * 4096];
#pragma unroll
            for (int i = 0; i < 16; ++i) { const int c = c0 + i; float s = bg;
#pragma unroll
                for (int r4 = 0; r4 < 4; ++r4) { const f32x4 a = *(const LAS f32x4*)(lr + c * 16 + 4 * r4); s += (a.x * W[4 * r4] + a.y * W[4 * r4 + 1]) + (a.z * W[4 * r4 + 2] + a.w * W[4 * r4 + 3]); }
                const float ls = fminf(s, 0.f) - __logf(1.0f + __expf(-fabsf(s)));
                bc += ls * (1.0f / 16.0f);
                const float eq = __expf(bc);
                zq[(size_t)c * 4096] = f2bf(bf2f(qv[i]) * 0.08838834764831845f * eq);
                LAS bf16_t* kp = (LAS bf16_t*)(lds + G1_KD + c * KD_PITCH + 2 * tid);
                *kp = f2bf(bf2f(*kp) * __builtin_amdgcn_rcpf(eq)); }
        }
        { const float e = __expf(bc); eb[tid] = e; DEC[(size_t)n * 512 + tid] = e; }
        __syncthreads();
#pragma unroll
        for (int i = 0; i < 8; ++i) { const int idx = tid + 512 * i, c = idx >> 6, ch = idx & 63;
            *(u32x4*)(Z + (size_t)(64 * n + c) * 4096 + 1536 + 8 * ch) = *(const LAS u32x4*)(lds + G1_KD + c * KD_PITCH + ch * 16); }
#pragma unroll 1
        for (int h = 0; h < 4; ++h) {
            if (h) __syncthreads();
#pragma unroll
            for (int i = 0; i < 4; ++i) { const int idx = tid + 512 * i, c = idx >> 5, ch = idx & 31;
                *(LAS u32x4*)(lds + G1_V + c * V_PITCH + ch * 16) = *(const u32x4*)(Z + (size_t)(64 * n + c) * 4096 + 2048 + h * 256 + 8 * ch); }
            __syncthreads();
            f32x4 acc[8][2];
#pragma unroll
            for (int mb = 0; mb < 8; ++mb) { acc[mb][0] = (f32x4){0.f, 0.f, 0.f, 0.f}; acc[mb][1] = (f32x4){0.f, 0.f, 0.f, 0.f}; }
#pragma unroll
            for (int ks = 0; ks < 2; ++ks) {
                bf16x8 bfr[2];
#pragma unroll
                for (int nb = 0; nb < 2; ++nb) { const unsigned a0 = v_a + (32 * ks + 8 * g4 + q4) * V_PITCH + (32 * wave + 16 * nb + 4 * p4) * 2; bfr[nb] = tr_frag(a0, a0 + 4 * V_PITCH); }
#pragma unroll
                for (int mb = 0; mb < 8; ++mb) { const unsigned a0 = kd_a + (32 * ks + 8 * g4 + q4) * KD_PITCH + (128 * h + 16 * mb + 4 * p4) * 2; const bf16x8 af = tr_frag(a0, a0 + 4 * KD_PITCH);
                    acc[mb][0] = mma16(af, bfr[0], acc[mb][0]); acc[mb][1] = mma16(af, bfr[1], acc[mb][1]); }
            }
            bf16_t* cs = CS + ((size_t)(n * 4 + h) * 256) * 128;
#pragma unroll
            for (int mb = 0; mb < 8; ++mb) { const f32x4 e4 = *(const LAS f32x4*)(eb + 128 * h + 16 * mb + 4 * g4);
#pragma unroll
                for (int nb = 0; nb < 2; ++nb) { const f32x4 v = acc[mb][nb] * e4; u32x2 w; w.x = pk_bf16(v[0], v[1]); w.y = pk_bf16(v[2], v[3]);
                    *(u32x2*)(cs + (size_t)(32 * wave + 16 * nb + (lane & 15)) * 128 + 16 * mb + 4 * g4) = w; } }
        }
    }
}

__device__ __forceinline__ void gla_scan_phase(const bf16_t* CS, const float* DEC, bf16_t* SP, int tid, int G) {
#pragma unroll 1
    for (int e = blockIdx.x * NTHR + tid; e < 4 * 256 * 128; e += G * NTHR) {
        const int h = e >> 15, k = e & 127;
        float S = 0.f;
        const bf16_t* cp = CS + e; const float* dp = DEC + h * 128 + k; bf16_t* sp = SP + e;
        bf16_t c0[16], c1[16]; float d0[16], d1[16];
#pragma unroll
        for (int i = 0; i < 16; ++i) { c0[i] = cp[(size_t)i * 131072]; d0[i] = dp[(size_t)i * 512]; }
#pragma unroll 1
        for (int n0 = 0; n0 < 256; n0 += 32) {
#pragma unroll
            for (int i = 0; i < 16; ++i) { c1[i] = cp[(size_t)(n0 + 16 + i) * 131072]; d1[i] = dp[(size_t)(n0 + 16 + i) * 512]; }
#pragma unroll
            for (int i = 0; i < 16; ++i) { sp[(size_t)(n0 + i) * 131072] = f2bf(S); S = fmaf(d0[i], S, bf2f(c0[i])); }
            if (n0 + 32 < 256) {
#pragma unroll
                for (int i = 0; i < 16; ++i) { c0[i] = cp[(size_t)(n0 + 32 + i) * 131072]; d0[i] = dp[(size_t)(n0 + 32 + i) * 512]; } }
#pragma unroll
            for (int i = 0; i < 16; ++i) { sp[(size_t)(n0 + 16 + i) * 131072] = f2bf(S); S = fmaf(d1[i], S, bf2f(c1[i])); }
        }
    }
}

constexpr int G3_QD = 0, QK_PITCH = 272, G3_KD = 64 * QK_PITCH, G3_V = 2 * 64 * QK_PITCH, G3_ATT = G3_V + 64 * V_PITCH, ATT_PITCH = 144,
              G3_SSQ = G3_ATT + 64 * ATT_PITCH, G3_RSTD = G3_SSQ + 2048, G3_STG = 0, STG_PITCH = 260;
static_assert(64 * STG_PITCH * 4 <= G3_ATT, "o staging aliases the q/k/v images only");
__device__ __forceinline__ void gla_out_phase(LAS unsigned char* lds, const bf16_t* Z, const bf16_t* SP, const float* gnorm, bf16_t* MIX, int tid, int lane, int wave, int G) {
    const unsigned v_a = (unsigned)(size_t)(lds + G3_V);
    const int g4 = lane >> 4, l15 = lane & 15, q4 = l15 >> 2, p4 = lane & 3;
    LAS float* ssq = (LAS float*)(lds + G3_SSQ); LAS float* rstd = (LAS float*)(lds + G3_RSTD); LAS float* stg = (LAS float*)(lds + G3_STG);
#pragma unroll 1
    for (int n = blockIdx.x; n < T / 64; n += G) {
        u32x4 nq[2], nk[2], nv[4], nr[4]; bf16x8 nsp[2][4];
#define G3_REQUEST(hh) do { \
            _Pragma("unroll") for (int i = 0; i < 2; ++i) { const int idx = tid + 512 * i, row = idx >> 4, ch = idx & 15; const bf16_t* zr = Z + (size_t)(64 * n + row) * 4096 + (hh) * 128 + 8 * ch; \
                nq[i] = *(const u32x4*)(zr + 1024); nk[i] = *(const u32x4*)(zr + 1536); } \
            _Pragma("unroll") for (int i = 0; i < 4; ++i) { const int idx = tid + 512 * i, c = idx >> 5, ch = idx & 31; nv[i] = *(const u32x4*)(Z + (size_t)(64 * n + c) * 4096 + 2048 + (hh) * 256 + 8 * ch); } \
            _Pragma("unroll") for (int i = 0; i < 4; ++i) { const int item = tid + 512 * i, row = item >> 5, c8 = (item & 31) * 8; nr[i] = *(const u32x4*)(Z + (size_t)(64 * n + row) * 4096 + 3072 + (hh) * 256 + c8); } \
            { const bf16_t* spb = SP + ((size_t)(n * 4 + (hh)) * 256) * 128; \
              _Pragma("unroll") for (int nb = 0; nb < 2; ++nb) _Pragma("unroll") for (int ks = 0; ks < 4; ++ks) nsp[nb][ks] = *(const bf16x8*)(spb + (size_t)(32 * wave + 16 * nb + l15) * 128 + 32 * ks + 8 * g4); } } while (0)
        G3_REQUEST(0);
#pragma unroll 1
        for (int h = 0; h < 4; ++h) {
            __syncthreads();
#pragma unroll
            for (int i = 0; i < 2; ++i) { const int idx = tid + 512 * i, row = idx >> 4, ch = idx & 15;
                *(LAS u32x4*)(lds + G3_QD + row * QK_PITCH + ch * 16) = nq[i]; *(LAS u32x4*)(lds + G3_KD + row * QK_PITCH + ch * 16) = nk[i]; }
#pragma unroll
            for (int i = 0; i < 4; ++i) { const int idx = tid + 512 * i, c = idx >> 5, ch = idx & 31; *(LAS u32x4*)(lds + G3_V + c * V_PITCH + ch * 16) = nv[i]; }
            u32x4 rpre[4]; bf16x8 sp[2][4];
#pragma unroll
            for (int i = 0; i < 4; ++i) rpre[i] = nr[i];
#pragma unroll
            for (int nb = 0; nb < 2; ++nb)
#pragma unroll
                for (int ks = 0; ks < 4; ++ks) sp[nb][ks] = nsp[nb][ks];
            { const int hn = h < 3 ? h + 1 : 3; G3_REQUEST(hn); }
            __syncthreads();
            f32x4 acc[4][2];
#pragma unroll
            for (int mb = 0; mb < 4; ++mb) { acc[mb][0] = (f32x4){0.f, 0.f, 0.f, 0.f}; acc[mb][1] = (f32x4){0.f, 0.f, 0.f, 0.f}; }
#pragma unroll
            for (int ks = 0; ks < 4; ++ks)
#pragma unroll
                for (int mb = 0; mb < 4; ++mb) { const bf16x8 a = *(const LAS bf16x8*)(lds + G3_QD + (16 * mb + l15) * QK_PITCH + (32 * ks + 8 * g4) * 2);
                    acc[mb][0] = mma16(a, sp[0][ks], acc[mb][0]); acc[mb][1] = mma16(a, sp[1][ks], acc[mb][1]); }
            { const int jb = wave >> 1;
#pragma unroll
                for (int ib2 = 0; ib2 < 2; ++ib2) { const int ib = 2 * (wave & 1) + ib2; f32x4 at = (f32x4){0.f, 0.f, 0.f, 0.f};
                    if (jb <= ib) {
#pragma unroll
                        for (int ks = 0; ks < 4; ++ks) { const bf16x8 a = *(const LAS bf16x8*)(lds + G3_KD + (16 * jb + l15) * QK_PITCH + (32 * ks + 8 * g4) * 2);
                            const bf16x8 b = *(const LAS bf16x8*)(lds + G3_QD + (16 * ib + l15) * QK_PITCH + (32 * ks + 8 * g4) * 2); at = mma16(a, b, at); } }
                    const int i = 16 * ib + l15, j0 = 16 * jb + 4 * g4;
                    u32x2 w; w.x = pk_bf16(j0 + 0 <= i ? at[0] : 0.f, j0 + 1 <= i ? at[1] : 0.f); w.y = pk_bf16(j0 + 2 <= i ? at[2] : 0.f, j0 + 3 <= i ? at[3] : 0.f);
                    *(LAS u32x2*)(lds + G3_ATT + i * ATT_PITCH + j0 * 2) = w; } }
            __syncthreads();
#pragma unroll
            for (int ks = 0; ks < 2; ++ks) {
                bf16x8 bfr[2];
#pragma unroll
                for (int nb = 0; nb < 2; ++nb) { const unsigned a0 = v_a + (32 * ks + 8 * g4 + q4) * V_PITCH + (32 * wave + 16 * nb + 4 * p4) * 2; bfr[nb] = tr_frag(a0, a0 + 4 * V_PITCH); }
#pragma unroll
                for (int mb = 0; mb < 4; ++mb) { const bf16x8 a = *(const LAS bf16x8*)(lds + G3_ATT + (16 * mb + l15) * ATT_PITCH + (32 * ks + 8 * g4) * 2);
                    acc[mb][0] = mma16(a, bfr[0], acc[mb][0]); acc[mb][1] = mma16(a, bfr[1], acc[mb][1]); }
            }
#pragma unroll
            for (int mb = 0; mb < 4; ++mb)
#pragma unroll
                for (int r = 0; r < 4; ++r) { float p = acc[mb][0][r] * acc[mb][0][r] + acc[mb][1][r] * acc[mb][1][r];
                    p += __shfl_xor(p, 1); p += __shfl_xor(p, 2); p += __shfl_xor(p, 4); p += __shfl_xor(p, 8);
                    if (l15 == 0) ssq[wave * 64 + 16 * mb + 4 * g4 + r] = p; }
            __syncthreads();
            if (tid < 64) { float s = 0.f;
#pragma unroll
                for (int w = 0; w < 8; ++w) s += ssq[w * 64 + tid];
                rstd[tid] = rsqrtf(s * (1.0f / 256.0f) + EPSF); }
#pragma unroll
            for (int mb = 0; mb < 4; ++mb)
#pragma unroll
                for (int nb = 0; nb < 2; ++nb)
#pragma unroll
                    for (int r = 0; r < 4; ++r) stg[(16 * mb + 4 * g4 + r) * STG_PITCH + 32 * wave + 16 * nb + l15] = acc[mb][nb][r];
            __syncthreads();
#pragma unroll
            for (int i = 0; i < 4; ++i) { const int item = tid + 512 * i, row = item >> 5, c8 = (item & 31) * 8;
                const f32x4 o0 = *(const LAS f32x4*)(stg + row * STG_PITCH + c8), o1 = *(const LAS f32x4*)(stg + row * STG_PITCH + c8 + 4);
                const float rs = rstd[row];
                const f32x4 g0 = *(const f32x4*)(gnorm + h * 256 + c8), g1 = *(const f32x4*)(gnorm + h * 256 + c8 + 4);
                const u32x4 rr = rpre[i];
                u32x4 w;
                w.x = pk_bf16(o0.x * rs * g0.x * silu_f(bf_lo(rr.x)), o0.y * rs * g0.y * silu_f(bf_hi(rr.x)));
                w.y = pk_bf16(o0.z * rs * g0.z * silu_f(bf_lo(rr.y)), o0.w * rs * g0.w * silu_f(bf_hi(rr.y)));
                w.z = pk_bf16(o1.x * rs * g1.x * silu_f(bf_lo(rr.z)), o1.y * rs * g1.y * silu_f(bf_hi(rr.z)));
                w.w = pk_bf16(o1.z * rs * g1.z * silu_f(bf_lo(rr.w)), o1.w * rs * g1.w * silu_f(bf_hi(rr.w)));
                *(u32x4*)(MIX + (size_t)(64 * n + row) * 2048 + 1024 + h * 256 + c8) = w; }
        }
    }
}

#undef G3_REQUEST
__device__ __forceinline__ void assign_phase(LAS unsigned char* lds, const int* topi, const int* hist, int* tok_slot, int* blk_expert, int* nrb_out,
                                             const bf16_t* H, bf16_t* HS, int tid, int lane, int wave, int G) {
    LAS int* lh = (LAS int*)lds;
    LAS int* tot = (LAS int*)(lds + 8192);
    LAS int* myslot = (LAS int*)(lds + 8192 + 256);
#pragma unroll
    for (int i = 0; i < 4; ++i) lh[tid + 512 * i] = __hip_atomic_load(hist + tid + 512 * i, RLX_AGENT);
    __syncthreads();
#pragma unroll 1
    for (int rb = blockIdx.x; rb < T / 64; rb += G) {
        if (tid < 48) tot[tid] = 0;
        __syncthreads();
        { const int e = tid & 7, j = tid >> 3; int t_ = 0, b_ = 0;
#pragma unroll
            for (int q = 0; q < 4; ++q) { const int bb = 4 * j + q; const int c = lh[bb * 8 + e]; t_ += c; b_ += (bb < rb) ? c : 0; }
            __hip_atomic_fetch_add(tot + e, t_, __ATOMIC_RELAXED, __HIP_MEMORY_SCOPE_WORKGROUP); __hip_atomic_fetch_add(tot + 16 + e, b_, __ATOMIC_RELAXED, __HIP_MEMORY_SCOPE_WORKGROUP); }
        __syncthreads();
        if (tid == 0) { int run = 0;
#pragma unroll
            for (int e = 0; e < 8; ++e) { const int pd = ((tot[e] + 255) >> 8) << 8; tot[8 + e] = pd; tot[24 + e] = run + tot[16 + e]; run += pd; tot[40 + e] = run; }
            if (rb == 0) *nrb_out = run >> 8; }
        __syncthreads();
        if (rb == 0 && tid < NRB_MAX) { int e = 0;
#pragma unroll
            for (int q = 0; q < 8; ++q) e += (tot[40 + q] <= tid * 256) ? 1 : 0;
            blk_expert[tid] = e < 7 ? e : 7; }
        int my_e = 0, my_rank = 0;
        if (wave < 2) { my_e = topi[128 * rb + tid];
#pragma unroll
            for (int e = 0; e < 8; ++e) { const unsigned long long m = __ballot(my_e == e);
                if (my_e == e) my_rank = __popcll(m & ((1ull << lane) - 1ull));
                if (wave == 0 && lane == 0) tot[32 + e] = __popcll(m); } }
        __syncthreads();
        if (wave < 2) { const int s = tot[24 + my_e] + my_rank + (wave == 1 ? tot[32 + my_e] : 0); myslot[tid] = s; tok_slot[128 * rb + tid] = s; }
        __syncthreads();
#pragma unroll 1
        for (int i0 = wave; i0 < 128; i0 += 32) {
#if MOE_UP_FMT == 2
            u32x4 v[4][4]; int sl[4];
#pragma unroll
            for (int k = 0; k < 4; ++k) { const int i = i0 + 8 * k; const int t = 64 * rb + (i >> 1); sl[k] = myslot[i];
#pragma unroll
                for (int q = 0; q < 4; ++q) v[k][q] = ((const u32x4*)(H + (size_t)t * DM))[4 * lane + q]; }
#pragma unroll
            for (int k = 0; k < 4; ++k) { f32x16 lo, hi;
#pragma unroll
                for (int q = 0; q < 2; ++q) { const u32x4 x = v[k][q], y = v[k][2 + q];
                    lo[8 * q + 0] = bf_lo(x.x); lo[8 * q + 1] = bf_hi(x.x); lo[8 * q + 2] = bf_lo(x.y); lo[8 * q + 3] = bf_hi(x.y); lo[8 * q + 4] = bf_lo(x.z); lo[8 * q + 5] = bf_hi(x.z); lo[8 * q + 6] = bf_lo(x.w); lo[8 * q + 7] = bf_hi(x.w);
                    hi[8 * q + 0] = bf_lo(y.x); hi[8 * q + 1] = bf_hi(y.x); hi[8 * q + 2] = bf_lo(y.y); hi[8 * q + 3] = bf_hi(y.y); hi[8 * q + 4] = bf_lo(y.z); hi[8 * q + 5] = bf_hi(y.z); hi[8 * q + 6] = bf_lo(y.w); hi[8 * q + 7] = bf_hi(y.w); }
#pragma unroll
                for (int i = 0; i < 16; ++i) { lo[i] = __builtin_fminf(__builtin_fmaxf(2.f * lo[i], -7.5f), 7.5f); hi[i] = __builtin_fminf(__builtin_fmaxf(2.f * hi[i], -7.5f), 7.5f); }
                const u32x6 w = __builtin_amdgcn_cvt_scalef32_2xpk16_fp6_f32(lo, hi, 1.0f);
                unsigned char* d = (TILE_HS ? (unsigned char*)HS + (size_t)(sl[k] >> 8) * (16 * 32768) + (size_t)(sl[k] & 255) * 128 + (size_t)(lane >> 2) * 32768
                                            : (unsigned char*)HS + (size_t)sl[k] * DM + (lane >> 2) * 128) + 16 * (lane & 3);
                *(u32x4*)d = (u32x4){w[0], w[1], w[2], w[3]}; *(u32x4*)(d + 64) = (u32x4){w[4], w[5], 0u, 0u};     }
#else
            u32x4 v[4][4]; int sl[4];
#pragma unroll
            for (int k = 0; k < 4; ++k) { const int i = i0 + 8 * k; const int t = 64 * rb + (i >> 1); sl[k] = myslot[i];
#pragma unroll
                for (int q = 0; q < 4; ++q) { const int ch = lane + 64 * q;
                    v[k][q] = TILE_H ? *(const u32x4*)(H + ((size_t)(t >> 8) * 32 + (ch >> 3)) * 16384 + (size_t)(t & 255) * 64 + (ch & 7) * 8) : ((const u32x4*)(H + (size_t)t * DM))[ch]; } }
#pragma unroll
            for (int k = 0; k < 4; ++k) { unsigned char* drow = TILE_HS ? (unsigned char*)HS + (size_t)(sl[k] >> 8) * (16 * 32768) + (size_t)(sl[k] & 255) * 128 : (unsigned char*)HS + (size_t)sl[k] * DM;
#pragma unroll
                for (int q = 0; q < 4; ++q) { const u32x4 x = v[k][q]; int w0 = 0, w1 = 0;
                    w0 = __builtin_amdgcn_cvt_pk_fp8_f32(4.f * bf_lo(x.x), 4.f * bf_hi(x.x), w0, false); w0 = __builtin_amdgcn_cvt_pk_fp8_f32(4.f * bf_lo(x.y), 4.f * bf_hi(x.y), w0, true);
                    w1 = __builtin_amdgcn_cvt_pk_fp8_f32(4.f * bf_lo(x.z), 4.f * bf_hi(x.z), w1, false); w1 = __builtin_amdgcn_cvt_pk_fp8_f32(4.f * bf_lo(x.w), 4.f * bf_hi(x.w), w1, true);
                    const int ch = lane + 64 * q;
                    *(u32x2*)(TILE_HS ? drow + (size_t)(ch >> 4) * 32768 + 8 * (ch & 15) : drow + 8 * ch) = (u32x2){(unsigned)w0, (unsigned)w1}; } }
#endif
        }
        __syncthreads();
    }
}

__device__ __forceinline__ void final_phase(LAS unsigned char* lds, const bf16_t* XS, const bf16_t* Y, const float* P, const int* nrb_p, const int* tok_slot, const float* topw,
                                            const float* gain, float* out, int tid, int lane, int wave, int G) {
    LAS int* tbl = (LAS int*)lds;
    const int nrb = __builtin_amdgcn_readfirstlane(__hip_atomic_load(nrb_p, RLX_AGENT));
    int full, tail, sk; moe_tail_split(nrb, G, full, tail, sk);
    for (int i = tid; i < NRB_MAX * 8; i += NTHR) tbl[i] = -1;
    __syncthreads();
    if (tid < tail) { int pm, pn; pg8::unit_map((long)full + tid, nrb, 8, pm, pn); tbl[pm * 8 + pn] = tid; }
    __syncthreads();
    f32x4 gv[8];
#pragma unroll
    for (int j = 0; j < 8; ++j) gv[j] = *(const f32x4*)(gain + 4 * lane + 256 * j);
    const int rstep = G * 8, rfirst = blockIdx.x * 8 + wave;
    if (rfirst >= T) return;
    auto clampr = [&](int r) { return r < T ? r : rfirst; };
    int cs0 = tok_slot[2 * rfirst], cs1 = tok_slot[2 * rfirst + 1]; float cw0 = topw[2 * rfirst], cw1 = topw[2 * rfirst + 1];
    int r1 = clampr(rfirst + rstep);
    int ns0 = tok_slot[2 * r1], ns1 = tok_slot[2 * r1 + 1]; float nw0 = topw[2 * r1], nw1 = topw[2 * r1 + 1];
    u32x2 px[8], py0[8], py1[8];
#pragma unroll
    for (int j = 0; j < 8; ++j) { px[j] = ((const u32x2*)(XS + (size_t)rfirst * DM) + lane)[64 * j]; py0[j] = ((const u32x2*)(Y + (size_t)cs0 * DM) + lane)[64 * j]; py1[j] = ((const u32x2*)(Y + (size_t)cs1 * DM) + lane)[64 * j]; }
#pragma unroll 1
    for (int row = rfirst; row < T; row += rstep) {
        const int s0 = cs0, s1 = cs1; const float w0 = cw0, w1 = cw1;
        u32x2 cx[8], cy0[8], cy1[8];
#pragma unroll
        for (int j = 0; j < 8; ++j) { cx[j] = px[j]; cy0[j] = py0[j]; cy1[j] = py1[j]; }
        { const int rn = clampr(row + rstep), rnn = clampr(row + 2 * rstep);
#pragma unroll
            for (int j = 0; j < 8; ++j) { px[j] = ((const u32x2*)(XS + (size_t)rn * DM) + lane)[64 * j]; py0[j] = ((const u32x2*)(Y + (size_t)ns0 * DM) + lane)[64 * j]; py1[j] = ((const u32x2*)(Y + (size_t)ns1 * DM) + lane)[64 * j]; }
            cs0 = ns0; cs1 = ns1; cw0 = nw0; cw1 = nw1;
            ns0 = tok_slot[2 * rnn]; ns1 = tok_slot[2 * rnn + 1]; nw0 = topw[2 * rnn]; nw1 = topw[2 * rnn + 1]; }
        f32x4 v[8]; float ss = 0.f;
        int anyt = -1;
#pragma unroll
        for (int j = 0; j < 8; ++j) { const int t0 = tbl[(s0 >> 8) * 8 + j], t1 = tbl[(s1 >> 8) * 8 + j]; anyt = t0 > anyt ? t0 : anyt; anyt = t1 > anyt ? t1 : anyt; }
        if (anyt < 0) {
#pragma unroll
            for (int j = 0; j < 8; ++j) { const u32x2 q = cx[j], a = cy0[j], b = cy1[j];
                v[j].x = bf_lo(q.x) + w0 * bf_lo(a.x) + w1 * bf_lo(b.x); v[j].y = bf_hi(q.x) + w0 * bf_hi(a.x) + w1 * bf_hi(b.x);
                v[j].z = bf_lo(q.y) + w0 * bf_lo(a.y) + w1 * bf_lo(b.y); v[j].w = bf_hi(q.y) + w0 * bf_hi(a.y) + w1 * bf_hi(b.y); }
        } else {
#pragma unroll 1
            for (int j = 0; j < 8; ++j) { { const u32x2 q = ((const u32x2*)(XS + (size_t)row * DM) + lane)[64 * j]; v[j] = (f32x4){bf_lo(q.x), bf_hi(q.x), bf_lo(q.y), bf_hi(q.y)}; }
#pragma unroll 1
                for (int k = 0; k < 2; ++k) { const int sl = k ? s1 : s0; const float w = k ? w1 : w0;
                    const int t = tbl[(sl >> 8) * 8 + j]; f32x4 y;
                    if (t >= 0) { y = (f32x4){0.f, 0.f, 0.f, 0.f};
                        for (int q = 0; q < sk; ++q) y += *(const f32x4*)(P + ((size_t)(t * sk + q) * 256 + (sl & 255)) * 256 + 4 * lane); }
                    else { const u32x2 a = ((const u32x2*)(Y + (size_t)sl * DM) + lane)[64 * j]; y = (f32x4){bf_lo(a.x), bf_hi(a.x), bf_lo(a.y), bf_hi(a.y)}; }
                    v[j] += w * y; } }
        }
#pragma unroll
        for (int j = 0; j < 8; ++j) ss += (v[j].x * v[j].x + v[j].y * v[j].y) + (v[j].z * v[j].z + v[j].w * v[j].w);
        const float rstd = rsqrtf(wave_sum(ss) * (1.0f / DM) + EPSF);
        f32x4* orow = (f32x4*)(out + (size_t)row * DM) + lane;
#pragma unroll
        for (int j = 0; j < 8; ++j) orow[64 * j] = v[j] * rstd * gv[j];
    }
}
#ifdef NO_GEMM
#define GEMMCALL(...) ;
#else
#define GEMMCALL(...) __VA_ARGS__
#endif
#ifdef NO_CVT
#define CVTCALL(...) ;
#else
#define CVTCALL(...) __VA_ARGS__
#endif
#ifdef NO_NORM
#define NORMCALL(...) ;
#else
#define NORMCALL(...) __VA_ARGS__
#endif
#ifdef NO_PRE
#define PRECALL(...) ;
#else
#define PRECALL(...) __VA_ARGS__
#endif
#ifdef NO_SCAN
#define SCANCALL(...) ;
#else
#define SCANCALL(...) __VA_ARGS__
#endif
#ifdef NO_OUT
#define OUTCALL(...) ;
#else
#define OUTCALL(...) __VA_ARGS__
#endif
#ifdef NO_ASG
#define ASGCALL(...) ;
#else
#define ASGCALL(...) __VA_ARGS__
#endif
#ifdef NO_FIN
#define FINCALL(...) ;
#else
#define FINCALL(...) __VA_ARGS__
#endif
struct Args { const float* in[18]; float* out; unsigned char* ws; int ph_lo, ph_hi, cvt_items, pad; };

__global__ void __launch_bounds__(NTHR, 2) fwd(Args args) {
    extern __shared__ __attribute__((aligned(16))) unsigned char lds_raw[];
    LAS unsigned char* lds = (LAS unsigned char*)lds_raw;
    volatile LAS unsigned* MISC = (volatile LAS unsigned*)(lds + MISC_OFF);
    const int tid = threadIdx.x, lane = tid & 63, wave = __builtin_amdgcn_readfirstlane(tid >> 6);
    const int G = gridDim.x;
    unsigned char* ws = args.ws;
    unsigned* ctl = (unsigned*)(ws + WS_CTL);
    const int lo = args.ph_lo, hi = args.ph_hi;
    if (tid < 64) MISC[tid] = 0u;
    __syncthreads();
    XcdBarrier bar; bar.bar = ctl + CW_BAR; bar.x = 0; bar.st = nullptr;
    if (hi - lo > 1) bar = xcd_barrier_post(ctl + CW_BAR, MISC + 8);
#define IN(k) (lo <= (k) && (k) < hi)
#define SEAM(k) do { if (IN(k) && IN((k) + 1)) xcd_barrier(bar); } while (0)

    const float* x = args.in[0]; const float* mix_norm = args.in[1]; const float* w_in = args.in[2]; const float* pool_scale = args.in[4];
    const float* w_gate_up = args.in[5]; const float* b_gate = args.in[6]; const float* gla_norm = args.in[7]; const float* ffn_norm = args.in[9];
    const float* w_router = args.in[13]; const float* final_norm = args.in[17];
    bf16_t* H = (bf16_t*)(ws + WS_H); bf16_t* XS = (bf16_t*)(ws + WS_XS); float* GLR = (float*)(ws + WS_GLR);
    bf16_t* Z = (bf16_t*)(ws + WS_Z); bf16_t* DP = (bf16_t*)(ws + WS_DP); bf16_t* MIX = (bf16_t*)(ws + WS_MIX);
    bf16_t* CS = (bf16_t*)(ws + WS_CS); bf16_t* SP = (bf16_t*)(ws + WS_SP); float* DEC = (float*)(ws + WS_DEC);
    bf16_t* ACT = (bf16_t*)(ws + WS_ACT); bf16_t* HS = (bf16_t*)(ws + WS_HS); bf16_t* ACT2 = (bf16_t*)(ws + WS_ACT2); bf16_t* Y = (bf16_t*)(ws + WS_Y);
    int* topi = (int*)(ws + WS_ROUTE + RT_TOPI); float* topw = (float*)(ws + WS_ROUTE + RT_TOPW); int* tok_slot = (int*)(ws + WS_ROUTE + RT_TOKSLOT);
    int* hist = (int*)(ws + WS_ROUTE + RT_HIST); int* blk_expert = (int*)(ws + WS_ROUTE + RT_BLKE); int* nrb_p = (int*)(ws + WS_ROUTE + RT_NRB);

    if (IN(PH_PRO)) {
        CvtPtrs P; P.w_in = w_in; P.w_pool = args.in[3]; P.w_out = args.in[8]; P.dwg = args.in[10]; P.dwu = args.in[11]; P.dwd = args.in[12];
        P.ewg = args.in[14]; P.ewu = args.in[15]; P.ewd = args.in[16]; P.ws = ws;
        LAS float* scr = (LAS float*)(lds + wave * 17408);
        const int gw = blockIdx.x * 8 + wave, NGW = G * 8;
        CVTCALL({ const int nit = args.cvt_items;
            if (gw < nit) { f32x4 va[16], vb[16]; CvtJob ja = cvt_decode(P, gw), jb; cvt_load(ja, va, lane);
                _Pragma("unroll 1") for (int it = gw; it < nit; it += 2 * NGW) {
                    const int i2 = it + NGW, i3 = i2 + NGW;
                    jb = cvt_decode(P, i2 < nit ? i2 : nit - 1); cvt_load(jb, vb, lane);
                    cvt_finish(ja, va, scr, lane);
                    ja = cvt_decode(P, i3 < nit ? i3 : nit - 1); cvt_load(ja, va, lane);
                    if (i2 < nit) cvt_finish(jb, vb, scr, lane);
                } } })
        __syncthreads();
        NORMCALL(norm_phase<0, false, false>(lds, x, mix_norm, H, w_in + 3072, ZW, GLR, nullptr, nullptr, nullptr, tid, lane, wave, G);)
    }
    SEAM(PH_PRO);

    { constexpr int l = 0;
        const int pb = 1 + PH_PER_LAYER * l;
        if (IN(pb + PK_INPROJ)) {
            pg8::Gemm g{TILE_H ? 64 : 2048, 64, 2048, 0, 0, TILE_H ? 32768 : 128, 32768}; pg8::Order<false> S; S.init(T / 256, 16, G, (int)blockIdx.x);
            S.A = (const char*)H; S.B = (const char*)(ws + WS_WIN) + (size_t)l * 4096 * 2048 * 2; S.a_pm = (size_t)256 * 2048 * 2; S.a_pn = 0; S.b_pn = (size_t)256 * 2048 * 2; S.b_e = 0; S.blk_expert = nullptr;
            pg8::EpiBf16 E{Z, 4096, nullptr};
            GEMMCALL(pg8::gemm_phase<pg8::EpiBf16, pg8::Order<false>, GEMM_ALIGN, GEMM_SP2>(lds, g, S, E);)
        }
        SEAM(pb + PK_INPROJ);
        if (IN(pb + PK_PRE)) {
            PRECALL(pool_d_phase(Z, DP, tid, G);)
            PRECALL(gla_state_phase(lds, Z, GLR, w_gate_up + (size_t)l * 16 * 512, b_gate + l * 512, CS, DEC, tid, lane, wave, G);)
        }
        SEAM(pb + PK_PRE);
        if (IN(pb + PK_POOLSCAN)) {
            SCANCALL(gla_scan_phase(CS, DEC, SP, tid, G);)
            __syncthreads();
            pg8::Gemm g{1024, 64, 256, 0, 0, 128, 32768}; pg8::Order<false> S; S.init(T / 256, 4, G, (int)blockIdx.x);
            S.A = (const char*)DP; S.B = (const char*)(ws + WS_WPOOL) + (size_t)l * 4 * 65536 * 2; S.a_pm = (size_t)256 * 1024 * 2; S.a_pn = 256 * 2; S.b_pn = (size_t)65536 * 2; S.b_e = 0; S.blk_expert = nullptr;
            pg8::EpiBf16 E{MIX, 2048, pool_scale + l * 1024};
            GEMMCALL(pg8::gemm_phase<pg8::EpiBf16, pg8::Order<false>, GEMM_ALIGN, GEMM_SP2>(lds, g, S, E);)
        }
        SEAM(pb + PK_POOLSCAN);
        if (IN(pb + PK_GLAOUT)) OUTCALL(gla_out_phase(lds, Z, SP, gla_norm + l * 1024, MIX, tid, lane, wave, G);)
        SEAM(pb + PK_GLAOUT);
        if (IN(pb + PK_OUTPROJ)) {
            pg8::Gemm g{2048, 64, 2048, 0, 0, 128, 32768}; pg8::Order<false> S; S.init(T / 256, 8, G, (int)blockIdx.x);
            S.A = (const char*)MIX; S.B = (const char*)(ws + WS_WOUT) + (size_t)l * 2048 * 2048 * 2; S.a_pm = (size_t)256 * 2048 * 2; S.a_pn = 0; S.b_pn = (size_t)256 * 2048 * 2; S.b_e = 0; S.blk_expert = nullptr;
            pg8::EpiRes<l == 0> E{l == 0 ? (const void*)x : (const void*)XS, XS, 2048};
            GEMMCALL(pg8::gemm_phase<pg8::EpiRes<l == 0>, pg8::Order<false>, true, true>(lds, g, S, E);)
        }
        SEAM(pb + PK_OUTPROJ);
        if (IN(pb + PK_NORM2)) {
            if (l == 0) NORMCALL(norm_phase<1, DENSE_FP8 == 1>(lds, XS, ffn_norm, H, nullptr, 0, nullptr, nullptr, nullptr, nullptr, tid, lane, wave, G);)
            else NORMCALL(norm_phase<2>(lds, XS, ffn_norm + DM, H, w_router, 8, nullptr, topi, topw, hist, tid, lane, wave, G);)
        }
        SEAM(pb + PK_NORM2);
        if (l == 1) { if (IN(pb + PK_ASSIGN)) ASGCALL(assign_phase(lds, topi, hist, tok_slot, blk_expert, nrb_p, H, HS, tid, lane, wave, G);)
            SEAM(pb + PK_ASSIGN); }
        if (IN(pb + PK_UP)) {
            if (l == 0) {
#if DENSE_FP8 == 1
                pg8::Gemm g{1024, 64, 1024, 0, 0x7f7f7f77, 128, 32768}; pg8::Order<false> S; S.init(T / 256, 44, G, (int)blockIdx.x);
                S.A = (const char*)H; S.B = (const char*)(ws + WS_WGU); S.a_pm = (size_t)256 * 2048; S.a_pn = 0; S.b_pn = (size_t)256 * 2048; S.b_e = 0; S.blk_expert = nullptr;
                pg8::EpiSwigluF8 E{(unsigned char*)ACT, 44, 4.f};
                GEMMCALL(pg8::gemm_phase<pg8::EpiSwigluF8, pg8::Order<false>, GEMM_ALIGN, GEMM_SP2, 1>(lds, g, S, E);)
#else
                pg8::Gemm g{TILE_H ? 64 : 2048, 64, 2048, 0, 0, TILE_H ? 32768 : 128, 32768}; pg8::Order<false> S; S.init(T / 256, 44, G, (int)blockIdx.x);
                S.A = (const char*)H; S.B = (const char*)(ws + WS_WGU); S.a_pm = (size_t)256 * 2048 * 2; S.a_pn = 0; S.b_pn = (size_t)256 * 2048 * 2; S.b_e = 0; S.blk_expert = nullptr;
#if DENSE_FP8 == 2
                pg8::EpiSwigluF8S E{(unsigned char*)ACT, 44, 4.f};
                GEMMCALL(pg8::gemm_phase<pg8::EpiSwigluF8S, pg8::Order<false>, true, GEMM_SP2>(lds, g, S, E);)
#else
                pg8::EpiSwiglu E{ACT, TILE_ACT ? 88 : -11264};
                GEMMCALL(pg8::gemm_phase<pg8::EpiSwiglu, pg8::Order<false>, GEMM_ALIGN, GEMM_SP2>(lds, g, S, E);)
#endif
#endif
            } else {
                const int nrb = __builtin_amdgcn_readfirstlane(__hip_atomic_load(nrb_p, RLX_AGENT));
                pg8::Gemm g{TILE_HS ? 64 : 1024, TILE_EWGU ? 64 : 1024, 1024, 0, MOE_UP_FMT == 2 ? 0x7f7f7f78 : 0x7f7f7f77, TILE_HS ? 32768 : 128, TILE_EWGU ? 32768 : 128}; pg8::Order<true> S; S.init(nrb, 56, G, (int)blockIdx.x);
                S.A = (const char*)HS; S.B = (const char*)(ws + WS_EWGU); S.a_pm = (size_t)256 * 2048; S.a_pn = 0; S.b_pn = (size_t)256 * 2048; S.b_e = (size_t)14336 * 2048; S.blk_expert = blk_expert;
                pg8::EpiSwigluF8S E{(unsigned char*)ACT2, 56, 4.f};
                GEMMCALL(pg8::gemm_phase<pg8::EpiSwigluF8S, pg8::Order<true>, true, GEMM_SP2, MOE_UP_FMT>(lds, g, S, E);)
            }
        }
        SEAM(pb + PK_UP);
        if (IN(pb + PK_DOWN)) {
            if (l == 0) {
#if DENSE_FP8
                pg8::Gemm g{64, 64, 2816, 0, 0x7f7f7f76, 32768, 32768}; pg8::Order<false> S; S.init(T / 256, 8, G, (int)blockIdx.x);
                S.A = (const char*)ACT; S.B = (const char*)(ws + WS_WD); S.a_pm = (size_t)256 * 5632; S.a_pn = 0; S.b_pn = (size_t)256 * 5632; S.b_e = 0; S.blk_expert = nullptr;
                pg8::EpiRes<false> E{XS, XS, 2048};
                GEMMCALL(pg8::gemm_phase<pg8::EpiRes<false>, pg8::Order<false>, true, true, 1>(lds, g, S, E);)
#else
                pg8::Gemm g{TILE_ACT ? 64 : 5632, 64, 5632, 0, 0, TILE_ACT ? 32768 : 128, 32768}; pg8::Order<false> S; S.init(T / 256, 8, G, (int)blockIdx.x);
                S.A = (const char*)ACT; S.B = (const char*)(ws + WS_WD); S.a_pm = (size_t)256 * 5632 * 2; S.a_pn = 0; S.b_pn = (size_t)256 * 5632 * 2; S.b_e = 0; S.blk_expert = nullptr;
                pg8::EpiRes<false> E{XS, XS, 2048};
                GEMMCALL(pg8::gemm_phase<pg8::EpiRes<false>, pg8::Order<false>, true, true>(lds, g, S, E);)
#endif
            } else {
                const int nrb = __builtin_amdgcn_readfirstlane(__hip_atomic_load(nrb_p, RLX_AGENT));
                pg8::Gemm g{TILE_ACT2 ? 64 : 3584, 64, 3584, 0, 0x7f7f7f76, TILE_ACT2 ? 32768 : 128, 32768}; pg8::Order<true> S; S.init(nrb, 8, G, (int)blockIdx.x);
                S.A = (const char*)ACT2; S.B = (const char*)(ws + WS_EWD); S.a_pm = (size_t)256 * 7168; S.a_pn = 0; S.b_pn = (size_t)256 * 7168; S.b_e = (size_t)2048 * 7168; S.blk_expert = blk_expert;
                int full, tail, sk; moe_tail_split(nrb, G, full, tail, sk); S.Lend = full;
                pg8::EpiBf16 E{Y, 2048, nullptr};
                GEMMCALL(pg8::gemm_phase<pg8::EpiBf16, pg8::Order<true>, GEMM_ALIGN, GEMM_SP2, 1>(lds, g, S, E);)
                if (sk > 0) {
                    const int kq = 3584 / sk;
                    pg8::Gemm g2{TILE_ACT2 ? 64 : 3584, 64, kq, 0, 0x7f7f7f76, TILE_ACT2 ? 32768 : 128, 32768}; pg8::TailOrder S2; S2.nM = nrb; S2.nN = 8; S2.c = (int)blockIdx.x; S2.full = full; S2.tail = tail; S2.s = sk; S2.ksliceA = TILE_ACT2 ? (size_t)(kq / 64) * 32768 : (size_t)kq * 2; S2.ksliceB = (size_t)(kq / 64) * 32768;
                    S2.A = (const char*)ACT2; S2.B = (const char*)(ws + WS_EWD); S2.a_pm = (size_t)256 * 7168; S2.b_pn = (size_t)256 * 7168; S2.b_e = (size_t)2048 * 7168; S2.blk_expert = blk_expert;
                    pg8::EpiPart E2{(float*)(ws + WS_PART)};
                    GEMMCALL(pg8::gemm_phase<pg8::EpiPart, pg8::TailOrder, false, GEMM_SP2, 1>(lds, g2, S2, E2);)
                }
            }
        }
        SEAM(pb + PK_DOWN);
        if (IN(pb + PK_TAIL)) {
            if (l == 0) NORMCALL(norm_phase<0>(lds, XS, mix_norm + DM, H, w_in + (size_t)DM * ZW + 3072, ZW, GLR, nullptr, nullptr, nullptr, tid, lane, wave, G);)
            else FINCALL(final_phase(lds, XS, Y, (const float*)(ws + WS_PART), nrb_p, tok_slot, topw, final_norm, args.out, tid, lane, wave, G);)
        }
        if (l == 0) SEAM(pb + PK_TAIL);
    }
    { constexpr int l = 1;
        const int pb = 1 + PH_PER_LAYER * l;
        if (IN(pb + PK_INPROJ)) {
            pg8::Gemm g{TILE_H ? 64 : 2048, 64, 2048, 0, 0, TILE_H ? 32768 : 128, 32768}; pg8::Order<false> S; S.init(T / 256, 16, G, (int)blockIdx.x);
            S.A = (const char*)H; S.B = (const char*)(ws + WS_WIN) + (size_t)l * 4096 * 2048 * 2; S.a_pm = (size_t)256 * 2048 * 2; S.a_pn = 0; S.b_pn = (size_t)256 * 2048 * 2; S.b_e = 0; S.blk_expert = nullptr;
            pg8::EpiBf16 E{Z, 4096, nullptr};
            GEMMCALL(pg8::gemm_phase<pg8::EpiBf16, pg8::Order<false>, GEMM_ALIGN, GEMM_SP2>(lds, g, S, E);)
        }
        SEAM(pb + PK_INPROJ);
        if (IN(pb + PK_PRE)) {
            PRECALL(pool_d_phase(Z, DP, tid, G);)
            PRECALL(gla_state_phase(lds, Z, GLR, w_gate_up + (size_t)l * 16 * 512, b_gate + l * 512, CS, DEC, tid, lane, wave, G);)
        }
        SEAM(pb + PK_PRE);
        if (IN(pb + PK_POOLSCAN)) {
            SCANCALL(gla_scan_phase(CS, DEC, SP, tid, G);)
            __syncthreads();
            pg8::Gemm g{1024, 64, 256, 0, 0, 128, 32768}; pg8::Order<false> S; S.init(T / 256, 4, G, (int)blockIdx.x);
            S.A = (const char*)DP; S.B = (const char*)(ws + WS_WPOOL) + (size_t)l * 4 * 65536 * 2; S.a_pm = (size_t)256 * 1024 * 2; S.a_pn = 256 * 2; S.b_pn = (size_t)65536 * 2; S.b_e = 0; S.blk_expert = nullptr;
            pg8::EpiBf16 E{MIX, 2048, pool_scale + l * 1024};
            GEMMCALL(pg8::gemm_phase<pg8::EpiBf16, pg8::Order<false>, GEMM_ALIGN, GEMM_SP2>(lds, g, S, E);)
        }
        SEAM(pb + PK_POOLSCAN);
        if (IN(pb + PK_GLAOUT)) OUTCALL(gla_out_phase(lds, Z, SP, gla_norm + l * 1024, MIX, tid, lane, wave, G);)
        SEAM(pb + PK_GLAOUT);
        if (IN(pb + PK_OUTPROJ)) {
            pg8::Gemm g{2048, 64, 2048, 0, 0, 128, 32768}; pg8::Order<false> S; S.init(T / 256, 8, G, (int)blockIdx.x);
            S.A = (const char*)MIX; S.B = (const char*)(ws + WS_WOUT) + (size_t)l * 2048 * 2048 * 2; S.a_pm = (size_t)256 * 2048 * 2; S.a_pn = 0; S.b_pn = (size_t)256 * 2048 * 2; S.b_e = 0; S.blk_expert = nullptr;
            pg8::EpiRes<l == 0> E{l == 0 ? (const void*)x : (const void*)XS, XS, 2048};
            GEMMCALL(pg8::gemm_phase<pg8::EpiRes<l == 0>, pg8::Order<false>, true, true>(lds, g, S, E);)
        }
        SEAM(pb + PK_OUTPROJ);
        if (IN(pb + PK_NORM2)) {
            if (l == 0) NORMCALL(norm_phase<1, DENSE_FP8 == 1>(lds, XS, ffn_norm, H, nullptr, 0, nullptr, nullptr, nullptr, nullptr, tid, lane, wave, G);)
            else NORMCALL(norm_phase<2>(lds, XS, ffn_norm + DM, H, w_router, 8, nullptr, topi, topw, hist, tid, lane, wave, G);)
        }
        SEAM(pb + PK_NORM2);
        if (l == 1) { if (IN(pb + PK_ASSIGN)) ASGCALL(assign_phase(lds, topi, hist, tok_slot, blk_expert, nrb_p, H, HS, tid, lane, wave, G);)
            SEAM(pb + PK_ASSIGN); }
        if (IN(pb + PK_UP)) {
            if (l == 0) {
#if DENSE_FP8 == 1
                pg8::Gemm g{1024, 64, 1024, 0, 0x7f7f7f77, 128, 32768}; pg8::Order<false> S; S.init(T / 256, 44, G, (int)blockIdx.x);
                S.A = (const char*)H; S.B = (const char*)(ws + WS_WGU); S.a_pm = (size_t)256 * 2048; S.a_pn = 0; S.b_pn = (size_t)256 * 2048; S.b_e = 0; S.blk_expert = nullptr;
                pg8::EpiSwigluF8 E{(unsigned char*)ACT, 44, 4.f};
                GEMMCALL(pg8::gemm_phase<pg8::EpiSwigluF8, pg8::Order<false>, GEMM_ALIGN, GEMM_SP2, 1>(lds, g, S, E);)
#else
                pg8::Gemm g{TILE_H ? 64 : 2048, 64, 2048, 0, 0, TILE_H ? 32768 : 128, 32768}; pg8::Order<false> S; S.init(T / 256, 44, G, (int)blockIdx.x);
                S.A = (const char*)H; S.B = (const char*)(ws + WS_WGU); S.a_pm = (size_t)256 * 2048 * 2; S.a_pn = 0; S.b_pn = (size_t)256 * 2048 * 2; S.b_e = 0; S.blk_expert = nullptr;
#if DENSE_FP8 == 2
                pg8::EpiSwigluF8S E{(unsigned char*)ACT, 44, 4.f};
                GEMMCALL(pg8::gemm_phase<pg8::EpiSwigluF8S, pg8::Order<false>, true, GEMM_SP2>(lds, g, S, E);)
#else
                pg8::EpiSwiglu E{ACT, TILE_ACT ? 88 : -11264};
                GEMMCALL(pg8::gemm_phase<pg8::EpiSwiglu, pg8::Order<false>, GEMM_ALIGN, GEMM_SP2>(lds, g, S, E);)
#endif
#endif
            } else {
                const int nrb = __builtin_amdgcn_readfirstlane(__hip_atomic_load(nrb_p, RLX_AGENT));
                pg8::Gemm g{TILE_HS ? 64 : 1024, TILE_EWGU ? 64 : 1024, 1024, 0, MOE_UP_FMT == 2 ? 0x7f7f7f78 : 0x7f7f7f77, TILE_HS ? 32768 : 128, TILE_EWGU ? 32768 : 128}; pg8::Order<true> S; S.init(nrb, 56, G, (int)blockIdx.x);
                S.A = (const char*)HS; S.B = (const char*)(ws + WS_EWGU); S.a_pm = (size_t)256 * 2048; S.a_pn = 0; S.b_pn = (size_t)256 * 2048; S.b_e = (size_t)14336 * 2048; S.blk_expert = blk_expert;
                pg8::EpiSwigluF8S E{(unsigned char*)ACT2, 56, 4.f};
#ifdef KPROBE
                if (args.pad) { GEMMCALL(pg8::gemm_phase<pg8::EpiSwigluF8S, pg8::Order<true>, true, GEMM_SP2, MOE_UP_FMT, KPROBE>(lds, g, S, E);) } else
#endif
                GEMMCALL(pg8::gemm_phase<pg8::EpiSwigluF8S, pg8::Order<true>, true, GEMM_SP2, MOE_UP_FMT>(lds, g, S, E);)
            }
        }
        SEAM(pb + PK_UP);
        if (IN(pb + PK_DOWN)) {
            if (l == 0) {
#if DENSE_FP8
                pg8::Gemm g{64, 64, 2816, 0, 0x7f7f7f76, 32768, 32768}; pg8::Order<false> S; S.init(T / 256, 8, G, (int)blockIdx.x);
                S.A = (const char*)ACT; S.B = (const char*)(ws + WS_WD); S.a_pm = (size_t)256 * 5632; S.a_pn = 0; S.b_pn = (size_t)256 * 5632; S.b_e = 0; S.blk_expert = nullptr;
                pg8::EpiRes<false> E{XS, XS, 2048};
                GEMMCALL(pg8::gemm_phase<pg8::EpiRes<false>, pg8::Order<false>, true, true, 1>(lds, g, S, E);)
#else
                pg8::Gemm g{TILE_ACT ? 64 : 5632, 64, 5632, 0, 0, TILE_ACT ? 32768 : 128, 32768}; pg8::Order<false> S; S.init(T / 256, 8, G, (int)blockIdx.x);
                S.A = (const char*)ACT; S.B = (const char*)(ws + WS_WD); S.a_pm = (size_t)256 * 5632 * 2; S.a_pn = 0; S.b_pn = (size_t)256 * 5632 * 2; S.b_e = 0; S.blk_expert = nullptr;
                pg8::EpiRes<false> E{XS, XS, 2048};
                GEMMCALL(pg8::gemm_phase<pg8::EpiRes<false>, pg8::Order<false>, true, true>(lds, g, S, E);)
#endif
            } else {
                const int nrb = __builtin_amdgcn_readfirstlane(__hip_atomic_load(nrb_p, RLX_AGENT));
                pg8::Gemm g{TILE_ACT2 ? 64 : 3584, 64, 3584, 0, 0x7f7f7f76, TILE_ACT2 ? 32768 : 128, 32768}; pg8::Order<true> S; S.init(nrb, 8, G, (int)blockIdx.x);
                S.A = (const char*)ACT2; S.B = (const char*)(ws + WS_EWD); S.a_pm = (size_t)256 * 7168; S.a_pn = 0; S.b_pn = (size_t)256 * 7168; S.b_e = (size_t)2048 * 7168; S.blk_expert = blk_expert;
                int full, tail, sk; moe_tail_split(nrb, G, full, tail, sk); S.Lend = full;
                pg8::EpiBf16 E{Y, 2048, nullptr};
                GEMMCALL(pg8::gemm_phase<pg8::EpiBf16, pg8::Order<true>, GEMM_ALIGN, GEMM_SP2, 1>(lds, g, S, E);)
                if (sk > 0) {
                    const int kq = 3584 / sk;
                    pg8::Gemm g2{TILE_ACT2 ? 64 : 3584, 64, kq, 0, 0x7f7f7f76, TILE_ACT2 ? 32768 : 128, 32768}; pg8::TailOrder S2; S2.nM = nrb; S2.nN = 8; S2.c = (int)blockIdx.x; S2.full = full; S2.tail = tail; S2.s = sk; S2.ksliceA = TILE_ACT2 ? (size_t)(kq / 64) * 32768 : (size_t)kq * 2; S2.ksliceB = (size_t)(kq / 64) * 32768;
                    S2.A = (const char*)ACT2; S2.B = (const char*)(ws + WS_EWD); S2.a_pm = (size_t)256 * 7168; S2.b_pn = (size_t)256 * 7168; S2.b_e = (size_t)2048 * 7168; S2.blk_expert = blk_expert;
                    pg8::EpiPart E2{(float*)(ws + WS_PART)};
                    GEMMCALL(pg8::gemm_phase<pg8::EpiPart, pg8::TailOrder, false, GEMM_SP2, 1>(lds, g2, S2, E2);)
                }
            }
        }
        SEAM(pb + PK_DOWN);
        if (IN(pb + PK_TAIL)) {
            if (l == 0) NORMCALL(norm_phase<0>(lds, XS, mix_norm + DM, H, w_in + (size_t)DM * ZW + 3072, ZW, GLR, nullptr, nullptr, nullptr, tid, lane, wave, G);)
            else FINCALL(final_phase(lds, XS, Y, (const float*)(ws + WS_PART), nrb_p, tok_slot, topw, final_norm, args.out, tid, lane, wave, G);)
        }
        if (l == 0) SEAM(pb + PK_TAIL);
    }
#undef IN
#undef SEAM
}
}
#ifndef MK_MODE
#define MK_MODE 0
#endif
#ifndef DBG_CUT
#define DBG_CUT 0
#endif
namespace dbg {
using fz::bf16_t;
__global__ __launch_bounds__(256) void k_cvt_z(const bf16_t* Z, const float* GLR, float* z) {
    const size_t i = (size_t)blockIdx.x * 256 + threadIdx.x; if (i >= (size_t)T * ZW) return;
    const int t = (int)(i / ZW), c = (int)(i % ZW);
    float v;
    if (c < 3072) v = fz::bf2f(Z[(size_t)t * 4096 + c]); else if (c < 3088) v = GLR[(size_t)t * 16 + (c - 3072)]; else v = fz::bf2f(Z[(size_t)t * 4096 + c - 16]);
    z[i] = v;
}
__global__ __launch_bounds__(256) void k_cvt_bf(const bf16_t* in, float* out, size_t n) {
    const size_t i = (size_t)blockIdx.x * 256 + threadIdx.x; if (i < n) out[i] = fz::bf2f(in[i]);
}
}

static void launch_fused(const fz::Args& base, int lo, int hi, int grid, hipStream_t stream) {
    fz::Args a = base; a.ph_lo = lo; a.ph_hi = hi;
    hipLaunchKernelGGL(fz::fwd, dim3(grid), dim3(fz::NTHR), fz::LDS_BYTES, stream, a);
}

extern "C" void kernel_launch(void* const* d_in, const int* in_sizes, int n_in, void* d_out, int out_size, void* d_ws, size_t ws_size, hipStream_t stream) {
    static int grid = 0;
    if (grid == 0) {
        int dev = 0, cus = 0;
        if (hipGetDevice(&dev) != hipSuccess || hipDeviceGetAttribute(&cus, hipDeviceAttributeMultiprocessorCount, dev) != hipSuccess) { grid = -1; return; }
        if (hipFuncSetAttribute((const void*)fz::fwd, hipFuncAttributeMaxDynamicSharedMemorySize, fz::LDS_BYTES) != hipSuccess) { fprintf(stderr, "hipFuncSetAttribute failed\n"); grid = -1; return; }
        int per_cu = 0;
        if (hipOccupancyMaxActiveBlocksPerMultiprocessor(&per_cu, (const void*)fz::fwd, fz::NTHR, fz::LDS_BYTES) != hipSuccess || per_cu < 1) fprintf(stderr, "occupancy query: %d\n", per_cu);
        (void)hipGetLastError();
        grid = cus;
        if (ws_size < fz::WS_END) { fprintf(stderr, "workspace too small\n"); grid = -1; return; }
    }
    if (grid < 0) return;
    unsigned char* ws = (unsigned char*)d_ws;
    (void)hipMemsetAsync(ws + fz::WS_CTL + (size_t)fz::CW_BAR * 4, 0, 16384, stream);
    fz::Args a{};
    for (int i = 0; i < 18; ++i) a.in[i] = (const float*)d_in[i];
    a.out = (float*)d_out; a.ws = ws; a.cvt_items = fz::CI_TOTAL;
#if MK_MODE == 0
    launch_fused(a, 0, fz::NPH, grid, stream);
#elif MK_MODE == 1
    for (int p = 0; p < fz::NPH; ++p) { if (p == 1 + fz::PK_ASSIGN) continue;
#ifdef KPROBE
        if (p == KPROBE_PHASE) { fz::Args b = a; b.pad = 1; for (int rr = 0; rr < KPROBE_N; ++rr) launch_fused(b, p, p + 1, grid, stream); }
#endif
        launch_fused(a, p, p + 1, grid, stream);
#ifdef REP_HI
#ifndef REP_N
#define REP_N 1
#endif
        if (p == REP_HI) for (int rr = 0; rr < REP_N; ++rr) for (int q = REP_LO; q <= REP_HI; ++q) { if (q == 1 + fz::PK_ASSIGN) continue; launch_fused(a, q, q + 1, grid, stream); }
#endif
    }
#elif MK_MODE == 2
    {
        const int l = DBG_CUT / 10, kind = DBG_CUT % 10; const int pb = 1 + fz::PH_PER_LAYER * l;
        const int pcut = kind == 1 ? pb + 1 : kind == 2 ? pb + 4 : kind == 3 ? pb + 5 : kind == 4 ? pb + 6 : pb + 9;
        const int scut = kind == 1 ? 7 * l + 2 : kind == 2 ? 7 * l + 4 : kind == 3 ? 7 * l + 5 : kind == 4 ? 7 * l + 6 : 7 * l + 7;
        a.cvt_items = fz::CI_NONEXP;
        for (int p = 0; p < pcut; ++p) { if (p == 1 + fz::PK_ASSIGN) continue; launch_fused(a, p, p + 1, grid, stream); }
        ora::Bufs B = ora::make_bufs(ws + fz::WS_EWGU, (float*)(ws + fz::WS_XS));
        if (kind == 1) hipLaunchKernelGGL(dbg::k_cvt_z, dim3((unsigned)(((size_t)T * ZW + 255) / 256)), dim3(256), 0, stream, (const fz::bf16_t*)(ws + fz::WS_Z), (const float*)(ws + fz::WS_GLR), B.z);
        if (kind == 2) hipLaunchKernelGGL(dbg::k_cvt_bf, dim3((unsigned)(((size_t)T * 2048 + 255) / 256)), dim3(256), 0, stream, (const fz::bf16_t*)(ws + fz::WS_MIX), B.mixf, (size_t)T * 2048);
        if (kind == 4) hipLaunchKernelGGL(dbg::k_cvt_bf, dim3((unsigned)(((size_t)T * 2048 + 255) / 256)), dim3(256), 0, stream, (const fz::bf16_t*)(ws + fz::WS_H), B.hf, (size_t)T * 2048);
        ora::run_range(d_in, (float*)d_out, B, scut, 15, stream);
    }
#elif MK_MODE == 3
    {
        const int scut = DBG_CUT; const int pcut = scut == 5 ? 1 + fz::PK_NORM2 : scut == 7 ? 1 + fz::PK_TAIL : 1 + fz::PH_PER_LAYER + fz::PK_NORM2;
        ora::Bufs B = ora::make_bufs(ws + fz::WS_EWGU, (float*)(ws + fz::WS_XS));
        ora::run_range(d_in, (float*)d_out, B, 0, scut, stream);
        launch_fused(a, 0, 1, grid, stream);
        for (int p = pcut; p < fz::NPH; ++p) { if (p == 1 + fz::PK_ASSIGN) continue; launch_fused(a, p, p + 1, grid, stream); }
    }
#endif
}
```

```cpp
#include <hip/hip_runtime.h>
#include <cstdio>
#include <cstdint>
constexpr int T = 16384, DM = 2048, ZW = 4112;
constexpr float EPSF = 1e-6f;
constexpr int LSLOT = 34816, NRB_MAX = 136;
#ifndef DENSE_FP8
#define DENSE_FP8 2
#endif
#ifndef GEMM_SP2
#define GEMM_SP2 true
#endif
#ifndef GEMM_KM
#define GEMM_KM 0x240000
#endif
#ifndef GEMM_FP6_NOPRIO
#define GEMM_FP6_NOPRIO 0
#endif
#ifndef GEMM_SADDR
#define GEMM_SADDR 4
#endif
#ifndef GEMM_BPF
#define GEMM_BPF 0
#endif
#ifndef GEMM_ALIGN
#define GEMM_ALIGN false
#endif
#ifndef TILE_EWGU
#define TILE_EWGU 1
#endif
#ifndef TILE_ACT2
#define TILE_ACT2 1
#endif
#ifndef TILE_H
#define TILE_H 0
#endif
#ifndef TILE_ACT
#define TILE_ACT 1
#endif
#ifndef TILE_HS
#define TILE_HS 1
#endif
#ifndef MOE_UP_FMT
#define MOE_UP_FMT 2
#endif
#define MK_MODE 0
#define DBG_CUT 0
namespace pg8 {
#define PG8_LAS __attribute__((address_space(3)))
typedef unsigned short bf16_t;
typedef short bf16x8 __attribute__((ext_vector_type(8)));
typedef float f32x4 __attribute__((ext_vector_type(4)));
typedef unsigned u32x4 __attribute__((ext_vector_type(4)));
constexpr int BM = 256, BK = 64, HALF = 128, HTB = HALF * BK * 2, STAGE_BYTES = 8 * HTB, NXCD = 8, WGM = 8;

__host__ __device__ __forceinline__ int lds_byte(int r, int c) { const int st = (r >> 4) * 2 + (c >> 5), rr = r & 15, cc = c & 31, ob = rr * 64 + cc * 2; return st * 1024 + (ob ^ (((ob >> 9) & 1) << 5)); }
__host__ __device__ __forceinline__ void stage_rc(int b, int& R, int& C) { const int st = b / 1024, sb = b % 1024, swz = sb ^ (((sb >> 9) & 1) << 5); R = (st >> 1) * 16 + swz / 64; C = (st & 1) * 32 + (swz % 64) / 2; }
__host__ __device__ __forceinline__ int perm32(int rho) { const int n = rho >> 4, i = rho & 15; return 8 * (i >> 2) + 4 * n + (i & 3); }

struct Unit { int pm, pn; const char* a; const char* b; };
struct Gemm { int lda, ldb, K; int sA, sB; int kstepA, kstepB; };
typedef int i32x8 __attribute__((ext_vector_type(8)));
typedef int i32x4 __attribute__((ext_vector_type(4)));
typedef int i32x6 __attribute__((ext_vector_type(6)));
typedef int i32x2 __attribute__((ext_vector_type(2)));

__device__ __forceinline__ void unit_map(long L, int nM, int nN, int& pm, int& pn) {
    const int nwg = nM * nN; int wgid = (int)L; { const int q = nwg / NXCD, r = nwg % NXCD, xcd = wgid % NXCD, off = wgid / NXCD; wgid = (xcd < r ? xcd * (q + 1) : r * (q + 1) + (xcd - r) * q) + off; }
    const int nig = WGM * nN, gid = wgid / nig, fm = gid * WGM, gsz = (nM - fm) < WGM ? (nM - fm) : WGM;
    pm = fm + ((wgid % nig) % gsz); pn = (wgid % nig) / gsz;
}
template <bool MOE> struct Order {
    int nM, nN, nwg, G, c; long Lend;
    const char* A; const char* B; size_t a_pm, a_pn, b_pn, b_e; const int* blk_expert;
    __device__ void init(int nM_, int nN_, int G_, int c_) { nM = nM_; nN = nN_; nwg = nM * nN; G = G_; c = c_; Lend = nwg; }
    __device__ __forceinline__ bool next(int i, Unit& u) const {
        const long L = (long)i * G + c; if (L >= Lend) return false;
        unit_map(L, nM, nN, u.pm, u.pn);
        u.a = A + (size_t)u.pm * a_pm + (size_t)u.pn * a_pn;
        u.b = B + (size_t)u.pn * b_pn;
        if (MOE) { const int e = __builtin_amdgcn_readfirstlane(__hip_atomic_load(blk_expert + u.pm, __ATOMIC_RELAXED, __HIP_MEMORY_SCOPE_AGENT)); u.b += (size_t)e * b_e; }
        return true;
    }
    __device__ __forceinline__ void a_ready(const Unit&) const {}
    __device__ __forceinline__ void done(const Unit&) const {}
};
struct TailOrder {
    int nM, nN, c, full, tail, s; size_t ksliceA, ksliceB;
    const char* A; const char* B; size_t a_pm, b_pn, b_e; const int* blk_expert;
    __device__ __forceinline__ bool next(int i, Unit& u) const {
        if (i > 0 || c >= tail * s) return false;
        const int t = c / s, sl = c % s; int pm, pn; unit_map((long)full + t, nM, nN, pm, pn);
        const int e = __builtin_amdgcn_readfirstlane(__hip_atomic_load(blk_expert + pm, __ATOMIC_RELAXED, __HIP_MEMORY_SCOPE_AGENT));
        u.pm = c; u.pn = 0; u.a = A + (size_t)pm * a_pm + (size_t)sl * ksliceA; u.b = B + (size_t)pn * b_pn + (size_t)e * b_e + (size_t)sl * ksliceB;
        return true;
    }
    __device__ __forceinline__ void a_ready(const Unit&) const {}
    __device__ __forceinline__ void done(const Unit&) const {}
};

__device__ __forceinline__ unsigned cvt_pk_bf16(float lo, float hi) { unsigned r; asm volatile("v_cvt_pk_bf16_f32 %0, %1, %2" : "=v"(r) : "v"(lo), "v"(hi)); return r; }
__device__ __forceinline__ float silu_f(float x) { return x * __builtin_amdgcn_rcpf(1.0f + __builtin_amdgcn_exp2f(-1.4426950408889634f * x)); }

struct EpiBf16 {
    static constexpr bool PERM = true, AFTER_DRAIN = false;
    bf16_t* O; int ldc; const float* scale;
    __device__ __forceinline__ void operator()(const f32x4 (&acc)[2][2][4][2], const Unit& u, int wr, int wc, int fr, int fq) const {
        const int row0 = u.pm * BM + wr * 64 + fr, col0 = u.pn * BM + wc * 32 + 8 * fq;
        f32x4 sv[2][2];
#pragma unroll
        for (int bj = 0; bj < 2; ++bj)
#pragma unroll
            for (int n = 0; n < 2; ++n) sv[bj][n] = scale ? *(const f32x4*)(scale + col0 + bj * HALF + 4 * n) : (f32x4){1.f, 1.f, 1.f, 1.f};
#pragma unroll
        for (int ai = 0; ai < 2; ++ai)
#pragma unroll
            for (int m = 0; m < 4; ++m) { bf16_t* rowp = O + (size_t)(row0 + ai * HALF + m * 16) * ldc + col0;
#pragma unroll
                for (int bj = 0; bj < 2; ++bj) { const f32x4 v0 = acc[ai][bj][m][0] * sv[bj][0], v1 = acc[ai][bj][m][1] * sv[bj][1];
                    u32x4 w; w.x = cvt_pk_bf16(v0[0], v0[1]); w.y = cvt_pk_bf16(v0[2], v0[3]); w.z = cvt_pk_bf16(v1[0], v1[1]); w.w = cvt_pk_bf16(v1[2], v1[3]);
                    *(u32x4*)(rowp + bj * HALF) = w; } }
    }
};
template <bool F32IN> struct EpiRes {
    static constexpr bool PERM = true, AFTER_DRAIN = false;
    const void* base; bf16_t* out; int ldc;
    __device__ __forceinline__ void operator()(const f32x4 (&acc)[2][2][4][2], const Unit& u, int wr, int wc, int fr, int fq) const {
        const int row0 = u.pm * BM + wr * 64 + fr, col0 = u.pn * BM + wc * 32 + 8 * fq;
        if constexpr (!F32IN) {
            u32x4 q[2][4][2];
#pragma unroll
            for (int ai = 0; ai < 2; ++ai)
#pragma unroll
                for (int m = 0; m < 4; ++m)
#pragma unroll
                    for (int bj = 0; bj < 2; ++bj) q[ai][m][bj] = *(const u32x4*)((const bf16_t*)base + (size_t)(row0 + ai * HALF + m * 16) * ldc + col0 + bj * HALF);
#pragma unroll
            for (int ai = 0; ai < 2; ++ai)
#pragma unroll
                for (int m = 0; m < 4; ++m)
#pragma unroll
                    for (int bj = 0; bj < 2; ++bj) { const u32x4 t = q[ai][m][bj];
                        const f32x4 v0 = (f32x4){__uint_as_float(t.x << 16), __uint_as_float(t.x & 0xffff0000u), __uint_as_float(t.y << 16), __uint_as_float(t.y & 0xffff0000u)} + acc[ai][bj][m][0];
                        const f32x4 v1 = (f32x4){__uint_as_float(t.z << 16), __uint_as_float(t.z & 0xffff0000u), __uint_as_float(t.w << 16), __uint_as_float(t.w & 0xffff0000u)} + acc[ai][bj][m][1];
                        u32x4 w; w.x = cvt_pk_bf16(v0[0], v0[1]); w.y = cvt_pk_bf16(v0[2], v0[3]); w.z = cvt_pk_bf16(v1[0], v1[1]); w.w = cvt_pk_bf16(v1[2], v1[3]);
                        *(u32x4*)(out + (size_t)(row0 + ai * HALF + m * 16) * ldc + col0 + bj * HALF) = w; }
        } else {
#pragma unroll
            for (int ai = 0; ai < 2; ++ai) {
                f32x4 b0[4][2], b1[4][2];
#pragma unroll
                for (int m = 0; m < 4; ++m)
#pragma unroll
                    for (int bj = 0; bj < 2; ++bj) { const float* bp = (const float*)base + (size_t)(row0 + ai * HALF + m * 16) * ldc + col0 + bj * HALF; b0[m][bj] = *(const f32x4*)bp; b1[m][bj] = *(const f32x4*)(bp + 4); }
#pragma unroll
                for (int m = 0; m < 4; ++m)
#pragma unroll
                    for (int bj = 0; bj < 2; ++bj) { const f32x4 v0 = b0[m][bj] + acc[ai][bj][m][0], v1 = b1[m][bj] + acc[ai][bj][m][1];
                        u32x4 w; w.x = cvt_pk_bf16(v0[0], v0[1]); w.y = cvt_pk_bf16(v0[2], v0[3]); w.z = cvt_pk_bf16(v1[0], v1[1]); w.w = cvt_pk_bf16(v1[2], v1[3]);
                        *(u32x4*)(out + (size_t)(row0 + ai * HALF + m * 16) * ldc + col0 + bj * HALF) = w; }
                asm volatile("" ::: "memory"); }
        }
    }
};
struct EpiPart {
    static constexpr bool PERM = false, AFTER_DRAIN = false;
    float* P;
    __device__ __forceinline__ void operator()(const f32x4 (&acc)[2][2][4][2], const Unit& u, int wr, int wc, int fr, int fq) const {
        float* base = P + (size_t)u.pm * 65536 + (size_t)(wr * 64 + fr) * 256 + wc * 32 + 4 * fq;
#pragma unroll
        for (int ai = 0; ai < 2; ++ai)
#pragma unroll
            for (int m = 0; m < 4; ++m)
#pragma unroll
                for (int bj = 0; bj < 2; ++bj)
#pragma unroll
                    for (int n = 0; n < 2; ++n) *(f32x4*)(base + (size_t)(ai * HALF + m * 16) * 256 + bj * HALF + n * 16) = acc[ai][bj][m][n];
    }
};
struct EpiSwiglu {
    static constexpr bool PERM = true, AFTER_DRAIN = false;
    bf16_t* O; int kt_per_panel;
    __device__ __forceinline__ void operator()(const f32x4 (&acc)[2][2][4][2], const Unit& u, int wr, int wc, int fr, int fq) const {
        const size_t rp = kt_per_panel > 0 ? (size_t)128 : (size_t)(-kt_per_panel);
        unsigned char* blk = kt_per_panel > 0 ? (unsigned char*)O + ((size_t)u.pm * kt_per_panel + u.pn * 2 + (wc >> 1)) * 32768 + (size_t)(wr * 64 + fr) * 128 + ((wc & 1) * 32 + 8 * fq) * 2
                                              : (unsigned char*)O + (size_t)(u.pm * BM + wr * 64 + fr) * rp + (u.pn * HALF + wc * 32 + 8 * fq) * 2;
#pragma unroll
        for (int ai = 0; ai < 2; ++ai)
#pragma unroll
            for (int m = 0; m < 4; ++m) { unsigned char* rowp = blk + (size_t)(ai * HALF + m * 16) * rp;
                const f32x4 g0 = acc[ai][0][m][0], g1 = acc[ai][0][m][1], u0 = acc[ai][1][m][0], u1 = acc[ai][1][m][1];
                u32x4 w; w.x = cvt_pk_bf16(silu_f(g0[0]) * u0[0], silu_f(g0[1]) * u0[1]); w.y = cvt_pk_bf16(silu_f(g0[2]) * u0[2], silu_f(g0[3]) * u0[3]);
                w.z = cvt_pk_bf16(silu_f(g1[0]) * u1[0], silu_f(g1[1]) * u1[1]); w.w = cvt_pk_bf16(silu_f(g1[2]) * u1[2], silu_f(g1[3]) * u1[3]);
                *(u32x4*)rowp = w; }
    }
};
struct EpiSwigluF8 {
    static constexpr bool PERM = true, AFTER_DRAIN = false;
    unsigned char* O; int kt_per_panel; float osc;
    __device__ __forceinline__ static float cl(float v) { return __builtin_fminf(__builtin_fmaxf(v, -448.f), 448.f); }
    __device__ __forceinline__ void operator()(const f32x4 (&acc)[2][2][4][2], const Unit& u, int wr, int wc, int fr, int fq) const {
        const size_t rp = kt_per_panel > 0 ? (size_t)128 : (size_t)(-kt_per_panel);
        unsigned char* blk = kt_per_panel > 0 ? O + ((size_t)u.pm * kt_per_panel + u.pn) * 32768 + (size_t)(wr * 64 + fr) * 128 + wc * 32 + 8 * fq
                                              : O + (size_t)(u.pm * BM + wr * 64 + fr) * rp + u.pn * HALF + wc * 32 + 8 * fq;
#pragma unroll
        for (int ai = 0; ai < 2; ++ai)
#pragma unroll
            for (int m = 0; m < 4; ++m) { unsigned char* rowp = blk + (size_t)(ai * HALF + m * 16) * rp;
                const f32x4 g0 = acc[ai][0][m][0], g1 = acc[ai][0][m][1], u0 = acc[ai][1][m][0], u1 = acc[ai][1][m][1];
                float v[8];
#pragma unroll
                for (int i = 0; i < 4; ++i) { v[i] = cl(silu_f(g0[i]) * u0[i] * osc); v[4 + i] = cl(silu_f(g1[i]) * u1[i] * osc); }
                int w0 = 0, w1 = 0;
                w0 = __builtin_amdgcn_cvt_pk_fp8_f32(v[0], v[1], w0, false); w0 = __builtin_amdgcn_cvt_pk_fp8_f32(v[2], v[3], w0, true);
                w1 = __builtin_amdgcn_cvt_pk_fp8_f32(v[4], v[5], w1, false); w1 = __builtin_amdgcn_cvt_pk_fp8_f32(v[6], v[7], w1, true);
                typedef int i32x2v __attribute__((ext_vector_type(2)));
                *(i32x2v*)rowp = (i32x2v){w0, w1}; }
    }
};

struct EpiSwigluF8S {
    static constexpr bool PERM = true, AFTER_DRAIN = false, STAGED = true;
    unsigned char* O; int kt_per_panel; float osc;
    __device__ __forceinline__ static float cl(float v) { return __builtin_fminf(__builtin_fmaxf(v, -448.f), 448.f); }
    __device__ __forceinline__ void staged(const f32x4 (&acc)[2][2][4][2], const Unit& u, int wr, int wc, int fr, int fq, PG8_LAS unsigned char* stg, int wid, int lane) const {
        constexpr int SP = 144;
        unsigned char* blk = O + ((size_t)u.pm * kt_per_panel + u.pn) * 32768;
        typedef int i32x2v __attribute__((ext_vector_type(2)));
#pragma unroll
        for (int ai = 0; ai < 2; ++ai) {
#pragma unroll
            for (int m = 0; m < 4; ++m) {
                const f32x4 g0 = acc[ai][0][m][0], g1 = acc[ai][0][m][1], u0 = acc[ai][1][m][0], u1 = acc[ai][1][m][1];
                float v[8];
#pragma unroll
                for (int i = 0; i < 4; ++i) { v[i] = cl(silu_f(g0[i]) * u0[i] * osc); v[4 + i] = cl(silu_f(g1[i]) * u1[i] * osc); }
                int w0 = 0, w1 = 0;
                w0 = __builtin_amdgcn_cvt_pk_fp8_f32(v[0], v[1], w0, false); w0 = __builtin_amdgcn_cvt_pk_fp8_f32(v[2], v[3], w0, true);
                w1 = __builtin_amdgcn_cvt_pk_fp8_f32(v[4], v[5], w1, false); w1 = __builtin_amdgcn_cvt_pk_fp8_f32(v[6], v[7], w1, true);
                *(PG8_LAS i32x2v*)(stg + (wr * 64 + m * 16 + fr) * SP + wc * 32 + 8 * fq) = (i32x2v){w0, w1}; }
            asm volatile("s_waitcnt lgkmcnt(0)" ::: "memory"); __builtin_amdgcn_s_barrier(); asm volatile("" ::: "memory");
            u32x4 t[2];
#pragma unroll
            for (int i = 0; i < 2; ++i) t[i] = *(const PG8_LAS u32x4*)(stg + (wid * 16 + (lane >> 3) + 8 * i) * SP + 16 * (lane & 7));
#pragma unroll
            for (int i = 0; i < 2; ++i) *(u32x4*)(blk + (size_t)(ai * HALF + wid * 16 + (lane >> 3) + 8 * i) * 128 + 16 * (lane & 7)) = t[i];
            asm volatile("s_waitcnt lgkmcnt(0)" ::: "memory"); __builtin_amdgcn_s_barrier(); asm volatile("" ::: "memory");
        }
    }
};
template <class E, class = void> struct epi_staged { static constexpr bool value = false; };
template <class E> struct epi_staged<E, decltype((void)E::STAGED)> { static constexpr bool value = E::STAGED; };

template <int N> __device__ __forceinline__ void waitv() { asm volatile("s_waitcnt vmcnt(%0)" :: "n"(N) : "memory"); }
template <class Epi, class Sched, bool ALIGN_EPI = false, bool SP2 = false, int FMT = 0, int KP = 0>
__device__ __forceinline__ void gemm_phase(PG8_LAS unsigned char* lds, const Gemm g, const Sched& S, const Epi& E) {
    const int tid = threadIdx.x, wid = __builtin_amdgcn_readfirstlane(tid >> 6), lane = tid & 63, wr = wid >> 2, wc = wid & 3, fr = lane & 15, fq = lane >> 4;
    const int K = g.K, nt = K / BK;
    constexpr bool FP8 = FMT != 0;
    constexpr bool BPF = SP2 && FMT == 2 && GEMM_BPF && KP == 0;
#define KP_RD if constexpr (!(KP & 1))
#define KP_ST if constexpr (!(KP & 2))
#define KP_MM if constexpr (!(KP & 4))
    constexpr int KM1 = ((GEMM_KM) >> (8 * FMT + 4)) & 15, KM2 = ((GEMM_KM) >> (8 * FMT)) & 15, GS1 = KM1 <= 1 ? 4 : 2, GS2 = KM2 <= 2 ? 3 : KM2 <= 4 ? 2 : 1;
    int f8sc = g.sB; if constexpr (FP8) { asm volatile("" : "+v"(f8sc)); }
    unsigned voffA[2], voffB[2];
#pragma unroll
    for (int i = 0; i < 2; ++i) { int R, C; stage_rc(tid * 16 + i * 8192, R, C); const int Rb = Epi::PERM ? ((R & ~31) + perm32(R & 31)) : R;
        voffA[i] = (unsigned)(R * g.lda + C) * 2u; voffB[i] = (unsigned)(Rb * g.ldb + C) * 2u; }
    const size_t kstepA = (size_t)g.kstepA, kstepB = (size_t)g.kstepB;
    const size_t hstepA = (size_t)HALF * g.lda * 2, hstepB = (size_t)HALF * g.ldb * 2;
    const unsigned ldsbase = __builtin_amdgcn_readfirstlane((unsigned)(size_t)lds + (unsigned)wid * 1024u);
    const unsigned ldsw = (unsigned)wid * 1024u;
    const int aoff = lds_byte(wr * 64 + fr, fq * 8), boff = lds_byte(wc * 32 + fr, fq * 8);
#define PG8_SA(b, h) (((b) * 2 + (h)) * HTB)
#define PG8_SB(b, h) ((4 + (b) * 2 + (h)) * HTB)
#define PG8_STAGE(bufoff, gbase, voff) do { _Pragma("unroll") for (int _i = 0; _i < 2; ++_i) \
        __builtin_amdgcn_global_load_lds((const unsigned*)((const char*)(gbase) + (voff)[_i]), (PG8_LAS unsigned*)(lds + (bufoff) + ldsw + _i * 8192), 16, 0, 0); } while (0)
#define PG8_LDA(dst, b, h) do { _Pragma("unroll") for (int m = 0; m < 4; ++m) { dst[m][0] = *(const PG8_LAS bf16x8*)(lds + PG8_SA(b, h) + aoff + m * 2048); \
        if constexpr (FMT == 2) { dst##H[m] = *(const PG8_LAS i32x2*)(lds + PG8_SA(b, h) + aoff + m * 2048 + 1024); asm volatile("" ::: "memory"); } else dst[m][1] = *(const PG8_LAS bf16x8*)(lds + PG8_SA(b, h) + aoff + m * 2048 + 1024); } } while (0)
#define PG8_LDB(dst, b, h) do { _Pragma("unroll") for (int n = 0; n < 2; ++n) { dst[n][0] = *(const PG8_LAS bf16x8*)(lds + PG8_SB(b, h) + boff + n * 2048); \
        if constexpr (FMT == 2) { dst##H[n] = *(const PG8_LAS i32x2*)(lds + PG8_SB(b, h) + boff + n * 2048 + 1024); asm volatile("" ::: "memory"); } else dst[n][1] = *(const PG8_LAS bf16x8*)(lds + PG8_SB(b, h) + boff + n * 2048 + 1024); } } while (0)
#define PG8_STAGE1(bufoff, gbase, voff, i) do { if constexpr ((GEMM_SADDR >> FMT) & 1) { \
        asm volatile("s_mov_b32 m0, %0\n\ts_nop 0\n\tglobal_load_lds_dwordx4 %1, %2" :: "s"(ldsbase + (unsigned)((bufoff) + (i) * 8192)), "v"((voff)[i]), "s"((const char*)(gbase)) : "m0", "memory"); } \
        else __builtin_amdgcn_global_load_lds((const unsigned*)((const char*)(gbase) + (voff)[i]), (PG8_LAS unsigned*)(lds + (bufoff) + ldsw + (i) * 8192), 16, 0, 0); } while (0)
#define PG8_MMA1(ai, bj, At, Bt, m) do { _Pragma("unroll") for (int n = 0; n < 2; ++n) { \
        if constexpr (FMT == 2) { const i32x4 w0_ = __builtin_bit_cast(i32x4, Bt[n][0]), a0_ = __builtin_bit_cast(i32x4, At[m][0]); \
            const i32x6 wf_ = (i32x6){w0_[0], w0_[1], w0_[2], w0_[3], Bt##H[n][0], Bt##H[n][1]}, af_ = (i32x6){a0_[0], a0_[1], a0_[2], a0_[3], At##H[m][0], At##H[m][1]}; \
            asm volatile("v_mfma_scale_f32_16x16x128_f8f6f4 %0, %1, %2, %0, %3, %3 op_sel:[0,1,0] op_sel_hi:[0,0,0] cbsz:2 blgp:2" : "+v"(acc[ai][bj][m][n]) : "v"(wf_), "v"(af_), "v"(f8sc)); } \
        else if constexpr (FMT == 1) { const i32x8 wf_ = __builtin_shufflevector(__builtin_bit_cast(i32x4, Bt[n][0]), __builtin_bit_cast(i32x4, Bt[n][1]), 0, 1, 2, 3, 4, 5, 6, 7); \
            const i32x8 af_ = __builtin_shufflevector(__builtin_bit_cast(i32x4, At[m][0]), __builtin_bit_cast(i32x4, At[m][1]), 0, 1, 2, 3, 4, 5, 6, 7); \
            asm volatile("v_mfma_scale_f32_16x16x128_f8f6f4 %0, %1, %2, %0, %3, %3 op_sel:[0,1,0] op_sel_hi:[0,0,0]" : "+v"(acc[ai][bj][m][n]) : "v"(wf_), "v"(af_), "v"(f8sc)); } \
        else { _Pragma("unroll") for (int k = 0; k < 2; ++k) acc[ai][bj][m][n] = __builtin_amdgcn_mfma_f32_16x16x32_bf16(Bt[n][k], At[m][k], acc[ai][bj][m][n], 0, 0, 0); } } } while (0)
#define PG8_MMA(ai, bj, At, Bt) do { __builtin_amdgcn_s_setprio(1); _Pragma("unroll") for (int m = 0; m < 4; ++m) PG8_MMA1(ai, bj, At, Bt, m); \
        __builtin_amdgcn_s_setprio(0); } while (0)
#define PG8_ST(bufoff, gbase, voff, i) do { PG8_SCHED; PG8_STAGE1(bufoff, gbase, voff, i); PG8_SCHED; } while (0)
#define PG8_PIECE2(j, bb, pb, pa) do { KP_ST if ((j) < 2) PG8_STAGE1(PG8_SB(bb, 0), pb, voffB, (j) & 1); else if ((j) < 4) PG8_STAGE1(PG8_SB(bb, 1), (pb) + hstepB, voffB, (j) & 1); else PG8_STAGE1(PG8_SA(bb, 0), pa, voffA, (j) & 1); } while (0)
#define PG8_GROUP(ai, g) do { KP_MM if ((g) < 4) PG8_MMA1(ai, 0, At, B0, (g) & 3); else PG8_MMA1(ai, 1, At, B1, (g) & 3); } while (0)
#define PG8_PRIO1 do { if constexpr (!(FMT == 2 && GEMM_FP6_NOPRIO)) __builtin_amdgcn_s_setprio(1); } while (0)
#define PG8_SP1X(bb, sb, ps) do { \
        _Pragma("unroll") for (int j_ = 0; j_ < 2 - KM1; ++j_) KP_ST PG8_STAGE1(PG8_SA(sb, 1), ps, voffA, j_); \
        KP_RD { PG8_LDB(B0, bb, 0); PG8_LDB(B1, bb, 1); PG8_SCHED; PG8_LDA(At, bb, 0); } \
        waitv<8 - KM1>(); PG8_WAIT_L(0); PG8_BAR; PG8_PRIO1; \
        _Pragma("unroll") for (int g_ = 0; g_ < 8; ++g_) { PG8_GROUP(0, g_); \
            if (g_ % GS1 == 0 && g_ / GS1 < KM1) { PG8_SCHED; KP_ST PG8_STAGE1(PG8_SA(sb, 1), ps, voffA, 2 - KM1 + g_ / GS1); PG8_SCHED; } } \
        __builtin_amdgcn_s_setprio(0); PG8_BAR; PG8_SCHED; } while (0)
#define PG8_SP2X(bb, pb, pa) do { \
        _Pragma("unroll") for (int j_ = 0; j_ < 6 - KM2; ++j_) PG8_PIECE2(j_, bb, pb, pa); \
        KP_RD { PG8_LDA(At, bb, 1); } \
        waitv<8 - KM2>(); PG8_WAIT_L(0); PG8_BAR; PG8_PRIO1; \
        _Pragma("unroll") for (int g_ = 0; g_ < 8; ++g_) { PG8_GROUP(1, g_); \
            if (g_ % GS2 == 0 && g_ / GS2 < KM2) { PG8_SCHED; PG8_PIECE2(6 - KM2 + g_ / GS2, bb, pb, pa); PG8_SCHED; } } \
        __builtin_amdgcn_s_setprio(0); PG8_BAR; PG8_SCHED; } while (0)
#define PG8_SP1B(bb, sb, ps, Bc) do { \
        _Pragma("unroll") for (int j_ = 0; j_ < 2 - KM1; ++j_) PG8_STAGE1(PG8_SA(sb, 1), ps, voffA, j_); \
        PG8_LDB(B1, bb, 1); PG8_SCHED; PG8_LDA(At, bb, 0); \
        waitv<6 - KM1>(); PG8_WAIT_L(0); PG8_BAR; __builtin_amdgcn_s_setprio(1); \
        _Pragma("unroll") for (int g_ = 0; g_ < 8; ++g_) { if (g_ < 4) PG8_MMA1(0, 0, At, Bc, g_ & 3); else PG8_MMA1(0, 1, At, B1, g_ & 3); \
            if (g_ % GS1 == 0 && g_ / GS1 < KM1) { PG8_SCHED; PG8_STAGE1(PG8_SA(sb, 1), ps, voffA, 2 - KM1 + g_ / GS1); PG8_SCHED; } } \
        __builtin_amdgcn_s_setprio(0); PG8_BAR; PG8_SCHED; } while (0)
#define PG8_SP2B(bb, pb, pa, Bc, Bn) do { \
        _Pragma("unroll") for (int j_ = 0; j_ < 6 - KM2; ++j_) PG8_PIECE2(j_, bb, pb, pa); \
        PG8_LDA(At, bb, 1); PG8_SCHED; PG8_LDB(Bn, 1 - (bb), 0); \
        waitv<8 - KM2>(); PG8_WAIT_L(0); PG8_BAR; __builtin_amdgcn_s_setprio(1); \
        _Pragma("unroll") for (int g_ = 0; g_ < 8; ++g_) { if (g_ < 4) PG8_MMA1(1, 0, At, Bc, g_ & 3); else PG8_MMA1(1, 1, At, B1, g_ & 3); \
            if (g_ % GS2 == 0 && g_ / GS2 < KM2) { PG8_SCHED; PG8_PIECE2(6 - KM2 + g_ / GS2, bb, pb, pa); PG8_SCHED; } } \
        __builtin_amdgcn_s_setprio(0); PG8_BAR; PG8_SCHED; } while (0)
#define PG8_WAIT_V(n) asm volatile("s_waitcnt vmcnt(" #n ")" ::: "memory")
#define PG8_WAIT_L(n) asm volatile("s_waitcnt lgkmcnt(" #n ")" ::: "memory")
#define PG8_BAR __builtin_amdgcn_s_barrier()
#define PG8_SCHED __builtin_amdgcn_sched_barrier(0)
    Unit cur, nxt; int ui = 0;
    if (!S.next(0, cur)) return;
    f32x4 acc[2][2][4][2];
#pragma unroll
    for (int a = 0; a < 2; ++a)
#pragma unroll
        for (int b = 0; b < 2; ++b)
#pragma unroll
            for (int m = 0; m < 4; ++m)
#pragma unroll
                for (int n = 0; n < 2; ++n) acc[a][b][m][n] = (f32x4){0.f, 0.f, 0.f, 0.f};
    bf16x8 At[4][2] = {}, B0[2][2] = {}, B1[2][2] = {}, B2[2][2] = {}; i32x2 AtH[4] = {}, B0H[2] = {}, B1H[2] = {}, B2H[2] = {};
    const char* cA = cur.a; const char* cB = cur.b;
    S.a_ready(cur);
    if constexpr (SP2) {
        PG8_STAGE(PG8_SB(0, 0), cB, voffB); PG8_STAGE(PG8_SB(0, 1), cB + hstepB, voffB); PG8_STAGE(PG8_SA(0, 0), cA, voffA); PG8_STAGE(PG8_SA(0, 1), cA + hstepA, voffA);
        if (wr == 1) PG8_BAR;
        PG8_WAIT_V(2); PG8_BAR;
        PG8_STAGE(PG8_SB(1, 0), cB + kstepB, voffB); PG8_STAGE(PG8_SA(1, 0), cA + kstepA, voffA); PG8_STAGE(PG8_SB(1, 1), cB + hstepB + kstepB, voffB);
        PG8_WAIT_V(6); PG8_BAR;
    } else {
        PG8_STAGE(PG8_SB(0, 0), cB, voffB); PG8_STAGE(PG8_SA(0, 0), cA, voffA); PG8_STAGE(PG8_SB(0, 1), cB + hstepB, voffB); PG8_STAGE(PG8_SA(0, 1), cA + hstepA, voffA);
        if (wr == 1) PG8_BAR;
        PG8_WAIT_V(4); PG8_BAR;
        PG8_STAGE(PG8_SB(1, 0), cB + kstepB, voffB); PG8_STAGE(PG8_SA(1, 0), cA + kstepA, voffA); PG8_STAGE(PG8_SB(1, 1), cB + hstepB + kstepB, voffB);
        PG8_WAIT_V(6); PG8_BAR;
    }
    if constexpr (BPF) { PG8_LDB(B0, 0, 0); }
    for (;;) {
        const bool has_next = S.next(ui + 1, nxt);
        const char* nA = has_next ? nxt.a : cA; const char* nB = has_next ? nxt.b : cB;
        for (int t = 0; t < nt; t += 2) {
            const bool last = (t == nt - 2);
            const char* a1 = cA + (size_t)(t + 1) * kstepA;
            const char* a2 = last ? nA : cA + (size_t)(t + 2) * kstepA; const char* b2 = last ? nB : cB + (size_t)(t + 2) * kstepB;
            const char* a3 = a2 + kstepA; const char* b3 = b2 + kstepB;
            if (last && has_next) S.a_ready(nxt);
            if constexpr (BPF) {
            PG8_SP1B(0, 1, a1 + hstepA, B0); PG8_SP2B(0, b2, a2, B0, B2); PG8_SP1B(1, 0, a2 + hstepA, B2); PG8_SP2B(1, b3, a3, B2, B0);
            } else if constexpr (SP2 && (KM1 | KM2) != 0) {
            PG8_SP1X(0, 1, a1 + hstepA); PG8_SP2X(0, b2, a2); PG8_SP1X(1, 0, a2 + hstepA); PG8_SP2X(1, b3, a3);
            } else if constexpr (SP2) {
            PG8_STAGE(PG8_SA(1, 1), a1 + hstepA, voffA); PG8_LDB(B0, 0, 0); PG8_LDB(B1, 0, 1); PG8_SCHED; PG8_LDA(At, 0, 0);
            PG8_WAIT_V(8); PG8_WAIT_L(0); PG8_BAR; PG8_MMA(0, 0, At, B0); PG8_MMA(0, 1, At, B1); PG8_BAR; PG8_SCHED;
            PG8_STAGE(PG8_SB(0, 0), b2, voffB); PG8_STAGE(PG8_SB(0, 1), b2 + hstepB, voffB); PG8_STAGE(PG8_SA(0, 0), a2, voffA); PG8_LDA(At, 0, 1);
            PG8_WAIT_V(8); PG8_WAIT_L(0); PG8_BAR; PG8_MMA(1, 0, At, B0); PG8_MMA(1, 1, At, B1); PG8_BAR; PG8_SCHED;
            PG8_STAGE(PG8_SA(0, 1), a2 + hstepA, voffA); PG8_LDB(B0, 1, 0); PG8_LDB(B1, 1, 1); PG8_SCHED; PG8_LDA(At, 1, 0);
            PG8_WAIT_V(8); PG8_WAIT_L(0); PG8_BAR; PG8_MMA(0, 0, At, B0); PG8_MMA(0, 1, At, B1); PG8_BAR; PG8_SCHED;
            PG8_STAGE(PG8_SB(1, 0), b3, voffB); PG8_STAGE(PG8_SB(1, 1), b3 + hstepB, voffB); PG8_STAGE(PG8_SA(1, 0), a3, voffA); PG8_LDA(At, 1, 1);
            PG8_WAIT_V(8); PG8_WAIT_L(0); PG8_BAR; PG8_MMA(1, 0, At, B0); PG8_MMA(1, 1, At, B1); PG8_BAR; PG8_SCHED;
            } else {
            PG8_LDB(B0, 0, 0); PG8_SCHED; PG8_LDA(At, 0, 0); PG8_STAGE(PG8_SA(1, 1), a1 + hstepA, voffA);
            PG8_WAIT_L(8); PG8_BAR; PG8_WAIT_L(0); PG8_MMA(0, 0, At, B0); PG8_BAR; PG8_SCHED;
            PG8_LDB(B1, 0, 1); PG8_STAGE(PG8_SB(0, 0), b2, voffB);
            PG8_BAR; PG8_WAIT_L(0); PG8_MMA(0, 1, At, B1); PG8_BAR;
            PG8_LDA(At, 0, 1); PG8_STAGE(PG8_SA(0, 0), a2, voffA);
            PG8_BAR; PG8_WAIT_L(0); PG8_MMA(1, 0, At, B0); PG8_BAR; PG8_SCHED;
            PG8_STAGE(PG8_SB(0, 1), b2 + hstepB, voffB);
            PG8_WAIT_V(6); PG8_BAR; PG8_MMA(1, 1, At, B1); PG8_BAR;
            PG8_LDB(B0, 1, 0); PG8_SCHED; PG8_LDA(At, 1, 0); PG8_STAGE(PG8_SA(0, 1), a2 + hstepA, voffA);
            PG8_WAIT_L(8); PG8_BAR; PG8_WAIT_L(0); PG8_MMA(0, 0, At, B0); PG8_BAR; PG8_SCHED;
            PG8_LDB(B1, 1, 1); PG8_STAGE(PG8_SB(1, 0), b3, voffB);
            PG8_BAR; PG8_WAIT_L(0); PG8_MMA(0, 1, At, B1); PG8_BAR;
            PG8_LDA(At, 1, 1); PG8_STAGE(PG8_SA(1, 0), a3, voffA);
            PG8_BAR; PG8_WAIT_L(0); PG8_MMA(1, 0, At, B0); PG8_BAR; PG8_SCHED;
            PG8_STAGE(PG8_SB(1, 1), b3 + hstepB, voffB);
            PG8_WAIT_V(6); PG8_BAR; PG8_MMA(1, 1, At, B1); PG8_BAR;
            }
        }
        if constexpr (ALIGN_EPI) { if (wr == 0) PG8_BAR; }
        if constexpr (FP8) { asm volatile("s_nop 15\n\ts_nop 15" ::: "memory"); }
        if constexpr (epi_staged<Epi>::value) { static_assert(ALIGN_EPI, "a staged epilogue uses workgroup barriers: both halves must run it together"); E.staged(acc, cur, wr, wc, fr, fq, lds + STAGE_BYTES, wid, lane); S.done(cur); }
        else if constexpr (!Epi::AFTER_DRAIN) { E(acc, cur, wr, wc, fr, fq); S.done(cur); }
        if (!has_next) break;
#pragma unroll
        for (int a = 0; a < 2; ++a)
#pragma unroll
            for (int b = 0; b < 2; ++b)
#pragma unroll
                for (int m = 0; m < 4; ++m)
#pragma unroll
                    for (int n = 0; n < 2; ++n) acc[a][b][m][n] = (f32x4){0.f, 0.f, 0.f, 0.f};
        cur = nxt; cA = nA; cB = nB; ++ui;
        if constexpr (ALIGN_EPI) { if (wr == 1) PG8_BAR; }
    }
    PG8_WAIT_V(0);
    if constexpr (!ALIGN_EPI) { if (wr == 0) PG8_BAR; }
    PG8_BAR;
    if constexpr (Epi::AFTER_DRAIN) { E.fused(acc, cur, wr, wc, fr, fq, lds, wid, lane); S.done(cur); }
#undef PG8_SA
#undef PG8_SB
#undef PG8_STAGE
#undef PG8_LDA
#undef PG8_LDB
#undef PG8_MMA
#undef PG8_MMA1
#undef PG8_STAGE1
#undef PG8_ST
#undef KP_RD
#undef KP_ST
#undef KP_MM
#undef PG8_PIECE2
#undef PG8_GROUP
#undef PG8_SP1X
#undef PG8_SP2X
#undef PG8_PRIO1
#undef PG8_SP1B
#undef PG8_SP2B
#undef PG8_WAIT_V
#undef PG8_WAIT_L
#undef PG8_BAR
#undef PG8_SCHED
}}
namespace fz {
#define LAS __attribute__((address_space(3)))
typedef unsigned short bf16_t;
typedef short bf16x8 __attribute__((ext_vector_type(8)));
typedef float f32x4 __attribute__((ext_vector_type(4)));
typedef float f32x2 __attribute__((ext_vector_type(2)));
typedef unsigned u32x4 __attribute__((ext_vector_type(4)));
typedef unsigned u32x2 __attribute__((ext_vector_type(2)));
typedef unsigned u32x6 __attribute__((ext_vector_type(6)));
typedef float f32x16 __attribute__((ext_vector_type(16)));
constexpr int NTHR = 512;
constexpr int LDS_BYTES = 163840, MISC_OFF = LDS_BYTES - 256;

constexpr size_t MiB = 1u << 20;
constexpr size_t WS_CTL = 0, CTL_ZERO_BYTES = 1 * MiB;
constexpr size_t WS_WIN = 1 * MiB;
constexpr size_t WS_WPOOL = WS_WIN + 32 * MiB;
constexpr size_t WS_WOUT = WS_WPOOL + 1 * MiB;
constexpr size_t WS_WGU = WS_WOUT + 16 * MiB;
constexpr size_t WS_WD = WS_WGU + 44 * MiB;
constexpr size_t WS_EWGU = WS_WD + 22 * MiB;
constexpr size_t WS_EWD = WS_EWGU + 448 * MiB;
constexpr size_t WS_XS = WS_EWD + 224 * MiB;
constexpr size_t WS_H = WS_XS + 128 * MiB;
constexpr size_t WS_GLR = WS_H + 65 * MiB;
constexpr size_t WS_ROUTE = WS_GLR + 1 * MiB;
constexpr size_t WS_U = WS_ROUTE + 2 * MiB;
constexpr size_t WS_Z = WS_U;
constexpr size_t WS_DP = WS_Z + 128 * MiB;
constexpr size_t WS_MIX = WS_DP + 32 * MiB;
constexpr size_t WS_CS = WS_MIX + 64 * MiB;
constexpr size_t WS_SP = WS_CS + 128 * MiB;
constexpr size_t WS_DEC = WS_SP + 64 * MiB;
constexpr size_t WS_ACT = WS_U;
constexpr size_t WS_HS = WS_U;
constexpr size_t WS_ACT2 = WS_HS + 136 * MiB;
constexpr size_t WS_Y = WS_ACT2 + 476 * MiB;
constexpr size_t WS_PART = WS_ACT2 + 240 * MiB;
constexpr size_t WS_END = WS_Y + 136 * MiB;
static_assert(WS_END <= 1792 * MiB, "workspace map");
static_assert(WS_DEC + 1 * MiB <= WS_END, "mixer view inside U");
constexpr size_t RT_TOPI = 0, RT_TOPW = 128 * 1024, RT_TOKSLOT = 256 * 1024, RT_HIST = 384 * 1024, RT_BLKE = 400 * 1024, RT_NRB = 404 * 1024;

constexpr int CW_BAR = 4096;

constexpr int PH_PRO = 0, PH_PER_LAYER = 10, NPH = 1 + 2 * PH_PER_LAYER;
constexpr int PK_INPROJ = 0, PK_PRE = 1, PK_POOLSCAN = 2, PK_GLAOUT = 3, PK_OUTPROJ = 4, PK_NORM2 = 5, PK_ASSIGN = 6, PK_UP = 7, PK_DOWN = 8, PK_TAIL = 9;

#define VM_WAIT() asm volatile("s_waitcnt vmcnt(0)" ::: "memory")
#define LDS_WAIT() asm volatile("s_waitcnt lgkmcnt(0)" ::: "memory")
#define RLX_AGENT __ATOMIC_RELAXED, __HIP_MEMORY_SCOPE_AGENT

__device__ __forceinline__ unsigned pk_bf16(float lo, float hi) { unsigned r; asm volatile("v_cvt_pk_bf16_f32 %0, %1, %2" : "=v"(r) : "v"(lo), "v"(hi)); return r; }
__device__ __forceinline__ float bf_lo(unsigned w) { return __uint_as_float(w << 16); }
__device__ __forceinline__ float bf_hi(unsigned w) { return __uint_as_float(w & 0xffff0000u); }
__device__ __forceinline__ float bf2f(bf16_t b) { return __uint_as_float(((unsigned)b) << 16); }
__device__ __forceinline__ bf16_t f2bf(float f) { return (bf16_t)(pk_bf16(f, 0.f) & 0xffffu); }
__device__ __forceinline__ float wave_sum(float v) {
#pragma unroll
    for (int o = 1; o < 64; o <<= 1) v += __shfl_xor(v, o);
    return v;
}
__device__ __forceinline__ float silu_f(float x) { return x * __builtin_amdgcn_rcpf(1.0f + __builtin_amdgcn_exp2f(-1.4426950408889634f * x)); }
__device__ __forceinline__ bf16x8 mk8(u32x2 lo, u32x2 hi) { u32x4 t; t.x = lo.x; t.y = lo.y; t.z = hi.x; t.w = hi.y; return __builtin_bit_cast(bf16x8, t); }
__device__ __forceinline__ bf16x8 tr_frag(unsigned a0, unsigned a1) {
    u32x2 lo, hi;
    asm volatile("ds_read_b64_tr_b16 %0, %2\n\tds_read_b64_tr_b16 %1, %3\n\ts_waitcnt lgkmcnt(0)" : "=&v"(lo), "=&v"(hi) : "v"(a0), "v"(a1) : "memory");
    return mk8(lo, hi);
}
__device__ __forceinline__ void moe_tail_split(int nrb, int G, int& full, int& tail, int& s) {
    const int nwg = nrb * 8; full = (nwg / G) * G; tail = nwg - full;
    s = tail == 0 ? 0 : (tail * 7 <= G ? 7 : (tail * 4 <= G ? 4 : (tail * 2 <= G ? 2 : 0)));
    if (s == 0) { full = nwg; tail = 0; }
}
__device__ __forceinline__ f32x4 mma16(bf16x8 a, bf16x8 b, f32x4 c) { return __builtin_amdgcn_mfma_f32_16x16x32_bf16(a, b, c, 0, 0, 0); }

#define XB_TMO      128
#define XB_XCNT(j)  (256  + 64 * (j))
#define XB_XSUB(j)  (1280 + 64 * (j))
#define XB_XGEN(j)  (2304 + 64 * (j))
#define XB_TOP      3328
#define XB_TOPGEN   3392
#define XCD_BAR_WORDS 3456
#define XB_SPIN_CAP (1u << 18)
__device__ __forceinline__ unsigned xb_ld(unsigned* p)              { return __hip_atomic_load(p, __ATOMIC_RELAXED, __HIP_MEMORY_SCOPE_AGENT); }
__device__ __forceinline__ unsigned xb_add(unsigned* p, unsigned v) { return __hip_atomic_fetch_add(p, v, __ATOMIC_RELAXED, __HIP_MEMORY_SCOPE_AGENT); }
__device__ __forceinline__ unsigned xb_xcc_id() { return (unsigned)__builtin_amdgcn_s_getreg((3 << 11) | 20) & 0xFu; }
#define XB_SPIN(cond, bar) do { unsigned _sp = 0; while (cond) { __builtin_amdgcn_s_sleep(1); \
    if ((++_sp & 255u) == 0u) { if (xb_ld(&(bar)[XB_TMO])) break; if (_sp > XB_SPIN_CAP) { atomicAdd(&(bar)[XB_TMO], 1u); break; } } } } while (0)
struct XcdBarrier { unsigned* bar; unsigned x; volatile LAS unsigned* st; };
__device__ __forceinline__ XcdBarrier xcd_barrier_post(unsigned* bar, volatile LAS unsigned* st) {
    XcdBarrier b; b.bar = bar; b.x = xb_xcc_id(); b.st = st;
    if (threadIdx.x == 0) (void)xb_add(&bar[XB_XCNT(b.x)], 1u);
    return b;
}
__device__ __forceinline__ void xcd_barrier_complete(unsigned* bar, unsigned x, unsigned& nloc, unsigned& nx) {
    const unsigned G = gridDim.x * gridDim.y * gridDim.z;
    unsigned sum, cnt, mine, sp = 0u;
    for (;;) {
        sum = 0u; cnt = 0u; mine = 0u;
#pragma unroll
        for (unsigned j = 0; j < 16; ++j) { const unsigned c = xb_ld(&bar[XB_XCNT(j)]); sum += c; cnt += (c > 0u) ? 1u : 0u; mine = (j == x) ? c : mine; }
        if (sum == G) break;
        __builtin_amdgcn_s_sleep(1);
        if ((++sp & 255u) == 0u) { if (xb_ld(&bar[XB_TMO])) break; if (sp > XB_SPIN_CAP) { atomicAdd(&bar[XB_TMO], 1u); break; } }
    }
    nloc = mine > 0u ? mine : 1u; nx = cnt > 0u ? cnt : 1u;
}
__device__ __forceinline__ void xcd_barrier(const XcdBarrier& b) {
    asm volatile("s_waitcnt vmcnt(0)" ::: "memory");
    __syncthreads();
    if (threadIdx.x == 0) {
        unsigned* bar = b.bar;
        __builtin_amdgcn_s_waitcnt(0);
        unsigned nloc = b.st[0], nx = b.st[1];
        if (nloc == 0u) { xcd_barrier_complete(bar, b.x, nloc, nx); b.st[0] = nloc; b.st[1] = nx; }
        const unsigned old = xb_add(&bar[XB_XSUB(b.x)], 1u);
        const unsigned gen = old / nloc;
        if (old + 1u == (gen + 1u) * nloc) {
            __builtin_amdgcn_fence(__ATOMIC_RELEASE, "agent");
            asm volatile("s_waitcnt vmcnt(0)" ::: "memory");
            const unsigned og = xb_add(&bar[XB_TOP], 1u);
            const unsigned tg = og / nx;
            if (og + 1u == (tg + 1u) * nx) xb_add(&bar[XB_TOPGEN], 1u);
            else XB_SPIN(xb_ld(&bar[XB_TOPGEN]) == tg, bar);
            __builtin_amdgcn_fence(__ATOMIC_ACQUIRE, "agent");
            xb_add(&bar[XB_XGEN(b.x)], 1u);
            asm volatile("s_waitcnt vmcnt(0)" ::: "memory");
        } else {
            XB_SPIN(xb_ld(&bar[XB_XGEN(b.x)]) == gen, bar);
            __builtin_amdgcn_fence(__ATOMIC_ACQUIRE, "agent");
            asm volatile("s_waitcnt vmcnt(0)" ::: "memory");
        }
    }
    __syncthreads();
}

struct CvtJob { const float* src; int ld_src; int k0; int n0; unsigned char* dstb; int dpitch; float f8scale; int fmt6; };
__device__ __forceinline__ void cvt_load(const CvtJob& j, f32x4 (&v)[16], int lane) {
    if (j.f8scale != 0.f) { const int kr = lane >> 3, nq = lane & 7;
#pragma unroll
        for (int i = 0; i < 16; ++i) v[i] = *(const f32x4*)(j.src + (size_t)(j.k0 + 8 * i + kr) * j.ld_src + j.n0 + 4 * nq);
    } else { const int kr = lane >> 4, nq = lane & 15;
#pragma unroll
        for (int i = 0; i < 16; ++i) v[i] = *(const f32x4*)(j.src + (size_t)(j.k0 + 4 * i + kr) * j.ld_src + j.n0 + 4 * nq); }
}
__device__ __forceinline__ float f8cl(float v) { return __builtin_fminf(__builtin_fmaxf(v, -448.f), 448.f); }
__device__ __forceinline__ void cvt_finish(const CvtJob& j, const f32x4 (&v)[16], LAS float* scr, int lane) {
    const int nlo = lane & 7, kq = lane >> 3;
    if (j.f8scale != 0.f) { const int kr = lane >> 3, nq = lane & 7;
#pragma unroll
        for (int i = 0; i < 16; ++i) { LAS float* w = scr + (8 * i + kr) * 33 + 4 * nq; w[0] = v[i].x; w[1] = v[i].y; w[2] = v[i].z; w[3] = v[i].w; }
        LDS_WAIT(); asm volatile("" ::: "memory");
        const float sc = j.f8scale;
        if (j.fmt6) {
            const int n = lane & 31;
#pragma unroll
            for (int gi = 0; gi < 2; ++gi) { const int g = 2 * (lane >> 5) + gi; const LAS float* s = scr + (32 * g) * 33 + n; f32x16 lo, hi;
#pragma unroll
                for (int i = 0; i < 16; ++i) { lo[i] = __builtin_fminf(__builtin_fmaxf(s[i * 33] * sc, -7.5f), 7.5f); hi[i] = __builtin_fminf(__builtin_fmaxf(s[(16 + i) * 33] * sc, -7.5f), 7.5f); }
                const u32x6 w = __builtin_amdgcn_cvt_scalef32_2xpk16_fp6_f32(lo, hi, 1.0f);
                unsigned char* d = j.dstb + (size_t)n * j.dpitch + 16 * g;
                *(u32x4*)d = (u32x4){w[0], w[1], w[2], w[3]}; *(u32x4*)(d + 64) = (u32x4){w[4], w[5], 0u, 0u};     }
        } else
#pragma unroll
        for (int jn = 0; jn < 4; ++jn) { const int n = 8 * jn + nlo; const LAS float* s = scr + (16 * kq) * 33 + n; int w[4];
#pragma unroll
            for (int d = 0; d < 4; ++d) { int x = 0;
                x = __builtin_amdgcn_cvt_pk_fp8_f32(f8cl(s[(4 * d + 0) * 33] * sc), f8cl(s[(4 * d + 1) * 33] * sc), x, false);
                x = __builtin_amdgcn_cvt_pk_fp8_f32(f8cl(s[(4 * d + 2) * 33] * sc), f8cl(s[(4 * d + 3) * 33] * sc), x, true); w[d] = x; }
            *(u32x4*)(j.dstb + (size_t)n * j.dpitch + 16 * kq) = (u32x4){(unsigned)w[0], (unsigned)w[1], (unsigned)w[2], (unsigned)w[3]}; }
    } else { const int kr = lane >> 4, nq = lane & 15;
#pragma unroll
        for (int i = 0; i < 16; ++i) { LAS float* w = scr + (4 * i + kr) * 65 + 4 * nq; w[0] = v[i].x; w[1] = v[i].y; w[2] = v[i].z; w[3] = v[i].w; }
        LDS_WAIT(); asm volatile("" ::: "memory");
#pragma unroll
        for (int jn = 0; jn < 8; ++jn) { const int n = 8 * jn + nlo; const LAS float* s = scr + (8 * kq) * 65 + n;
            u32x4 o; o.x = pk_bf16(s[0 * 65], s[1 * 65]); o.y = pk_bf16(s[2 * 65], s[3 * 65]); o.z = pk_bf16(s[4 * 65], s[5 * 65]); o.w = pk_bf16(s[6 * 65], s[7 * 65]);
            *(u32x4*)(j.dstb + (size_t)n * j.dpitch + 16 * kq) = o; }
    }
    LDS_WAIT(); asm volatile("" ::: "memory");
}
struct CvtPtrs { const float *w_in, *w_pool, *w_out, *dwg, *dwu, *dwd, *ewg, *ewu, *ewd; unsigned char* ws; };
constexpr int CI_WIN = 32 * 64, CI_WPOOL = 16, CI_WOUT = 32 * 32, CI_DGU = 32 * 88, CI_DD = 88 * 32, CI_EGU = 16 * 224, CI_ED = 56 * 64;
constexpr int CI_NONEXP = 2 * CI_WIN + 8 * CI_WPOOL + 2 * CI_WOUT + 2 * CI_DGU + CI_DD;
constexpr int CI_TOTAL = CI_NONEXP + 8 * (2 * CI_EGU + CI_ED);
__device__ __forceinline__ unsigned char* cvt_dst(unsigned char* base, int KT, int row0, int kt) { return base + ((size_t)((row0 >> 8) * KT + kt) * 256 + (row0 & 255)) * 128; }
__device__ __forceinline__ CvtJob cvt_decode(const CvtPtrs& P, int r) {
    CvtJob j; j.f8scale = 0.f; j.dpitch = 128; j.fmt6 = 0;
    if (r < 2 * CI_WIN) { const int l = r / CI_WIN, q = r % CI_WIN, kb = q / 64, ng = q % 64; const int c0 = 64 * ng;
        j.src = P.w_in + (size_t)l * DM * ZW; j.ld_src = ZW; j.k0 = 64 * kb; j.n0 = c0 < 3072 ? c0 : c0 + 16;
        j.dstb = cvt_dst(P.ws + WS_WIN + (size_t)l * 4096 * 2048 * 2, 32, c0, kb); return j; }
    r -= 2 * CI_WIN;
    if (r < 8 * CI_WPOOL) { const int m = r / CI_WPOOL, q = r % CI_WPOOL, kb = q / 4, ng = q % 4;
        j.src = P.w_pool + (size_t)m * 65536; j.ld_src = 256; j.k0 = 64 * kb; j.n0 = 64 * ng;
        j.dstb = cvt_dst(P.ws + WS_WPOOL + (size_t)m * 65536 * 2, 4, 64 * ng, kb); return j; }
    r -= 8 * CI_WPOOL;
    if (r < 2 * CI_WOUT) { const int l = r / CI_WOUT, q = r % CI_WOUT, kb = q / 32, ng = q % 32;
        j.src = P.w_out + (size_t)l * 2048 * 2048; j.ld_src = 2048; j.k0 = 64 * kb; j.n0 = 64 * ng;
        j.dstb = cvt_dst(P.ws + WS_WOUT + (size_t)l * 2048 * 2048 * 2, 32, 64 * ng, kb); return j; }
    r -= 2 * CI_WOUT;
#if DENSE_FP8 == 1
    if (r < 2 * CI_DGU) { const int up = r / CI_DGU, q = r % CI_DGU, kb = q / 176, ng = q % 176; const int c0 = 32 * ng;
        j.src = up ? P.dwu : P.dwg; j.ld_src = 5632; j.k0 = 128 * kb; j.n0 = c0;
        j.dstb = cvt_dst(P.ws + WS_WGU, 16, 256 * (c0 >> 7) + (c0 & 127) + 128 * up, kb); j.f8scale = 64.f; return j; }
#else
    if (r < 2 * CI_DGU) { const int up = r / CI_DGU, q = r % CI_DGU, kb = q / 88, ng = q % 88; const int c0 = 64 * ng;
        j.src = up ? P.dwu : P.dwg; j.ld_src = 5632; j.k0 = 64 * kb; j.n0 = c0;
        j.dstb = cvt_dst(P.ws + WS_WGU, 32, 256 * (c0 >> 7) + (c0 & 127) + 128 * up, kb); return j; }
#endif
    r -= 2 * CI_DGU;
#if DENSE_FP8 >= 1
    if (r < CI_DD) { const int kb = r / 64, ng = r % 64;
        j.src = P.dwd; j.ld_src = 2048; j.k0 = 128 * kb; j.n0 = 32 * ng;
        j.dstb = cvt_dst(P.ws + WS_WD, 44, 32 * ng, kb); j.f8scale = 128.f; return j; }
#else
    if (r < CI_DD) { const int kb = r / 32, ng = r % 32;
        j.src = P.dwd; j.ld_src = 2048; j.k0 = 64 * kb; j.n0 = 64 * ng;
        j.dstb = cvt_dst(P.ws + WS_WD, 88, 64 * ng, kb); return j; }
#endif
    r -= CI_DD;
    { const int e = r / (2 * CI_EGU + CI_ED); int q = r % (2 * CI_EGU + CI_ED);
        if (q < 2 * CI_EGU) { const int up = q / CI_EGU; q %= CI_EGU; const int kb = q / 224, ng = q % 224, c0 = 32 * ng;
            j.src = (up ? P.ewu : P.ewg) + (size_t)e * 2048 * 7168; j.ld_src = 7168; j.k0 = 128 * kb; j.n0 = c0;
            const int row0 = 256 * (c0 >> 7) + (c0 & 127) + 128 * up;
            if (TILE_EWGU) j.dstb = cvt_dst(P.ws + WS_EWGU + (size_t)e * 14336 * 2048, 16, row0, kb);
            else { j.dstb = P.ws + WS_EWGU + (size_t)e * 14336 * 2048 + (size_t)row0 * 2048 + 128 * kb; j.dpitch = 2048; }
            j.f8scale = 64.f; j.fmt6 = (MOE_UP_FMT == 2); return j; }
        q -= 2 * CI_EGU; { const int kb = q / 64, ng = q % 64;
            j.src = P.ewd + (size_t)e * 7168 * 2048; j.ld_src = 2048; j.k0 = 128 * kb; j.n0 = 32 * ng;
            j.dstb = cvt_dst(P.ws + WS_EWD + (size_t)e * 2048 * 7168, 56, 32 * ng, kb); j.f8scale = 128.f; return j; } }
}

constexpr int NP_PITCH = 4112;
template <int MODE, bool OUT8 = false, bool INBF = true>
__device__ __forceinline__ void norm_phase(LAS unsigned char* lds, const void* xin, const float* gain, bf16_t* H, const float* Wp, int ldw,
                                           float* glr, int* topi, float* topw, int* hist, int tid, int lane, int wave, int G) {
    LAS float* Wl = (LAS float*)lds;
    LAS unsigned char* Wt = lds;
    LAS unsigned char* Ht = lds + 16 * NP_PITCH;
    LAS float* part = (LAS float*)(lds + 32 * NP_PITCH);
    LAS int* cnt = (LAS int*)(lds + 135168);
    if (MODE == 2) {
#pragma unroll
        for (int i = 0; i < 4; ++i) { const int k = tid + 512 * i;
#pragma unroll
            for (int p4 = 0; p4 < 2; ++p4) { const f32x4 w = *(const f32x4*)(Wp + (size_t)k * ldw + 4 * p4);
                Wl[(4 * p4 + 0) * 2048 + k] = w.x; Wl[(4 * p4 + 1) * 2048 + k] = w.y; Wl[(4 * p4 + 2) * 2048 + k] = w.z; Wl[(4 * p4 + 3) * 2048 + k] = w.w; } }
    }
    if (MODE == 0) {
#pragma unroll
        for (int i = 0; i < 4; ++i) { const int k = tid + 512 * i;
#pragma unroll
            for (int p4 = 0; p4 < 4; ++p4) { const f32x4 w = *(const f32x4*)(Wp + (size_t)k * ldw + 4 * p4);
                *(LAS bf16_t*)(Wt + (4 * p4 + 0) * NP_PITCH + 2 * k) = f2bf(w.x); *(LAS bf16_t*)(Wt + (4 * p4 + 1) * NP_PITCH + 2 * k) = f2bf(w.y);
                *(LAS bf16_t*)(Wt + (4 * p4 + 2) * NP_PITCH + 2 * k) = f2bf(w.z); *(LAS bf16_t*)(Wt + (4 * p4 + 3) * NP_PITCH + 2 * k) = f2bf(w.w); } }
    }
    f32x4 gv[8];
#pragma unroll
    for (int j = 0; j < 8; ++j) gv[j] = *(const f32x4*)(gain + 4 * lane + 256 * j);
#pragma unroll 1
    for (int rb = blockIdx.x; rb < T / 64; rb += G) {
        if (MODE == 2) { if (tid < 8) cnt[tid] = 0; }
        __syncthreads();
        u32x2 rawb[8]; f32x4 rawf[8];
        { const int lr0 = MODE == 0 ? 2 * wave : 8 * wave; const int row0 = 64 * rb + lr0;
#pragma unroll
            for (int j = 0; j < 8; ++j) {
                if (INBF) rawb[j] = ((const u32x2*)((const bf16_t*)xin + (size_t)row0 * DM) + lane)[64 * j];
                else rawf[j] = ((const f32x4*)((const float*)xin + (size_t)row0 * DM) + lane)[64 * j]; } }
#pragma unroll 1
        for (int r = 0; r < 8; ++r) {
            const int lrow = MODE == 0 ? 16 * (r >> 1) + 2 * wave + (r & 1) : 8 * wave + r;
            const int row = 64 * rb + lrow;
            f32x4 v[8]; float ss = 0.f;
#pragma unroll
            for (int j = 0; j < 8; ++j) {
                if (INBF) { const u32x2 q = (u32x2){rawb[j].x, rawb[j].y}; v[j] = (f32x4){bf_lo(q.x), bf_hi(q.x), bf_lo(q.y), bf_hi(q.y)}; }
                else v[j] = rawf[j];
                ss += (v[j].x * v[j].x + v[j].y * v[j].y) + (v[j].z * v[j].z + v[j].w * v[j].w); }
            { const int rn = r + 1 < 8 ? r + 1 : r;
                const int lrn = MODE == 0 ? 16 * (rn >> 1) + 2 * wave + (rn & 1) : 8 * wave + rn; const int rown = 64 * rb + lrn;
#pragma unroll
                for (int j = 0; j < 8; ++j) {
                    if (INBF) rawb[j] = ((const u32x2*)((const bf16_t*)xin + (size_t)rown * DM) + lane)[64 * j];
                    else rawf[j] = ((const f32x4*)((const float*)xin + (size_t)rown * DM) + lane)[64 * j]; } }
            const float rstd = rsqrtf(wave_sum(ss) * (1.0f / DM) + EPSF);
            u32x2* ho = TILE_H ? (u32x2*)(H + ((size_t)(row >> 8) * 32 + (lane >> 4)) * 16384 + (size_t)(row & 255) * 64 + 4 * (lane & 15)) : (u32x2*)(H + (size_t)row * DM) + lane;
            constexpr int HJ = TILE_H ? 4 * 16384 / 4 : 64;
#pragma unroll
            for (int j = 0; j < 8; ++j) { v[j] = v[j] * rstd * gv[j];
                if (OUT8) { int w = 0; w = __builtin_amdgcn_cvt_pk_fp8_f32(f8cl(4.f * v[j].x), f8cl(4.f * v[j].y), w, false); w = __builtin_amdgcn_cvt_pk_fp8_f32(f8cl(4.f * v[j].z), f8cl(4.f * v[j].w), w, true);
                    ((unsigned*)((unsigned char*)H + (size_t)row * DM))[lane + 64 * j] = (unsigned)w; }
                else { u32x2 o; o.x = pk_bf16(v[j].x, v[j].y); o.y = pk_bf16(v[j].z, v[j].w); ho[HJ * j] = o;
                    if (MODE == 0) *(LAS u32x2*)(Ht + (lrow & 15) * NP_PITCH + (4 * lane + 256 * j) * 2) = o; } }
            if (MODE == 0 && (r & 1)) {
                __syncthreads();
                f32x4 acc = (f32x4){0.f, 0.f, 0.f, 0.f};
#pragma unroll
                for (int q = 0; q < 8; ++q) { const int ks = 8 * wave + q;
                    const bf16x8 a = *(const LAS bf16x8*)(Ht + (lane & 15) * NP_PITCH + (32 * ks + 8 * (lane >> 4)) * 2);
                    const bf16x8 b = *(const LAS bf16x8*)(Wt + (lane & 15) * NP_PITCH + (32 * ks + 8 * (lane >> 4)) * 2);
                    acc = mma16(a, b, acc); }
#pragma unroll
                for (int i = 0; i < 4; ++i) part[wave * 256 + (4 * (lane >> 4) + i) * 16 + (lane & 15)] = acc[i];
                __syncthreads();
                if (tid < 256) { float s = 0.f;
#pragma unroll
                    for (int w = 0; w < 8; ++w) s += part[w * 256 + tid];
                    glr[(size_t)(64 * rb + 16 * (r >> 1) + (tid >> 4)) * 16 + (tid & 15)] = s; }
            }
            if (MODE == 2) {
                float pr[8];
#pragma unroll
                for (int p = 0; p < 8; ++p) { float s = 0.f;
#pragma unroll
                    for (int j = 0; j < 8; ++j) { const f32x4 w = *(const LAS f32x4*)(Wl + p * 2048 + 4 * lane + 256 * j); s += (v[j].x * w.x + v[j].y * w.y) + (v[j].z * w.z + v[j].w * w.w); }
                    pr[p] = s; }
                float q4[4], q2[2], q1;
#pragma unroll
                for (int e = 0; e < 4; ++e) { const bool hi = (lane & 32) != 0; const float snd = hi ? pr[e] : pr[e + 4], kp = hi ? pr[e + 4] : pr[e]; q4[e] = kp + __shfl_xor(snd, 32); }
#pragma unroll
                for (int e = 0; e < 2; ++e) { const bool hi = (lane & 16) != 0; const float snd = hi ? q4[e] : q4[e + 2], kp = hi ? q4[e + 2] : q4[e]; q2[e] = kp + __shfl_xor(snd, 16); }
                { const bool hi = (lane & 8) != 0; const float snd = hi ? q2[0] : q2[1], kp = hi ? q2[1] : q2[0]; q1 = kp + __shfl_xor(snd, 8); }
                q1 += __shfl_xor(q1, 4); q1 += __shfl_xor(q1, 2); q1 += __shfl_xor(q1, 1);
                float lg[8];
#pragma unroll
                for (int e = 0; e < 8; ++e) lg[e] = __int_as_float(__builtin_amdgcn_readlane(__float_as_int(q1), 8 * e));
                int i0 = 0; float v0 = lg[0];
#pragma unroll
                for (int e = 1; e < 8; ++e) if (lg[e] > v0) { v0 = lg[e]; i0 = e; }
                int i1 = 0; float v1 = -3.4e38f;
#pragma unroll
                for (int e = 0; e < 8; ++e) if (e != i0 && lg[e] > v1) { v1 = lg[e]; i1 = e; }
                if (lane == 0) { const float e1 = __expf(v1 - v0), inv = 1.0f / (1.0f + e1);
                    topi[2 * row] = i0; topi[2 * row + 1] = i1; topw[2 * row] = inv; topw[2 * row + 1] = e1 * inv;
                    __hip_atomic_fetch_add(cnt + i0, 1, __ATOMIC_RELAXED, __HIP_MEMORY_SCOPE_WORKGROUP); __hip_atomic_fetch_add(cnt + i1, 1, __ATOMIC_RELAXED, __HIP_MEMORY_SCOPE_WORKGROUP); }
            }
        }
        if (MODE == 2) { __syncthreads(); if (tid < 8) hist[rb * 8 + tid] = cnt[tid]; }
    }
}
template <int W> __device__ __forceinline__ void pool_d_item(const bf16_t* Z, bf16_t* DP, int t, int c) {
    float s[8];
#pragma unroll
    for (int e = 0; e < 8; ++e) s[e] = 0.f;
    u32x4 q[W];
#pragma unroll
    for (int j = 0; j < W; ++j) { const int tt = t - j; q[j] = tt >= 0 ? *(const u32x4*)(Z + (size_t)tt * 4096 + c) : (u32x4){0u, 0u, 0u, 0u}; }
#pragma unroll
    for (int j = 0; j < W; ++j) { s[0] += bf_lo(q[j].x); s[1] += bf_hi(q[j].x); s[2] += bf_lo(q[j].y); s[3] += bf_hi(q[j].y); s[4] += bf_lo(q[j].z); s[5] += bf_hi(q[j].z); s[6] += bf_lo(q[j].w); s[7] += bf_hi(q[j].w); }
    const int cnt = (t + 1) < W ? (t + 1) : W; const float inv = 1.0f / (float)cnt;
    u32x4 o;
    o.x = pk_bf16(s[0] * inv - bf_lo(q[0].x), s[1] * inv - bf_hi(q[0].x)); o.y = pk_bf16(s[2] * inv - bf_lo(q[0].y), s[3] * inv - bf_hi(q[0].y));
    o.z = pk_bf16(s[4] * inv - bf_lo(q[0].z), s[5] * inv - bf_hi(q[0].z)); o.w = pk_bf16(s[6] * inv - bf_lo(q[0].w), s[7] * inv - bf_hi(q[0].w));
    *(u32x4*)(DP + (size_t)t * 1024 + c) = o;
}
__device__ __forceinline__ void pool_d_phase(const bf16_t* Z, bf16_t* DP, int tid, int G) {
#pragma unroll 1
    for (int item = blockIdx.x * NTHR + tid; item < T * 128; item += G * NTHR) {
        const int g = item / (T * 32), r = item % (T * 32), t = r >> 5, c = g * 256 + (r & 31) * 8;
        if (g == 0) pool_d_item<2>(Z, DP, t, c); else if (g == 1) pool_d_item<4>(Z, DP, t, c); else if (g == 2) pool_d_item<8>(Z, DP, t, c); else pool_d_item<16>(Z, DP, t, c);
    }
}

constexpr int G1_LR = 0, G1_EB = 4096, G1_KD = 6144, KD_PITCH = 1040, G1_V = G1_KD + 64 * KD_PITCH, V_PITCH = 528;
__device__ __forceinline__ void gla_state_phase(LAS unsigned char* lds, bf16_t* Z, const float* GLR, const float* wgu, const float* bgate, bf16_t* CS, float* DEC,
                                                int tid, int lane, int wave, int G) {
    LAS float* lr = (LAS float*)(lds + G1_LR);
    LAS float* eb = (LAS float*)(lds + G1_EB);
    const unsigned kd_a = (unsigned)(size_t)(lds + G1_KD), v_a = (unsigned)(size_t)(lds + G1_V);
    const int g4 = lane >> 4, q4 = (lane & 15) >> 2, p4 = lane & 3;
    float W[16];
#pragma unroll
    for (int r = 0; r < 16; ++r) W[r] = wgu[r * 512 + tid];
    const float bg = bgate[tid];
#pragma unroll 1
    for (int n = blockIdx.x; n < T / 64; n += G) {
        __syncthreads();
        if (tid < 256) *(LAS f32x4*)(lr + 4 * tid) = *(const f32x4*)(GLR + (size_t)n * 1024 + 4 * tid);
#pragma unroll
        for (int i = 0; i < 8; ++i) { const int idx = tid + 512 * i, c = idx >> 6, ch = idx & 63;
            *(LAS u32x4*)(lds + G1_KD + c * KD_PITCH + ch * 16) = *(const u32x4*)(Z + (size_t)(64 * n + c) * 4096 + 1536 + 8 * ch); }
        __syncthreads();
        float bc = 0.f;
        bf16_t* zq = Z + (size_t)(64 * n) * 4096 + 1024 + tid;
#pragma unroll 1
        for (int c0 = 0; c0 < 64; c0 += 16) {
            bf16_t qv[16];
#pragma unroll
            for (int i = 0; i < 16; ++i) qv[i] = zq[(size_t)(c0 + i) * 4096];
#pragma unroll
            for (int i = 0; i < 16; ++i) { const int c = c0 + i; float s = bg;
#pragma unroll
                for (int r4 = 0; r4 < 4; ++r4) { const f32x4 a = *(const LAS f32x4*)(lr + c * 16 + 4 * r4); s += (a.x * W[4 * r4] + a.y * W[4 * r4 + 1]) + (a.z * W[4 * r4 + 2] + a.w * W[4 * r4 + 3]); }
                const float ls = fminf(s, 0.f) - __logf(1.0f + __expf(-fabsf(s)));
                bc += ls * (1.0f / 16.0f);
                const float eq = __expf(bc);
                zq[(size_t)c * 4096] = f2bf(bf2f(qv[i]) * 0.08838834764831845f * eq);
                LAS bf16_t* kp = (LAS bf16_t*)(lds + G1_KD + c * KD_PITCH + 2 * tid);
                *kp = f2bf(bf2f(*kp) * __builtin_amdgcn_rcpf(eq)); }
        }
        { const float e = __expf(bc); eb[tid] = e; DEC[(size_t)n * 512 + tid] = e; }
        __syncthreads();
#pragma unroll
        for (int i = 0; i < 8; ++i) { const int idx = tid + 512 * i, c = idx >> 6, ch = idx & 63;
            *(u32x4*)(Z + (size_t)(64 * n + c) * 4096 + 1536 + 8 * ch) = *(const LAS u32x4*)(lds + G1_KD + c * KD_PITCH + ch * 16); }
#pragma unroll 1
        for (int h = 0; h < 4; ++h) {
            if (h) __syncthreads();
#pragma unroll
            for (int i = 0; i < 4; ++i) { const int idx = tid + 512 * i, c = idx >> 5, ch = idx & 31;
                *(LAS u32x4*)(lds + G1_V + c * V_PITCH + ch * 16) = *(const u32x4*)(Z + (size_t)(64 * n + c) * 4096 + 2048 + h * 256 + 8 * ch); }
            __syncthreads();
            f32x4 acc[8][2];
#pragma unroll
            for (int mb = 0; mb < 8; ++mb) { acc[mb][0] = (f32x4){0.f, 0.f, 0.f, 0.f}; acc[mb][1] = (f32x4){0.f, 0.f, 0.f, 0.f}; }
#pragma unroll
            for (int ks = 0; ks < 2; ++ks) {
                bf16x8 bfr[2];
#pragma unroll
                for (int nb = 0; nb < 2; ++nb) { const unsigned a0 = v_a + (32 * ks + 8 * g4 + q4) * V_PITCH + (32 * wave + 16 * nb + 4 * p4) * 2; bfr[nb] = tr_frag(a0, a0 + 4 * V_PITCH); }
#pragma unroll
                for (int mb = 0; mb < 8; ++mb) { const unsigned a0 = kd_a + (32 * ks + 8 * g4 + q4) * KD_PITCH + (128 * h + 16 * mb + 4 * p4) * 2; const bf16x8 af = tr_frag(a0, a0 + 4 * KD_PITCH);
                    acc[mb][0] = mma16(af, bfr[0], acc[mb][0]); acc[mb][1] = mma16(af, bfr[1], acc[mb][1]); }
            }
            bf16_t* cs = CS + ((size_t)(n * 4 + h) * 256) * 128;
#pragma unroll
            for (int mb = 0; mb < 8; ++mb) { const f32x4 e4 = *(const LAS f32x4*)(eb + 128 * h + 16 * mb + 4 * g4);
#pragma unroll
                for (int nb = 0; nb < 2; ++nb) { const f32x4 v = acc[mb][nb] * e4; u32x2 w; w.x = pk_bf16(v[0], v[1]); w.y = pk_bf16(v[2], v[3]);
                    *(u32x2*)(cs + (size_t)(32 * wave + 16 * nb + (lane & 15)) * 128 + 16 * mb + 4 * g4) = w; } }
        }
    }
}

__device__ __forceinline__ void gla_scan_phase(const bf16_t* CS, const float* DEC, bf16_t* SP, int tid, int G) {
#pragma unroll 1
    for (int e = blockIdx.x * NTHR + tid; e < 4 * 256 * 128; e += G * NTHR) {
        const int h = e >> 15, k = e & 127;
        float S = 0.f;
        const bf16_t* cp = CS + e; const float* dp = DEC + h * 128 + k; bf16_t* sp = SP + e;
        bf16_t c0[16], c1[16]; float d0[16], d1[16];
#pragma unroll
        for (int i = 0; i < 16; ++i) { c0[i] = cp[(size_t)i * 131072]; d0[i] = dp[(size_t)i * 512]; }
#pragma unroll 1
        for (int n0 = 0; n0 < 256; n0 += 32) {
#pragma unroll
            for (int i = 0; i < 16; ++i) { c1[i] = cp[(size_t)(n0 + 16 + i) * 131072]; d1[i] = dp[(size_t)(n0 + 16 + i) * 512]; }
#pragma unroll
            for (int i = 0; i < 16; ++i) { sp[(size_t)(n0 + i) * 131072] = f2bf(S); S = fmaf(d0[i], S, bf2f(c0[i])); }
            if (n0 + 32 < 256) {
#pragma unroll
                for (int i = 0; i < 16; ++i) { c0[i] = cp[(size_t)(n0 + 32 + i) * 131072]; d0[i] = dp[(size_t)(n0 + 32 + i) * 512]; } }
#pragma unroll
            for (int i = 0; i < 16; ++i) { sp[(size_t)(n0 + 16 + i) * 131072] = f2bf(S); S = fmaf(d1[i], S, bf2f(c1[i])); }
        }
    }
}

constexpr int G3_QD = 0, QK_PITCH = 272, G3_KD = 64 * QK_PITCH, G3_V = 2 * 64 * QK_PITCH, G3_ATT = G3_V + 64 * V_PITCH, ATT_PITCH = 144,
              G3_SSQ = G3_ATT + 64 * ATT_PITCH, G3_RSTD = G3_SSQ + 2048, G3_STG = 0, STG_PITCH = 260;
static_assert(64 * STG_PITCH * 4 <= G3_ATT, "o staging aliases the q/k/v images only");
__device__ __forceinline__ void gla_out_phase(LAS unsigned char* lds, const bf16_t* Z, const bf16_t* SP, const float* gnorm, bf16_t* MIX, int tid, int lane, int wave, int G) {
    const unsigned v_a = (unsigned)(size_t)(lds + G3_V);
    const int g4 = lane >> 4, l15 = lane & 15, q4 = l15 >> 2, p4 = lane & 3;
    LAS float* ssq = (LAS float*)(lds + G3_SSQ); LAS float* rstd = (LAS float*)(lds + G3_RSTD); LAS float* stg = (LAS float*)(lds + G3_STG);
#pragma unroll 1
    for (int n = blockIdx.x; n < T / 64; n += G) {
        u32x4 nq[2], nk[2], nv[4], nr[4]; bf16x8 nsp[2][4];
#define G3_REQUEST(hh) do { \
            _Pragma("unroll") for (int i = 0; i < 2; ++i) { const int idx = tid + 512 * i, row = idx >> 4, ch = idx & 15; const bf16_t* zr = Z + (size_t)(64 * n + row) * 4096 + (hh) * 128 + 8 * ch; \
                nq[i] = *(const u32x4*)(zr + 1024); nk[i] = *(const u32x4*)(zr + 1536); } \
            _Pragma("unroll") for (int i = 0; i < 4; ++i) { const int idx = tid + 512 * i, c = idx >> 5, ch = idx & 31; nv[i] = *(const u32x4*)(Z + (size_t)(64 * n + c) * 4096 + 2048 + (hh) * 256 + 8 * ch); } \
            _Pragma("unroll") for (int i = 0; i < 4; ++i) { const int item = tid + 512 * i, row = item >> 5, c8 = (item & 31) * 8; nr[i] = *(const u32x4*)(Z + (size_t)(64 * n + row) * 4096 + 3072 + (hh) * 256 + c8); } \
            { const bf16_t* spb = SP + ((size_t)(n * 4 + (hh)) * 256) * 128; \
              _Pragma("unroll") for (int nb = 0; nb < 2; ++nb) _Pragma("unroll") for (int ks = 0; ks < 4; ++ks) nsp[nb][ks] = *(const bf16x8*)(spb + (size_t)(32 * wave + 16 * nb + l15) * 128 + 32 * ks + 8 * g4); } } while (0)
        G3_REQUEST(0);
#pragma unroll 1
        for (int h = 0; h < 4; ++h) {
            __syncthreads();
#pragma unroll
            for (int i = 0; i < 2; ++i) { const int idx = tid + 512 * i, row = idx >> 4, ch = idx & 15;
                *(LAS u32x4*)(lds + G3_QD + row * QK_PITCH + ch * 16) = nq[i]; *(LAS u32x4*)(lds + G3_KD + row * QK_PITCH + ch * 16) = nk[i]; }
#pragma unroll
            for (int i = 0; i < 4; ++i) { const int idx = tid + 512 * i, c = idx >> 5, ch = idx & 31; *(LAS u32x4*)(lds + G3_V + c * V_PITCH + ch * 16) = nv[i]; }
            u32x4 rpre[4]; bf16x8 sp[2][4];
#pragma unroll
            for (int i = 0; i < 4; ++i) rpre[i] = nr[i];
#pragma unroll
            for (int nb = 0; nb < 2; ++nb)
#pragma unroll
                for (int ks = 0; ks < 4; ++ks) sp[nb][ks] = nsp[nb][ks];
            { const int hn = h < 3 ? h + 1 : 3; G3_REQUEST(hn); }
            __syncthreads();
            f32x4 acc[4][2];
#pragma unroll
            for (int mb = 0; mb < 4; ++mb) { acc[mb][0] = (f32x4){0.f, 0.f, 0.f, 0.f}; acc[mb][1] = (f32x4){0.f, 0.f, 0.f, 0.f}; }
#pragma unroll
            for (int ks = 0; ks < 4; ++ks)
#pragma unroll
                for (int mb = 0; mb < 4; ++mb) { const bf16x8 a = *(const LAS bf16x8*)(lds + G3_QD + (16 * mb + l15) * QK_PITCH + (32 * ks + 8 * g4) * 2);
                    acc[mb][0] = mma16(a, sp[0][ks], acc[mb][0]); acc[mb][1] = mma16(a, sp[1][ks], acc[mb][1]); }
            { const int jb = wave >> 1;
#pragma unroll
                for (int ib2 = 0; ib2 < 2; ++ib2) { const int ib = 2 * (wave & 1) + ib2; f32x4 at = (f32x4){0.f, 0.f, 0.f, 0.f};
                    if (jb <= ib) {
#pragma unroll
                        for (int ks = 0; ks < 4; ++ks) { const bf16x8 a = *(const LAS bf16x8*)(lds + G3_KD + (16 * jb + l15) * QK_PITCH + (32 * ks + 8 * g4) * 2);
                            const bf16x8 b = *(const LAS bf16x8*)(lds + G3_QD + (16 * ib + l15) * QK_PITCH + (32 * ks + 8 * g4) * 2); at = mma16(a, b, at); } }
                    const int i = 16 * ib + l15, j0 = 16 * jb + 4 * g4;
                    u32x2 w; w.x = pk_bf16(j0 + 0 <= i ? at[0] : 0.f, j0 + 1 <= i ? at[1] : 0.f); w.y = pk_bf16(j0 + 2 <= i ? at[2] : 0.f, j0 + 3 <= i ? at[3] : 0.f);
                    *(LAS u32x2*)(lds + G3_ATT + i * ATT_PITCH + j0 * 2) = w; } }
            __syncthreads();
#pragma unroll
            for (int ks = 0; ks < 2; ++ks) {
                bf16x8 bfr[2];
#pragma unroll
                for (int nb = 0; nb < 2; ++nb) { const unsigned a0 = v_a + (32 * ks + 8 * g4 + q4) * V_PITCH + (32 * wave + 16 * nb + 4 * p4) * 2; bfr[nb] = tr_frag(a0, a0 + 4 * V_PITCH); }
#pragma unroll
                for (int mb = 0; mb < 4; ++mb) { const bf16x8 a = *(const LAS bf16x8*)(lds + G3_ATT + (16 * mb + l15) * ATT_PITCH + (32 * ks + 8 * g4) * 2);
                    acc[mb][0] = mma16(a, bfr[0], acc[mb][0]); acc[mb][1] = mma16(a, bfr[1], acc[mb][1]); }
            }
#pragma unroll
            for (int mb = 0; mb < 4; ++mb)
#pragma unroll
                for (int r = 0; r < 4; ++r) { float p = acc[mb][0][r] * acc[mb][0][r] + acc[mb][1][r] * acc[mb][1][r];
                    p += __shfl_xor(p, 1); p += __shfl_xor(p, 2); p += __shfl_xor(p, 4); p += __shfl_xor(p, 8);
                    if (l15 == 0) ssq[wave * 64 + 16 * mb + 4 * g4 + r] = p; }
            __syncthreads();
            if (tid < 64) { float s = 0.f;
#pragma unroll
                for (int w = 0; w < 8; ++w) s += ssq[w * 64 + tid];
                rstd[tid] = rsqrtf(s * (1.0f / 256.0f) + EPSF); }
#pragma unroll
            for (int mb = 0; mb < 4; ++mb)
#pragma unroll
                for (int nb = 0; nb < 2; ++nb)
#pragma unroll
                    for (int r = 0; r < 4; ++r) stg[(16 * mb + 4 * g4 + r) * STG_PITCH + 32 * wave + 16 * nb + l15] = acc[mb][nb][r];
            __syncthreads();
#pragma unroll
            for (int i = 0; i < 4; ++i) { const int item = tid + 512 * i, row = item >> 5, c8 = (item & 31) * 8;
                const f32x4 o0 = *(const LAS f32x4*)(stg + row * STG_PITCH + c8), o1 = *(const LAS f32x4*)(stg + row * STG_PITCH + c8 + 4);
                const float rs = rstd[row];
                const f32x4 g0 = *(const f32x4*)(gnorm + h * 256 + c8), g1 = *(const f32x4*)(gnorm + h * 256 + c8 + 4);
                const u32x4 rr = rpre[i];
                u32x4 w;
                w.x = pk_bf16(o0.x * rs * g0.x * silu_f(bf_lo(rr.x)), o0.y * rs * g0.y * silu_f(bf_hi(rr.x)));
                w.y = pk_bf16(o0.z * rs * g0.z * silu_f(bf_lo(rr.y)), o0.w * rs * g0.w * silu_f(bf_hi(rr.y)));
                w.z = pk_bf16(o1.x * rs * g1.x * silu_f(bf_lo(rr.z)), o1.y * rs * g1.y * silu_f(bf_hi(rr.z)));
                w.w = pk_bf16(o1.z * rs * g1.z * silu_f(bf_lo(rr.w)), o1.w * rs * g1.w * silu_f(bf_hi(rr.w)));
                *(u32x4*)(MIX + (size_t)(64 * n + row) * 2048 + 1024 + h * 256 + c8) = w; }
        }
    }
}

#undef G3_REQUEST
__device__ __forceinline__ void assign_phase(LAS unsigned char* lds, const int* topi, const int* hist, int* tok_slot, int* blk_expert, int* nrb_out,
                                             const bf16_t* H, bf16_t* HS, int tid, int lane, int wave, int G) {
    LAS int* lh = (LAS int*)lds;
    LAS int* tot = (LAS int*)(lds + 8192);
    LAS int* myslot = (LAS int*)(lds + 8192 + 256);
#pragma unroll
    for (int i = 0; i < 4; ++i) lh[tid + 512 * i] = __hip_atomic_load(hist + tid + 512 * i, RLX_AGENT);
    __syncthreads();
#pragma unroll 1
    for (int rb = blockIdx.x; rb < T / 64; rb += G) {
        if (tid < 48) tot[tid] = 0;
        __syncthreads();
        { const int e = tid & 7, j = tid >> 3; int t_ = 0, b_ = 0;
#pragma unroll
            for (int q = 0; q < 4; ++q) { const int bb = 4 * j + q; const int c = lh[bb * 8 + e]; t_ += c; b_ += (bb < rb) ? c : 0; }
            __hip_atomic_fetch_add(tot + e, t_, __ATOMIC_RELAXED, __HIP_MEMORY_SCOPE_WORKGROUP); __hip_atomic_fetch_add(tot + 16 + e, b_, __ATOMIC_RELAXED, __HIP_MEMORY_SCOPE_WORKGROUP); }
        __syncthreads();
        if (tid == 0) { int run = 0;
#pragma unroll
            for (int e = 0; e < 8; ++e) { const int pd = ((tot[e] + 255) >> 8) << 8; tot[8 + e] = pd; tot[24 + e] = run + tot[16 + e]; run += pd; tot[40 + e] = run; }
            if (rb == 0) *nrb_out = run >> 8; }
        __syncthreads();
        if (rb == 0 && tid < NRB_MAX) { int e = 0;
#pragma unroll
            for (int q = 0; q < 8; ++q) e += (tot[40 + q] <= tid * 256) ? 1 : 0;
            blk_expert[tid] = e < 7 ? e : 7; }
        int my_e = 0, my_rank = 0;
        if (wave < 2) { my_e = topi[128 * rb + tid];
#pragma unroll
            for (int e = 0; e < 8; ++e) { const unsigned long long m = __ballot(my_e == e);
                if (my_e == e) my_rank = __popcll(m & ((1ull << lane) - 1ull));
                if (wave == 0 && lane == 0) tot[32 + e] = __popcll(m); } }
        __syncthreads();
        if (wave < 2) { const int s = tot[24 + my_e] + my_rank + (wave == 1 ? tot[32 + my_e] : 0); myslot[tid] = s; tok_slot[128 * rb + tid] = s; }
        __syncthreads();
#pragma unroll 1
        for (int i0 = wave; i0 < 128; i0 += 32) {
#if MOE_UP_FMT == 2
            u32x4 v[4][4]; int sl[4];
#pragma unroll
            for (int k = 0; k < 4; ++k) { const int i = i0 + 8 * k; const int t = 64 * rb + (i >> 1); sl[k] = myslot[i];
#pragma unroll
                for (int q = 0; q < 4; ++q) v[k][q] = ((const u32x4*)(H + (size_t)t * DM))[4 * lane + q]; }
#pragma unroll
            for (int k = 0; k < 4; ++k) { f32x16 lo, hi;
#pragma unroll
                for (int q = 0; q < 2; ++q) { const u32x4 x = v[k][q], y = v[k][2 + q];
                    lo[8 * q + 0] = bf_lo(x.x); lo[8 * q + 1] = bf_hi(x.x); lo[8 * q + 2] = bf_lo(x.y); lo[8 * q + 3] = bf_hi(x.y); lo[8 * q + 4] = bf_lo(x.z); lo[8 * q + 5] = bf_hi(x.z); lo[8 * q + 6] = bf_lo(x.w); lo[8 * q + 7] = bf_hi(x.w);
                    hi[8 * q + 0] = bf_lo(y.x); hi[8 * q + 1] = bf_hi(y.x); hi[8 * q + 2] = bf_lo(y.y); hi[8 * q + 3] = bf_hi(y.y); hi[8 * q + 4] = bf_lo(y.z); hi[8 * q + 5] = bf_hi(y.z); hi[8 * q + 6] = bf_lo(y.w); hi[8 * q + 7] = bf_hi(y.w); }
#pragma unroll
                for (int i = 0; i < 16; ++i) { lo[i] = __builtin_fminf(__builtin_fmaxf(2.f * lo[i], -7.5f), 7.5f); hi[i] = __builtin_fminf(__builtin_fmaxf(2.f * hi[i], -7.5f), 7.5f); }
                const u32x6 w = __builtin_amdgcn_cvt_scalef32_2xpk16_fp6_f32(lo, hi, 1.0f);
                unsigned char* d = (TILE_HS ? (unsigned char*)HS + (size_t)(sl[k] >> 8) * (16 * 32768) + (size_t)(sl[k] & 255) * 128 + (size_t)(lane >> 2) * 32768
                                            : (unsigned char*)HS + (size_t)sl[k] * DM + (lane >> 2) * 128) + 16 * (lane & 3);
                *(u32x4*)d = (u32x4){w[0], w[1], w[2], w[3]}; *(u32x4*)(d + 64) = (u32x4){w[4], w[5], 0u, 0u};     }
#else
            u32x4 v[4][4]; int sl[4];
#pragma unroll
            for (int k = 0; k < 4; ++k) { const int i = i0 + 8 * k; const int t = 64 * rb + (i >> 1); sl[k] = myslot[i];
#pragma unroll
                for (int q = 0; q < 4; ++q) { const int ch = lane + 64 * q;
                    v[k][q] = TILE_H ? *(const u32x4*)(H + ((size_t)(t >> 8) * 32 + (ch >> 3)) * 16384 + (size_t)(t & 255) * 64 + (ch & 7) * 8) : ((const u32x4*)(H + (size_t)t * DM))[ch]; } }
#pragma unroll
            for (int k = 0; k < 4; ++k) { unsigned char* drow = TILE_HS ? (unsigned char*)HS + (size_t)(sl[k] >> 8) * (16 * 32768) + (size_t)(sl[k] & 255) * 128 : (unsigned char*)HS + (size_t)sl[k] * DM;
#pragma unroll
                for (int q = 0; q < 4; ++q) { const u32x4 x = v[k][q]; int w0 = 0, w1 = 0;
                    w0 = __builtin_amdgcn_cvt_pk_fp8_f32(4.f * bf_lo(x.x), 4.f * bf_hi(x.x), w0, false); w0 = __builtin_amdgcn_cvt_pk_fp8_f32(4.f * bf_lo(x.y), 4.f * bf_hi(x.y), w0, true);
                    w1 = __builtin_amdgcn_cvt_pk_fp8_f32(4.f * bf_lo(x.z), 4.f * bf_hi(x.z), w1, false); w1 = __builtin_amdgcn_cvt_pk_fp8_f32(4.f * bf_lo(x.w), 4.f * bf_hi(x.w), w1, true);
                    const int ch = lane + 64 * q;
                    *(u32x2*)(TILE_HS ? drow + (size_t)(ch >> 4) * 32768 + 8 * (ch & 15) : drow + 8 * ch) = (u32x2){(unsigned)w0, (unsigned)w1}; } }
#endif
        }
        __syncthreads();
    }
}

__device__ __forceinline__ void final_phase(LAS unsigned char* lds, const bf16_t* XS, const bf16_t* Y, const float* P, const int* nrb_p, const int* tok_slot, const float* topw,
                                            const float* gain, float* out, int tid, int lane, int wave, int G) {
    LAS int* tbl = (LAS int*)lds;
    const int nrb = __builtin_amdgcn_readfirstlane(__hip_atomic_load(nrb_p, RLX_AGENT));
    int full, tail, sk; moe_tail_split(nrb, G, full, tail, sk);
    for (int i = tid; i < NRB_MAX * 8; i += NTHR) tbl[i] = -1;
    __syncthreads();
    if (tid < tail) { int pm, pn; pg8::unit_map((long)full + tid, nrb, 8, pm, pn); tbl[pm * 8 + pn] = tid; }
    __syncthreads();
    f32x4 gv[8];
#pragma unroll
    for (int j = 0; j < 8; ++j) gv[j] = *(const f32x4*)(gain + 4 * lane + 256 * j);
    const int rstep = G * 8, rfirst = blockIdx.x * 8 + wave;
    if (rfirst >= T) return;
    auto clampr = [&](int r) { return r < T ? r : rfirst; };
    int cs0 = tok_slot[2 * rfirst], cs1 = tok_slot[2 * rfirst + 1]; float cw0 = topw[2 * rfirst], cw1 = topw[2 * rfirst + 1];
    int r1 = clampr(rfirst + rstep);
    int ns0 = tok_slot[2 * r1], ns1 = tok_slot[2 * r1 + 1]; float nw0 = topw[2 * r1], nw1 = topw[2 * r1 + 1];
    u32x2 px[8], py0[8], py1[8];
#pragma unroll
    for (int j = 0; j < 8; ++j) { px[j] = ((const u32x2*)(XS + (size_t)rfirst * DM) + lane)[64 * j]; py0[j] = ((const u32x2*)(Y + (size_t)cs0 * DM) + lane)[64 * j]; py1[j] = ((const u32x2*)(Y + (size_t)cs1 * DM) + lane)[64 * j]; }
#pragma unroll 1
    for (int row = rfirst; row < T; row += rstep) {
        const int s0 = cs0, s1 = cs1; const float w0 = cw0, w1 = cw1;
        u32x2 cx[8], cy0[8], cy1[8];
#pragma unroll
        for (int j = 0; j < 8; ++j) { cx[j] = px[j]; cy0[j] = py0[j]; cy1[j] = py1[j]; }
        { const int rn = clampr(row + rstep), rnn = clampr(row + 2 * rstep);
#pragma unroll
            for (int j = 0; j < 8; ++j) { px[j] = ((const u32x2*)(XS + (size_t)rn * DM) + lane)[64 * j]; py0[j] = ((const u32x2*)(Y + (size_t)ns0 * DM) + lane)[64 * j]; py1[j] = ((const u32x2*)(Y + (size_t)ns1 * DM) + lane)[64 * j]; }
            cs0 = ns0; cs1 = ns1; cw0 = nw0; cw1 = nw1;
            ns0 = tok_slot[2 * rnn]; ns1 = tok_slot[2 * rnn + 1]; nw0 = topw[2 * rnn]; nw1 = topw[2 * rnn + 1]; }
        f32x4 v[8]; float ss = 0.f;
        int anyt = -1;
#pragma unroll
        for (int j = 0; j < 8; ++j) { const int t0 = tbl[(s0 >> 8) * 8 + j], t1 = tbl[(s1 >> 8) * 8 + j]; anyt = t0 > anyt ? t0 : anyt; anyt = t1 > anyt ? t1 : anyt; }
        if (anyt < 0) {
#pragma unroll
            for (int j = 0; j < 8; ++j) { const u32x2 q = cx[j], a = cy0[j], b = cy1[j];
                v[j].x = bf_lo(q.x) + w0 * bf_lo(a.x) + w1 * bf_lo(b.x); v[j].y = bf_hi(q.x) + w0 * bf_hi(a.x) + w1 * bf_hi(b.x);
                v[j].z = bf_lo(q.y) + w0 * bf_lo(a.y) + w1 * bf_lo(b.y); v[j].w = bf_hi(q.y) + w0 * bf_hi(a.y) + w1 * bf_hi(b.y); }
        } else {
#pragma unroll 1
            for (int j = 0; j < 8; ++j) { { const u32x2 q = ((const u32x2*)(XS + (size_t)row * DM) + lane)[64 * j]; v[j] = (f32x4){bf_lo(q.x), bf_hi(q.x), bf_lo(q.y), bf_hi(q.y)}; }
#pragma unroll 1
                for (int k = 0; k < 2; ++k) { const int sl = k ? s1 : s0; const float w = k ? w1 : w0;
                    const int t = tbl[(sl >> 8) * 8 + j]; f32x4 y;
                    if (t >= 0) { y = (f32x4){0.f, 0.f, 0.f, 0.f};
                        for (int q = 0; q < sk; ++q) y += *(const f32x4*)(P + ((size_t)(t * sk + q) * 256 + (sl & 255)) * 256 + 4 * lane); }
                    else { const u32x2 a = ((const u32x2*)(Y + (size_t)sl * DM) + lane)[64 * j]; y = (f32x4){bf_lo(a.x), bf_hi(a.x), bf_lo(a.y), bf_hi(a.y)}; }
                    v[j] += w * y; } }
        }
#pragma unroll
        for (int j = 0; j < 8; ++j) ss += (v[j].x * v[j].x + v[j].y * v[j].y) + (v[j].z * v[j].z + v[j].w * v[j].w);
        const float rstd = rsqrtf(wave_sum(ss) * (1.0f / DM) + EPSF);
        f32x4* orow = (f32x4*)(out + (size_t)row * DM) + lane;
#pragma unroll
        for (int j = 0; j < 8; ++j) orow[64 * j] = v[j] * rstd * gv[j];
    }
}
#ifdef NO_GEMM
#define GEMMCALL(...) ;
#else
#define GEMMCALL(...) __VA_ARGS__
#endif
#ifdef NO_CVT
#define CVTCALL(...) ;
#else
#define CVTCALL(...) __VA_ARGS__
#endif
#ifdef NO_NORM
#define NORMCALL(...) ;
#else
#define NORMCALL(...) __VA_ARGS__
#endif
#ifdef NO_PRE
#define PRECALL(...) ;
#else
#define PRECALL(...) __VA_ARGS__
#endif
#ifdef NO_SCAN
#define SCANCALL(...) ;
#else
#define SCANCALL(...) __VA_ARGS__
#endif
#ifdef NO_OUT
#define OUTCALL(...) ;
#else
#define OUTCALL(...) __VA_ARGS__
#endif
#ifdef NO_ASG
#define ASGCALL(...) ;
#else
#define ASGCALL(...) __VA_ARGS__
#endif
#ifdef NO_FIN
#define FINCALL(...) ;
#else
#define FINCALL(...) __VA_ARGS__
#endif
struct Args { const float* in[18]; float* out; unsigned char* ws; int ph_lo, ph_hi, cvt_items, pad; };

__global__ void __launch_bounds__(NTHR, 2) fwd(Args args) {
    extern __shared__ __attribute__((aligned(16))) unsigned char lds_raw[];
    LAS unsigned char* lds = (LAS unsigned char*)lds_raw;
    volatile LAS unsigned* MISC = (volatile LAS unsigned*)(lds + MISC_OFF);
    const int tid = threadIdx.x, lane = tid & 63, wave = __builtin_amdgcn_readfirstlane(tid >> 6);
    const int G = gridDim.x;
    unsigned char* ws = args.ws;
    unsigned* ctl = (unsigned*)(ws + WS_CTL);
    const int lo = args.ph_lo, hi = args.ph_hi;
    if (tid < 64) MISC[tid] = 0u;
    __syncthreads();
    XcdBarrier bar; bar.bar = ctl + CW_BAR; bar.x = 0; bar.st = nullptr;
    if (hi - lo > 1) bar = xcd_barrier_post(ctl + CW_BAR, MISC + 8);
#define IN(k) (lo <= (k) && (k) < hi)
#define SEAM(k) do { if (IN(k) && IN((k) + 1)) xcd_barrier(bar); } while (0)

    const float* x = args.in[0]; const float* mix_norm = args.in[1]; const float* w_in = args.in[2]; const float* pool_scale = args.in[4];
    const float* w_gate_up = args.in[5]; const float* b_gate = args.in[6]; const float* gla_norm = args.in[7]; const float* ffn_norm = args.in[9];
    const float* w_router = args.in[13]; const float* final_norm = args.in[17];
    bf16_t* H = (bf16_t*)(ws + WS_H); bf16_t* XS = (bf16_t*)(ws + WS_XS); float* GLR = (float*)(ws + WS_GLR);
    bf16_t* Z = (bf16_t*)(ws + WS_Z); bf16_t* DP = (bf16_t*)(ws + WS_DP); bf16_t* MIX = (bf16_t*)(ws + WS_MIX);
    bf16_t* CS = (bf16_t*)(ws + WS_CS); bf16_t* SP = (bf16_t*)(ws + WS_SP); float* DEC = (float*)(ws + WS_DEC);
    bf16_t* ACT = (bf16_t*)(ws + WS_ACT); bf16_t* HS = (bf16_t*)(ws + WS_HS); bf16_t* ACT2 = (bf16_t*)(ws + WS_ACT2); bf16_t* Y = (bf16_t*)(ws + WS_Y);
    int* topi = (int*)(ws + WS_ROUTE + RT_TOPI); float* topw = (float*)(ws + WS_ROUTE + RT_TOPW); int* tok_slot = (int*)(ws + WS_ROUTE + RT_TOKSLOT);
    int* hist = (int*)(ws + WS_ROUTE + RT_HIST); int* blk_expert = (int*)(ws + WS_ROUTE + RT_BLKE); int* nrb_p = (int*)(ws + WS_ROUTE + RT_NRB);

    if (IN(PH_PRO)) {
        CvtPtrs P; P.w_in = w_in; P.w_pool = args.in[3]; P.w_out = args.in[8]; P.dwg = args.in[10]; P.dwu = args.in[11]; P.dwd = args.in[12];
        P.ewg = args.in[14]; P.ewu = args.in[15]; P.ewd = args.in[16]; P.ws = ws;
        LAS float* scr = (LAS float*)(lds + wave * 17408);
        const int gw = blockIdx.x * 8 + wave, NGW = G * 8;
        CVTCALL({ const int nit = args.cvt_items;
            if (gw < nit) { f32x4 va[16], vb[16]; CvtJob ja = cvt_decode(P, gw), jb; cvt_load(ja, va, lane);
                _Pragma("unroll 1") for (int it = gw; it < nit; it += 2 * NGW) {
                    const int i2 = it + NGW, i3 = i2 + NGW;
                    jb = cvt_decode(P, i2 < nit ? i2 : nit - 1); cvt_load(jb, vb, lane);
                    cvt_finish(ja, va, scr, lane);
                    ja = cvt_decode(P, i3 < nit ? i3 : nit - 1); cvt_load(ja, va, lane);
                    if (i2 < nit) cvt_finish(jb, vb, scr, lane);
                } } })
        __syncthreads();
        NORMCALL(norm_phase<0, false, false>(lds, x, mix_norm, H, w_in + 3072, ZW, GLR, nullptr, nullptr, nullptr, tid, lane, wave, G);)
    }
    SEAM(PH_PRO);

    { constexpr int l = 0;
        const int pb = 1 + PH_PER_LAYER * l;
        if (IN(pb + PK_INPROJ)) {
            pg8::Gemm g{TILE_H ? 64 : 2048, 64, 2048, 0, 0, TILE_H ? 32768 : 128, 32768}; pg8::Order<false> S; S.init(T / 256, 16, G, (int)blockIdx.x);
            S.A = (const char*)H; S.B = (const char*)(ws + WS_WIN) + (size_t)l * 4096 * 2048 * 2; S.a_pm = (size_t)256 * 2048 * 2; S.a_pn = 0; S.b_pn = (size_t)256 * 2048 * 2; S.b_e = 0; S.blk_expert = nullptr;
            pg8::EpiBf16 E{Z, 4096, nullptr};
            GEMMCALL(pg8::gemm_phase<pg8::EpiBf16, pg8::Order<false>, GEMM_ALIGN, GEMM_SP2>(lds, g, S, E);)
        }
        SEAM(pb + PK_INPROJ);
        if (IN(pb + PK_PRE)) {
            PRECALL(pool_d_phase(Z, DP, tid, G);)
            PRECALL(gla_state_phase(lds, Z, GLR, w_gate_up + (size_t)l * 16 * 512, b_gate + l * 512, CS, DEC, tid, lane, wave, G);)
        }
        SEAM(pb + PK_PRE);
        if (IN(pb + PK_POOLSCAN)) {
            SCANCALL(gla_scan_phase(CS, DEC, SP, tid, G);)
            __syncthreads();
            pg8::Gemm g{1024, 64, 256, 0, 0, 128, 32768}; pg8::Order<false> S; S.init(T / 256, 4, G, (int)blockIdx.x);
            S.A = (const char*)DP; S.B = (const char*)(ws + WS_WPOOL) + (size_t)l * 4 * 65536 * 2; S.a_pm = (size_t)256 * 1024 * 2; S.a_pn = 256 * 2; S.b_pn = (size_t)65536 * 2; S.b_e = 0; S.blk_expert = nullptr;
            pg8::EpiBf16 E{MIX, 2048, pool_scale + l * 1024};
            GEMMCALL(pg8::gemm_phase<pg8::EpiBf16, pg8::Order<false>, GEMM_ALIGN, GEMM_SP2>(lds, g, S, E);)
        }
        SEAM(pb + PK_POOLSCAN);
        if (IN(pb + PK_GLAOUT)) OUTCALL(gla_out_phase(lds, Z, SP, gla_norm + l * 1024, MIX, tid, lane, wave, G);)
        SEAM(pb + PK_GLAOUT);
        if (IN(pb + PK_OUTPROJ)) {
            pg8::Gemm g{2048, 64, 2048, 0, 0, 128, 32768}; pg8::Order<false> S; S.init(T / 256, 8, G, (int)blockIdx.x);
            S.A = (const char*)MIX; S.B = (const char*)(ws + WS_WOUT) + (size_t)l * 2048 * 2048 * 2; S.a_pm = (size_t)256 * 2048 * 2; S.a_pn = 0; S.b_pn = (size_t)256 * 2048 * 2; S.b_e = 0; S.blk_expert = nullptr;
            pg8::EpiRes<l == 0> E{l == 0 ? (const void*)x : (const void*)XS, XS, 2048};
            GEMMCALL(pg8::gemm_phase<pg8::EpiRes<l == 0>, pg8::Order<false>, true, true>(lds, g, S, E);)
        }
        SEAM(pb + PK_OUTPROJ);
        if (IN(pb + PK_NORM2)) {
            if (l == 0) NORMCALL(norm_phase<1, DENSE_FP8 == 1>(lds, XS, ffn_norm, H, nullptr, 0, nullptr, nullptr, nullptr, nullptr, tid, lane, wave, G);)
            else NORMCALL(norm_phase<2>(lds, XS, ffn_norm + DM, H, w_router, 8, nullptr, topi, topw, hist, tid, lane, wave, G);)
        }
        SEAM(pb + PK_NORM2);
        if (l == 1) { if (IN(pb + PK_ASSIGN)) ASGCALL(assign_phase(lds, topi, hist, tok_slot, blk_expert, nrb_p, H, HS, tid, lane, wave, G);)
            SEAM(pb + PK_ASSIGN); }
        if (IN(pb + PK_UP)) {
            if (l == 0) {
#if DENSE_FP8 == 1
                pg8::Gemm g{1024, 64, 1024, 0, 0x7f7f7f77, 128, 32768}; pg8::Order<false> S; S.init(T / 256, 44, G, (int)blockIdx.x);
                S.A = (const char*)H; S.B = (const char*)(ws + WS_WGU); S.a_pm = (size_t)256 * 2048; S.a_pn = 0; S.b_pn = (size_t)256 * 2048; S.b_e = 0; S.blk_expert = nullptr;
                pg8::EpiSwigluF8 E{(unsigned char*)ACT, 44, 4.f};
                GEMMCALL(pg8::gemm_phase<pg8::EpiSwigluF8, pg8::Order<false>, GEMM_ALIGN, GEMM_SP2, 1>(lds, g, S, E);)
#else
                pg8::Gemm g{TILE_H ? 64 : 2048, 64, 2048, 0, 0, TILE_H ? 32768 : 128, 32768}; pg8::Order<false> S; S.init(T / 256, 44, G, (int)blockIdx.x);
                S.A = (const char*)H; S.B = (const char*)(ws + WS_WGU); S.a_pm = (size_t)256 * 2048 * 2; S.a_pn = 0; S.b_pn = (size_t)256 * 2048 * 2; S.b_e = 0; S.blk_expert = nullptr;
#if DENSE_FP8 == 2
                pg8::EpiSwigluF8S E{(unsigned char*)ACT, 44, 4.f};
                GEMMCALL(pg8::gemm_phase<pg8::EpiSwigluF8S, pg8::Order<false>, true, GEMM_SP2>(lds, g, S, E);)
#else
                pg8::EpiSwiglu E{ACT, TILE_ACT ? 88 : -11264};
                GEMMCALL(pg8::gemm_phase<pg8::EpiSwiglu, pg8::Order<false>, GEMM_ALIGN, GEMM_SP2>(lds, g, S, E);)
#endif
#endif
            } else {
                const int nrb = __builtin_amdgcn_readfirstlane(__hip_atomic_load(nrb_p, RLX_AGENT));
                pg8::Gemm g{TILE_HS ? 64 : 1024, TILE_EWGU ? 64 : 1024, 1024, 0, MOE_UP_FMT == 2 ? 0x7f7f7f78 : 0x7f7f7f77, TILE_HS ? 32768 : 128, TILE_EWGU ? 32768 : 128}; pg8::Order<true> S; S.init(nrb, 56, G, (int)blockIdx.x);
                S.A = (const char*)HS; S.B = (const char*)(ws + WS_EWGU); S.a_pm = (size_t)256 * 2048; S.a_pn = 0; S.b_pn = (size_t)256 * 2048; S.b_e = (size_t)14336 * 2048; S.blk_expert = blk_expert;
                pg8::EpiSwigluF8S E{(unsigned char*)ACT2, 56, 4.f};
                GEMMCALL(pg8::gemm_phase<pg8::EpiSwigluF8S, pg8::Order<true>, true, GEMM_SP2, MOE_UP_FMT>(lds, g, S, E);)
            }
        }
        SEAM(pb + PK_UP);
        if (IN(pb + PK_DOWN)) {
            if (l == 0) {
#if DENSE_FP8
                pg8::Gemm g{64, 64, 2816, 0, 0x7f7f7f76, 32768, 32768}; pg8::Order<false> S; S.init(T / 256, 8, G, (int)blockIdx.x);
                S.A = (const char*)ACT; S.B = (const char*)(ws + WS_WD); S.a_pm = (size_t)256 * 5632; S.a_pn = 0; S.b_pn = (size_t)256 * 5632; S.b_e = 0; S.blk_expert = nullptr;
                pg8::EpiRes<false> E{XS, XS, 2048};
                GEMMCALL(pg8::gemm_phase<pg8::EpiRes<false>, pg8::Order<false>, true, true, 1>(lds, g, S, E);)
#else
                pg8::Gemm g{TILE_ACT ? 64 : 5632, 64, 5632, 0, 0, TILE_ACT ? 32768 : 128, 32768}; pg8::Order<false> S; S.init(T / 256, 8, G, (int)blockIdx.x);
                S.A = (const char*)ACT; S.B = (const char*)(ws + WS_WD); S.a_pm = (size_t)256 * 5632 * 2; S.a_pn = 0; S.b_pn = (size_t)256 * 5632 * 2; S.b_e = 0; S.blk_expert = nullptr;
                pg8::EpiRes<false> E{XS, XS, 2048};
                GEMMCALL(pg8::gemm_phase<pg8::EpiRes<false>, pg8::Order<false>, true, true>(lds, g, S, E);)
#endif
            } else {
                const int nrb = __builtin_amdgcn_readfirstlane(__hip_atomic_load(nrb_p, RLX_AGENT));
                pg8::Gemm g{TILE_ACT2 ? 64 : 3584, 64, 3584, 0, 0x7f7f7f76, TILE_ACT2 ? 32768 : 128, 32768}; pg8::Order<true> S; S.init(nrb, 8, G, (int)blockIdx.x);
                S.A = (const char*)ACT2; S.B = (const char*)(ws + WS_EWD); S.a_pm = (size_t)256 * 7168; S.a_pn = 0; S.b_pn = (size_t)256 * 7168; S.b_e = (size_t)2048 * 7168; S.blk_expert = blk_expert;
                int full, tail, sk; moe_tail_split(nrb, G, full, tail, sk); S.Lend = full;
                pg8::EpiBf16 E{Y, 2048, nullptr};
                GEMMCALL(pg8::gemm_phase<pg8::EpiBf16, pg8::Order<true>, GEMM_ALIGN, GEMM_SP2, 1>(lds, g, S, E);)
                if (sk > 0) {
                    const int kq = 3584 / sk;
                    pg8::Gemm g2{TILE_ACT2 ? 64 : 3584, 64, kq, 0, 0x7f7f7f76, TILE_ACT2 ? 32768 : 128, 32768}; pg8::TailOrder S2; S2.nM = nrb; S2.nN = 8; S2.c = (int)blockIdx.x; S2.full = full; S2.tail = tail; S2.s = sk; S2.ksliceA = TILE_ACT2 ? (size_t)(kq / 64) * 32768 : (size_t)kq * 2; S2.ksliceB = (size_t)(kq / 64) * 32768;
                    S2.A = (const char*)ACT2; S2.B = (const char*)(ws + WS_EWD); S2.a_pm = (size_t)256 * 7168; S2.b_pn = (size_t)256 * 7168; S2.b_e = (size_t)2048 * 7168; S2.blk_expert = blk_expert;
                    pg8::EpiPart E2{(float*)(ws + WS_PART)};
                    GEMMCALL(pg8::gemm_phase<pg8::EpiPart, pg8::TailOrder, false, GEMM_SP2, 1>(lds, g2, S2, E2);)
                }
            }
        }
        SEAM(pb + PK_DOWN);
        if (IN(pb + PK_TAIL)) {
            if (l == 0) NORMCALL(norm_phase<0>(lds, XS, mix_norm + DM, H, w_in + (size_t)DM * ZW + 3072, ZW, GLR, nullptr, nullptr, nullptr, tid, lane, wave, G);)
            else FINCALL(final_phase(lds, XS, Y, (const float*)(ws + WS_PART), nrb_p, tok_slot, topw, final_norm, args.out, tid, lane, wave, G);)
        }
        if (l == 0) SEAM(pb + PK_TAIL);
    }
    { constexpr int l = 1;
        const int pb = 1 + PH_PER_LAYER * l;
        if (IN(pb + PK_INPROJ)) {
            pg8::Gemm g{TILE_H ? 64 : 2048, 64, 2048, 0, 0, TILE_H ? 32768 : 128, 32768}; pg8::Order<false> S; S.init(T / 256, 16, G, (int)blockIdx.x);
            S.A = (const char*)H; S.B = (const char*)(ws + WS_WIN) + (size_t)l * 4096 * 2048 * 2; S.a_pm = (size_t)256 * 2048 * 2; S.a_pn = 0; S.b_pn = (size_t)256 * 2048 * 2; S.b_e = 0; S.blk_expert = nullptr;
            pg8::EpiBf16 E{Z, 4096, nullptr};
            GEMMCALL(pg8::gemm_phase<pg8::EpiBf16, pg8::Order<false>, GEMM_ALIGN, GEMM_SP2>(lds, g, S, E);)
        }
        SEAM(pb + PK_INPROJ);
        if (IN(pb + PK_PRE)) {
            PRECALL(pool_d_phase(Z, DP, tid, G);)
            PRECALL(gla_state_phase(lds, Z, GLR, w_gate_up + (size_t)l * 16 * 512, b_gate + l * 512, CS, DEC, tid, lane, wave, G);)
        }
        SEAM(pb + PK_PRE);
        if (IN(pb + PK_POOLSCAN)) {
            SCANCALL(gla_scan_phase(CS, DEC, SP, tid, G);)
            __syncthreads();
            pg8::Gemm g{1024, 64, 256, 0, 0, 128, 32768}; pg8::Order<false> S; S.init(T / 256, 4, G, (int)blockIdx.x);
            S.A = (const char*)DP; S.B = (const char*)(ws + WS_WPOOL) + (size_t)l * 4 * 65536 * 2; S.a_pm = (size_t)256 * 1024 * 2; S.a_pn = 256 * 2; S.b_pn = (size_t)65536 * 2; S.b_e = 0; S.blk_expert = nullptr;
            pg8::EpiBf16 E{MIX, 2048, pool_scale + l * 1024};
            GEMMCALL(pg8::gemm_phase<pg8::EpiBf16, pg8::Order<false>, GEMM_ALIGN, GEMM_SP2>(lds, g, S, E);)
        }
        SEAM(pb + PK_POOLSCAN);
        if (IN(pb + PK_GLAOUT)) OUTCALL(gla_out_phase(lds, Z, SP, gla_norm + l * 1024, MIX, tid, lane, wave, G);)
        SEAM(pb + PK_GLAOUT);
        if (IN(pb + PK_OUTPROJ)) {
            pg8::Gemm g{2048, 64, 2048, 0, 0, 128, 32768}; pg8::Order<false> S; S.init(T / 256, 8, G, (int)blockIdx.x);
            S.A = (const char*)MIX; S.B = (const char*)(ws + WS_WOUT) + (size_t)l * 2048 * 2048 * 2; S.a_pm = (size_t)256 * 2048 * 2; S.a_pn = 0; S.b_pn = (size_t)256 * 2048 * 2; S.b_e = 0; S.blk_expert = nullptr;
            pg8::EpiRes<l == 0> E{l == 0 ? (const void*)x : (const void*)XS, XS, 2048};
            GEMMCALL(pg8::gemm_phase<pg8::EpiRes<l == 0>, pg8::Order<false>, true, true>(lds, g, S, E);)
        }
        SEAM(pb + PK_OUTPROJ);
        if (IN(pb + PK_NORM2)) {
            if (l == 0) NORMCALL(norm_phase<1, DENSE_FP8 == 1>(lds, XS, ffn_norm, H, nullptr, 0, nullptr, nullptr, nullptr, nullptr, tid, lane, wave, G);)
            else NORMCALL(norm_phase<2>(lds, XS, ffn_norm + DM, H, w_router, 8, nullptr, topi, topw, hist, tid, lane, wave, G);)
        }
        SEAM(pb + PK_NORM2);
        if (l == 1) { if (IN(pb + PK_ASSIGN)) ASGCALL(assign_phase(lds, topi, hist, tok_slot, blk_expert, nrb_p, H, HS, tid, lane, wave, G);)
            SEAM(pb + PK_ASSIGN); }
        if (IN(pb + PK_UP)) {
            if (l == 0) {
#if DENSE_FP8 == 1
                pg8::Gemm g{1024, 64, 1024, 0, 0x7f7f7f77, 128, 32768}; pg8::Order<false> S; S.init(T / 256, 44, G, (int)blockIdx.x);
                S.A = (const char*)H; S.B = (const char*)(ws + WS_WGU); S.a_pm = (size_t)256 * 2048; S.a_pn = 0; S.b_pn = (size_t)256 * 2048; S.b_e = 0; S.blk_expert = nullptr;
                pg8::EpiSwigluF8 E{(unsigned char*)ACT, 44, 4.f};
                GEMMCALL(pg8::gemm_phase<pg8::EpiSwigluF8, pg8::Order<false>, GEMM_ALIGN, GEMM_SP2, 1>(lds, g, S, E);)
#else
                pg8::Gemm g{TILE_H ? 64 : 2048, 64, 2048, 0, 0, TILE_H ? 32768 : 128, 32768}; pg8::Order<false> S; S.init(T / 256, 44, G, (int)blockIdx.x);
                S.A = (const char*)H; S.B = (const char*)(ws + WS_WGU); S.a_pm = (size_t)256 * 2048 * 2; S.a_pn = 0; S.b_pn = (size_t)256 * 2048 * 2; S.b_e = 0; S.blk_expert = nullptr;
#if DENSE_FP8 == 2
                pg8::EpiSwigluF8S E{(unsigned char*)ACT, 44, 4.f};
                GEMMCALL(pg8::gemm_phase<pg8::EpiSwigluF8S, pg8::Order<false>, true, GEMM_SP2>(lds, g, S, E);)
#else
                pg8::EpiSwiglu E{ACT, TILE_ACT ? 88 : -11264};
                GEMMCALL(pg8::gemm_phase<pg8::EpiSwiglu, pg8::Order<false>, GEMM_ALIGN, GEMM_SP2>(lds, g, S, E);)
#endif
#endif
            } else {
                const int nrb = __builtin_amdgcn_readfirstlane(__hip_atomic_load(nrb_p, RLX_AGENT));
                pg8::Gemm g{TILE_HS ? 64 : 1024, TILE_EWGU ? 64 : 1024, 1024, 0, MOE_UP_FMT == 2 ? 0x7f7f7f78 : 0x7f7f7f77, TILE_HS ? 32768 : 128, TILE_EWGU ? 32768 : 128}; pg8::Order<true> S; S.init(nrb, 56, G, (int)blockIdx.x);
                S.A = (const char*)HS; S.B = (const char*)(ws + WS_EWGU); S.a_pm = (size_t)256 * 2048; S.a_pn = 0; S.b_pn = (size_t)256 * 2048; S.b_e = (size_t)14336 * 2048; S.blk_expert = blk_expert;
                pg8::EpiSwigluF8S E{(unsigned char*)ACT2, 56, 4.f};
#ifdef KPROBE
                if (args.pad) { GEMMCALL(pg8::gemm_phase<pg8::EpiSwigluF8S, pg8::Order<true>, true, GEMM_SP2, MOE_UP_FMT, KPROBE>(lds, g, S, E);) } else
#endif
                GEMMCALL(pg8::gemm_phase<pg8::EpiSwigluF8S, pg8::Order<true>, true, GEMM_SP2, MOE_UP_FMT>(lds, g, S, E);)
            }
        }
        SEAM(pb + PK_UP);
        if (IN(pb + PK_DOWN)) {
            if (l == 0) {
#if DENSE_FP8
                pg8::Gemm g{64, 64, 2816, 0, 0x7f7f7f76, 32768, 32768}; pg8::Order<false> S; S.init(T / 256, 8, G, (int)blockIdx.x);
                S.A = (const char*)ACT; S.B = (const char*)(ws + WS_WD); S.a_pm = (size_t)256 * 5632; S.a_pn = 0; S.b_pn = (size_t)256 * 5632; S.b_e = 0; S.blk_expert = nullptr;
                pg8::EpiRes<false> E{XS, XS, 2048};
                GEMMCALL(pg8::gemm_phase<pg8::EpiRes<false>, pg8::Order<false>, true, true, 1>(lds, g, S, E);)
#else
                pg8::Gemm g{TILE_ACT ? 64 : 5632, 64, 5632, 0, 0, TILE_ACT ? 32768 : 128, 32768}; pg8::Order<false> S; S.init(T / 256, 8, G, (int)blockIdx.x);
                S.A = (const char*)ACT; S.B = (const char*)(ws + WS_WD); S.a_pm = (size_t)256 * 5632 * 2; S.a_pn = 0; S.b_pn = (size_t)256 * 5632 * 2; S.b_e = 0; S.blk_expert = nullptr;
                pg8::EpiRes<false> E{XS, XS, 2048};
                GEMMCALL(pg8::gemm_phase<pg8::EpiRes<false>, pg8::Order<false>, true, true>(lds, g, S, E);)
#endif
            } else {
                const int nrb = __builtin_amdgcn_readfirstlane(__hip_atomic_load(nrb_p, RLX_AGENT));
                pg8::Gemm g{TILE_ACT2 ? 64 : 3584, 64, 3584, 0, 0x7f7f7f76, TILE_ACT2 ? 32768 : 128, 32768}; pg8::Order<true> S; S.init(nrb, 8, G, (int)blockIdx.x);
                S.A = (const char*)ACT2; S.B = (const char*)(ws + WS_EWD); S.a_pm = (size_t)256 * 7168; S.a_pn = 0; S.b_pn = (size_t)256 * 7168; S.b_e = (size_t)2048 * 7168; S.blk_expert = blk_expert;
                int full, tail, sk; moe_tail_split(nrb, G, full, tail, sk); S.Lend = full;
                pg8::EpiBf16 E{Y, 2048, nullptr};
                GEMMCALL(pg8::gemm_phase<pg8::EpiBf16, pg8::Order<true>, GEMM_ALIGN, GEMM_SP2, 1>(lds, g, S, E);)
                if (sk > 0) {
                    const int kq = 3584 / sk;
                    pg8::Gemm g2{TILE_ACT2 ? 64 : 3584, 64, kq, 0, 0x7f7f7f76, TILE_ACT2 ? 32768 : 128, 32768}; pg8::TailOrder S2; S2.nM = nrb; S2.nN = 8; S2.c = (int)blockIdx.x; S2.full = full; S2.tail = tail; S2.s = sk; S2.ksliceA = TILE_ACT2 ? (size_t)(kq / 64) * 32768 : (size_t)kq * 2; S2.ksliceB = (size_t)(kq / 64) * 32768;
                    S2.A = (const char*)ACT2; S2.B = (const char*)(ws + WS_EWD); S2.a_pm = (size_t)256 * 7168; S2.b_pn = (size_t)256 * 7168; S2.b_e = (size_t)2048 * 7168; S2.blk_expert = blk_expert;
                    pg8::EpiPart E2{(float*)(ws + WS_PART)};
                    GEMMCALL(pg8::gemm_phase<pg8::EpiPart, pg8::TailOrder, false, GEMM_SP2, 1>(lds, g2, S2, E2);)
                }
            }
        }
        SEAM(pb + PK_DOWN);
        if (IN(pb + PK_TAIL)) {
            if (l == 0) NORMCALL(norm_phase<0>(lds, XS, mix_norm + DM, H, w_in + (size_t)DM * ZW + 3072, ZW, GLR, nullptr, nullptr, nullptr, tid, lane, wave, G);)
            else FINCALL(final_phase(lds, XS, Y, (const float*)(ws + WS_PART), nrb_p, tok_slot, topw, final_norm, args.out, tid, lane, wave, G);)
        }
        if (l == 0) SEAM(pb + PK_TAIL);
    }
#undef IN
#undef SEAM
}
}
#ifndef MK_MODE
#define MK_MODE 0
#endif
#ifndef DBG_CUT
#define DBG_CUT 0
#endif
namespace dbg {
using fz::bf16_t;
__global__ __launch_bounds__(256) void k_cvt_z(const bf16_t* Z, const float* GLR, float* z) {
    const size_t i = (size_t)blockIdx.x * 256 + threadIdx.x; if (i >= (size_t)T * ZW) return;
    const int t = (int)(i / ZW), c = (int)(i % ZW);
    float v;
    if (c < 3072) v = fz::bf2f(Z[(size_t)t * 4096 + c]); else if (c < 3088) v = GLR[(size_t)t * 16 + (c - 3072)]; else v = fz::bf2f(Z[(size_t)t * 4096 + c - 16]);
    z[i] = v;
}
__global__ __launch_bounds__(256) void k_cvt_bf(const bf16_t* in, float* out, size_t n) {
    const size_t i = (size_t)blockIdx.x * 256 + threadIdx.x; if (i < n) out[i] = fz::bf2f(in[i]);
}
}

static void launch_fused(const fz::Args& base, int lo, int hi, int grid, hipStream_t stream) {
    fz::Args a = base; a.ph_lo = lo; a.ph_hi = hi;
    hipLaunchKernelGGL(fz::fwd, dim3(grid), dim3(fz::NTHR), fz::LDS_BYTES, stream, a);
}

extern "C" void kernel_launch(void* const* d_in, const int* in_sizes, int n_in, void* d_out, int out_size, void* d_ws, size_t ws_size, hipStream_t stream) {
    static int grid = 0;
    if (grid == 0) {
        int dev = 0, cus = 0;
        if (hipGetDevice(&dev) != hipSuccess || hipDeviceGetAttribute(&cus, hipDeviceAttributeMultiprocessorCount, dev) != hipSuccess) { grid = -1; return; }
        if (hipFuncSetAttribute((const void*)fz::fwd, hipFuncAttributeMaxDynamicSharedMemorySize, fz::LDS_BYTES) != hipSuccess) { fprintf(stderr, "hipFuncSetAttribute failed\n"); grid = -1; return; }
        int per_cu = 0;
        if (hipOccupancyMaxActiveBlocksPerMultiprocessor(&per_cu, (const void*)fz::fwd, fz::NTHR, fz::LDS_BYTES) != hipSuccess || per_cu < 1) fprintf(stderr, "occupancy query: %d\n", per_cu);
        (void)hipGetLastError();
        grid = cus;
        if (ws_size < fz::WS_END) { fprintf(stderr, "workspace too small\n"); grid = -1; return; }
    }
    if (grid < 0) return;
    unsigned char* ws = (unsigned char*)d_ws;
    (void)hipMemsetAsync(ws + fz::WS_CTL + (size_t)fz::CW_BAR * 4, 0, 16384, stream);
    fz::Args a{};
    for (int i = 0; i < 18; ++i) a.in[i] = (const float*)d_in[i];
    a.out = (float*)d_out; a.ws = ws; a.cvt_items = fz::CI_TOTAL;
#if MK_MODE == 0
    launch_fused(a, 0, fz::NPH, grid, stream);
#elif MK_MODE == 1
    for (int p = 0; p < fz::NPH; ++p) { if (p == 1 + fz::PK_ASSIGN) continue;
#ifdef KPROBE
        if (p == KPROBE_PHASE) { fz::Args b = a; b.pad = 1; for (int rr = 0; rr < KPROBE_N; ++rr) launch_fused(b, p, p + 1, grid, stream); }
#endif
        launch_fused(a, p, p + 1, grid, stream);
#ifdef REP_HI
#ifndef REP_N
#define REP_N 1
#endif
        if (p == REP_HI) for (int rr = 0; rr < REP_N; ++rr) for (int q = REP_LO; q <= REP_HI; ++q) { if (q == 1 + fz::PK_ASSIGN) continue; launch_fused(a, q, q + 1, grid, stream); }
#endif
    }
#elif MK_MODE == 2
    {
        const int l = DBG_CUT / 10, kind = DBG_CUT % 10; const int pb = 1 + fz::PH_PER_LAYER * l;
        const int pcut = kind == 1 ? pb + 1 : kind == 2 ? pb + 4 : kind == 3 ? pb + 5 : kind == 4 ? pb + 6 : pb + 9;
        const int scut = kind == 1 ? 7 * l + 2 : kind == 2 ? 7 * l + 4 : kind == 3 ? 7 * l + 5 : kind == 4 ? 7 * l + 6 : 7 * l + 7;
        a.cvt_items = fz::CI_NONEXP;
        for (int p = 0; p < pcut; ++p) { if (p == 1 + fz::PK_ASSIGN) continue; launch_fused(a, p, p + 1, grid, stream); }
        ora::Bufs B = ora::make_bufs(ws + fz::WS_EWGU, (float*)(ws + fz::WS_XS));
        if (kind == 1) hipLaunchKernelGGL(dbg::k_cvt_z, dim3((unsigned)(((size_t)T * ZW + 255) / 256)), dim3(256), 0, stream, (const fz::bf16_t*)(ws + fz::WS_Z), (const float*)(ws + fz::WS_GLR), B.z);
        if (kind == 2) hipLaunchKernelGGL(dbg::k_cvt_bf, dim3((unsigned)(((size_t)T * 2048 + 255) / 256)), dim3(256), 0, stream, (const fz::bf16_t*)(ws + fz::WS_MIX), B.mixf, (size_t)T * 2048);
        if (kind == 4) hipLaunchKernelGGL(dbg::k_cvt_bf, dim3((unsigned)(((size_t)T * 2048 + 255) / 256)), dim3(256), 0, stream, (const fz::bf16_t*)(ws + fz::WS_H), B.hf, (size_t)T * 2048);
        ora::run_range(d_in, (float*)d_out, B, scut, 15, stream);
    }
#elif MK_MODE == 3
    {
        const int scut = DBG_CUT; const int pcut = scut == 5 ? 1 + fz::PK_NORM2 : scut == 7 ? 1 + fz::PK_TAIL : 1 + fz::PH_PER_LAYER + fz::PK_NORM2;
        ora::Bufs B = ora::make_bufs(ws + fz::WS_EWGU, (float*)(ws + fz::WS_XS));
        ora::run_range(d_in, (float*)d_out, B, 0, scut, stream);
        launch_fused(a, 0, 1, grid, stream);
        for (int p = pcut; p < fz::NPH; ++p) { if (p == 1 + fz::PK_ASSIGN) continue; launch_fused(a, p, p + 1, grid, stream); }
    }
#endif
}
```

```cpp
#include <hip/hip_runtime.h>
#include <cstdio>
#include <cstdint>
constexpr int T = 16384, DM = 2048, ZW = 4112;
constexpr float EPSF = 1e-6f;
constexpr int LSLOT = 34816, NRB_MAX = 136;
#ifndef DENSE_FP8
#define DENSE_FP8 2
#endif
#ifndef GEMM_SP2
#define GEMM_SP2 true
#endif
#ifndef GEMM_KM
#define GEMM_KM 0x240000
#endif
#ifndef GEMM_FP6_NOPRIO
#define GEMM_FP6_NOPRIO 0
#endif
#ifndef GEMM_SADDR
#define GEMM_SADDR 4
#endif
#ifndef GEMM_RDFIRST
#define GEMM_RDFIRST 0
#endif
#ifndef GEMM_B1LATE
#define GEMM_B1LATE 0
#endif
#ifndef GEMM_LGKDEFER
#define GEMM_LGKDEFER 1
#endif
#ifndef GEMM_BPF
#define GEMM_BPF 0
#endif
#ifndef GEMM_ALIGN
#define GEMM_ALIGN false
#endif
#ifndef TILE_EWGU
#define TILE_EWGU 1
#endif
#ifndef TILE_ACT2
#define TILE_ACT2 1
#endif
#ifndef TILE_H
#define TILE_H 0
#endif
#ifndef TILE_ACT
#define TILE_ACT 1
#endif
#ifndef TILE_HS
#define TILE_HS 1
#endif
#ifndef MOE_UP_FMT
#define MOE_UP_FMT 2
#endif
#define MK_MODE 0
#define DBG_CUT 0
namespace pg8 {
#define PG8_LAS __attribute__((address_space(3)))
typedef unsigned short bf16_t;
typedef short bf16x8 __attribute__((ext_vector_type(8)));
typedef float f32x4 __attribute__((ext_vector_type(4)));
typedef unsigned u32x4 __attribute__((ext_vector_type(4)));
constexpr int BM = 256, BK = 64, HALF = 128, HTB = HALF * BK * 2, STAGE_BYTES = 8 * HTB, NXCD = 8, WGM = 8;

__host__ __device__ __forceinline__ int lds_byte(int r, int c) { const int st = (r >> 4) * 2 + (c >> 5), rr = r & 15, cc = c & 31, ob = rr * 64 + cc * 2; return st * 1024 + (ob ^ (((ob >> 9) & 1) << 5)); }
__host__ __device__ __forceinline__ void stage_rc(int b, int& R, int& C) { const int st = b / 1024, sb = b % 1024, swz = sb ^ (((sb >> 9) & 1) << 5); R = (st >> 1) * 16 + swz / 64; C = (st & 1) * 32 + (swz % 64) / 2; }
__host__ __device__ __forceinline__ int perm32(int rho) { const int n = rho >> 4, i = rho & 15; return 8 * (i >> 2) + 4 * n + (i & 3); }

struct Unit { int pm, pn; const char* a; const char* b; };
struct Gemm { int lda, ldb, K; int sA, sB; int kstepA, kstepB; };
typedef int i32x8 __attribute__((ext_vector_type(8)));
typedef int i32x4 __attribute__((ext_vector_type(4)));
typedef int i32x6 __attribute__((ext_vector_type(6)));
typedef int i32x2 __attribute__((ext_vector_type(2)));

__device__ __forceinline__ void unit_map(long L, int nM, int nN, int& pm, int& pn) {
    const int nwg = nM * nN; int wgid = (int)L; { const int q = nwg / NXCD, r = nwg % NXCD, xcd = wgid % NXCD, off = wgid / NXCD; wgid = (xcd < r ? xcd * (q + 1) : r * (q + 1) + (xcd - r) * q) + off; }
    const int nig = WGM * nN, gid = wgid / nig, fm = gid * WGM, gsz = (nM - fm) < WGM ? (nM - fm) : WGM;
    pm = fm + ((wgid % nig) % gsz); pn = (wgid % nig) / gsz;
}
template <bool MOE> struct Order {
    int nM, nN, nwg, G, c; long Lend;
    const char* A; const char* B; size_t a_pm, a_pn, b_pn, b_e; const int* blk_expert;
    __device__ void init(int nM_, int nN_, int G_, int c_) { nM = nM_; nN = nN_; nwg = nM * nN; G = G_; c = c_; Lend = nwg; }
    __device__ __forceinline__ bool next(int i, Unit& u) const {
        const long L = (long)i * G + c; if (L >= Lend) return false;
        unit_map(L, nM, nN, u.pm, u.pn);
        u.a = A + (size_t)u.pm * a_pm + (size_t)u.pn * a_pn;
        u.b = B + (size_t)u.pn * b_pn;
        if (MOE) { const int e = __builtin_amdgcn_readfirstlane(__hip_atomic_load(blk_expert + u.pm, __ATOMIC_RELAXED, __HIP_MEMORY_SCOPE_AGENT)); u.b += (size_t)e * b_e; }
        return true;
    }
    __device__ __forceinline__ void a_ready(const Unit&) const {}
    __device__ __forceinline__ void done(const Unit&) const {}
};
struct TailOrder {
    int nM, nN, c, full, tail, s; size_t ksliceA, ksliceB;
    const char* A; const char* B; size_t a_pm, b_pn, b_e; const int* blk_expert;
    __device__ __forceinline__ bool next(int i, Unit& u) const {
        if (i > 0 || c >= tail * s) return false;
        const int t = c / s, sl = c % s; int pm, pn; unit_map((long)full + t, nM, nN, pm, pn);
        const int e = __builtin_amdgcn_readfirstlane(__hip_atomic_load(blk_expert + pm, __ATOMIC_RELAXED, __HIP_MEMORY_SCOPE_AGENT));
        u.pm = c; u.pn = 0; u.a = A + (size_t)pm * a_pm + (size_t)sl * ksliceA; u.b = B + (size_t)pn * b_pn + (size_t)e * b_e + (size_t)sl * ksliceB;
        return true;
    }
    __device__ __forceinline__ void a_ready(const Unit&) const {}
    __device__ __forceinline__ void done(const Unit&) const {}
};

__device__ __forceinline__ unsigned cvt_pk_bf16(float lo, float hi) { unsigned r; asm volatile("v_cvt_pk_bf16_f32 %0, %1, %2" : "=v"(r) : "v"(lo), "v"(hi)); return r; }
__device__ __forceinline__ float silu_f(float x) { return x * __builtin_amdgcn_rcpf(1.0f + __builtin_amdgcn_exp2f(-1.4426950408889634f * x)); }

struct EpiBf16 {
    static constexpr bool PERM = true, AFTER_DRAIN = false;
    bf16_t* O; int ldc; const float* scale;
    __device__ __forceinline__ void operator()(const f32x4 (&acc)[2][2][4][2], const Unit& u, int wr, int wc, int fr, int fq) const {
        const int row0 = u.pm * BM + wr * 64 + fr, col0 = u.pn * BM + wc * 32 + 8 * fq;
        f32x4 sv[2][2];
#pragma unroll
        for (int bj = 0; bj < 2; ++bj)
#pragma unroll
            for (int n = 0; n < 2; ++n) sv[bj][n] = scale ? *(const f32x4*)(scale + col0 + bj * HALF + 4 * n) : (f32x4){1.f, 1.f, 1.f, 1.f};
#pragma unroll
        for (int ai = 0; ai < 2; ++ai)
#pragma unroll
            for (int m = 0; m < 4; ++m) { bf16_t* rowp = O + (size_t)(row0 + ai * HALF + m * 16) * ldc + col0;
#pragma unroll
                for (int bj = 0; bj < 2; ++bj) { const f32x4 v0 = acc[ai][bj][m][0] * sv[bj][0], v1 = acc[ai][bj][m][1] * sv[bj][1];
                    u32x4 w; w.x = cvt_pk_bf16(v0[0], v0[1]); w.y = cvt_pk_bf16(v0[2], v0[3]); w.z = cvt_pk_bf16(v1[0], v1[1]); w.w = cvt_pk_bf16(v1[2], v1[3]);
                    *(u32x4*)(rowp + bj * HALF) = w; } }
    }
};
template <bool F32IN> struct EpiRes {
    static constexpr bool PERM = true, AFTER_DRAIN = false;
    const void* base; bf16_t* out; int ldc;
    __device__ __forceinline__ void operator()(const f32x4 (&acc)[2][2][4][2], const Unit& u, int wr, int wc, int fr, int fq) const {
        const int row0 = u.pm * BM + wr * 64 + fr, col0 = u.pn * BM + wc * 32 + 8 * fq;
        if constexpr (!F32IN) {
            u32x4 q[2][4][2];
#pragma unroll
            for (int ai = 0; ai < 2; ++ai)
#pragma unroll
                for (int m = 0; m < 4; ++m)
#pragma unroll
                    for (int bj = 0; bj < 2; ++bj) q[ai][m][bj] = *(const u32x4*)((const bf16_t*)base + (size_t)(row0 + ai * HALF + m * 16) * ldc + col0 + bj * HALF);
#pragma unroll
            for (int ai = 0; ai < 2; ++ai)
#pragma unroll
                for (int m = 0; m < 4; ++m)
#pragma unroll
                    for (int bj = 0; bj < 2; ++bj) { const u32x4 t = q[ai][m][bj];
                        const f32x4 v0 = (f32x4){__uint_as_float(t.x << 16), __uint_as_float(t.x & 0xffff0000u), __uint_as_float(t.y << 16), __uint_as_float(t.y & 0xffff0000u)} + acc[ai][bj][m][0];
                        const f32x4 v1 = (f32x4){__uint_as_float(t.z << 16), __uint_as_float(t.z & 0xffff0000u), __uint_as_float(t.w << 16), __uint_as_float(t.w & 0xffff0000u)} + acc[ai][bj][m][1];
                        u32x4 w; w.x = cvt_pk_bf16(v0[0], v0[1]); w.y = cvt_pk_bf16(v0[2], v0[3]); w.z = cvt_pk_bf16(v1[0], v1[1]); w.w = cvt_pk_bf16(v1[2], v1[3]);
                        *(u32x4*)(out + (size_t)(row0 + ai * HALF + m * 16) * ldc + col0 + bj * HALF) = w; }
        } else {
#pragma unroll
            for (int ai = 0; ai < 2; ++ai) {
                f32x4 b0[4][2], b1[4][2];
#pragma unroll
                for (int m = 0; m < 4; ++m)
#pragma unroll
                    for (int bj = 0; bj < 2; ++bj) { const float* bp = (const float*)base + (size_t)(row0 + ai * HALF + m * 16) * ldc + col0 + bj * HALF; b0[m][bj] = *(const f32x4*)bp; b1[m][bj] = *(const f32x4*)(bp + 4); }
#pragma unroll
                for (int m = 0; m < 4; ++m)
#pragma unroll
                    for (int bj = 0; bj < 2; ++bj) { const f32x4 v0 = b0[m][bj] + acc[ai][bj][m][0], v1 = b1[m][bj] + acc[ai][bj][m][1];
                        u32x4 w; w.x = cvt_pk_bf16(v0[0], v0[1]); w.y = cvt_pk_bf16(v0[2], v0[3]); w.z = cvt_pk_bf16(v1[0], v1[1]); w.w = cvt_pk_bf16(v1[2], v1[3]);
                        *(u32x4*)(out + (size_t)(row0 + ai * HALF + m * 16) * ldc + col0 + bj * HALF) = w; }
                asm volatile("" ::: "memory"); }
        }
    }
};
struct EpiPart {
    static constexpr bool PERM = false, AFTER_DRAIN = false;
    float* P;
    __device__ __forceinline__ void operator()(const f32x4 (&acc)[2][2][4][2], const Unit& u, int wr, int wc, int fr, int fq) const {
        float* base = P + (size_t)u.pm * 65536 + (size_t)(wr * 64 + fr) * 256 + wc * 32 + 4 * fq;
#pragma unroll
        for (int ai = 0; ai < 2; ++ai)
#pragma unroll
            for (int m = 0; m < 4; ++m)
#pragma unroll
                for (int bj = 0; bj < 2; ++bj)
#pragma unroll
                    for (int n = 0; n < 2; ++n) *(f32x4*)(base + (size_t)(ai * HALF + m * 16) * 256 + bj * HALF + n * 16) = acc[ai][bj][m][n];
    }
};
struct EpiSwiglu {
    static constexpr bool PERM = true, AFTER_DRAIN = false;
    bf16_t* O; int kt_per_panel;
    __device__ __forceinline__ void operator()(const f32x4 (&acc)[2][2][4][2], const Unit& u, int wr, int wc, int fr, int fq) const {
        const size_t rp = kt_per_panel > 0 ? (size_t)128 : (size_t)(-kt_per_panel);
        unsigned char* blk = kt_per_panel > 0 ? (unsigned char*)O + ((size_t)u.pm * kt_per_panel + u.pn * 2 + (wc >> 1)) * 32768 + (size_t)(wr * 64 + fr) * 128 + ((wc & 1) * 32 + 8 * fq) * 2
                                              : (unsigned char*)O + (size_t)(u.pm * BM + wr * 64 + fr) * rp + (u.pn * HALF + wc * 32 + 8 * fq) * 2;
#pragma unroll
        for (int ai = 0; ai < 2; ++ai)
#pragma unroll
            for (int m = 0; m < 4; ++m) { unsigned char* rowp = blk + (size_t)(ai * HALF + m * 16) * rp;
                const f32x4 g0 = acc[ai][0][m][0], g1 = acc[ai][0][m][1], u0 = acc[ai][1][m][0], u1 = acc[ai][1][m][1];
                u32x4 w; w.x = cvt_pk_bf16(silu_f(g0[0]) * u0[0], silu_f(g0[1]) * u0[1]); w.y = cvt_pk_bf16(silu_f(g0[2]) * u0[2], silu_f(g0[3]) * u0[3]);
                w.z = cvt_pk_bf16(silu_f(g1[0]) * u1[0], silu_f(g1[1]) * u1[1]); w.w = cvt_pk_bf16(silu_f(g1[2]) * u1[2], silu_f(g1[3]) * u1[3]);
                *(u32x4*)rowp = w; }
    }
};
struct EpiSwigluF8 {
    static constexpr bool PERM = true, AFTER_DRAIN = false;
    unsigned char* O; int kt_per_panel; float osc;
    __device__ __forceinline__ static float cl(float v) { return __builtin_fminf(__builtin_fmaxf(v, -448.f), 448.f); }
    __device__ __forceinline__ void operator()(const f32x4 (&acc)[2][2][4][2], const Unit& u, int wr, int wc, int fr, int fq) const {
        const size_t rp = kt_per_panel > 0 ? (size_t)128 : (size_t)(-kt_per_panel);
        unsigned char* blk = kt_per_panel > 0 ? O + ((size_t)u.pm * kt_per_panel + u.pn) * 32768 + (size_t)(wr * 64 + fr) * 128 + wc * 32 + 8 * fq
                                              : O + (size_t)(u.pm * BM + wr * 64 + fr) * rp + u.pn * HALF + wc * 32 + 8 * fq;
#pragma unroll
        for (int ai = 0; ai < 2; ++ai)
#pragma unroll
            for (int m = 0; m < 4; ++m) { unsigned char* rowp = blk + (size_t)(ai * HALF + m * 16) * rp;
                const f32x4 g0 = acc[ai][0][m][0], g1 = acc[ai][0][m][1], u0 = acc[ai][1][m][0], u1 = acc[ai][1][m][1];
                float v[8];
#pragma unroll
                for (int i = 0; i < 4; ++i) { v[i] = cl(silu_f(g0[i]) * u0[i] * osc); v[4 + i] = cl(silu_f(g1[i]) * u1[i] * osc); }
                int w0 = 0, w1 = 0;
                w0 = __builtin_amdgcn_cvt_pk_fp8_f32(v[0], v[1], w0, false); w0 = __builtin_amdgcn_cvt_pk_fp8_f32(v[2], v[3], w0, true);
                w1 = __builtin_amdgcn_cvt_pk_fp8_f32(v[4], v[5], w1, false); w1 = __builtin_amdgcn_cvt_pk_fp8_f32(v[6], v[7], w1, true);
                typedef int i32x2v __attribute__((ext_vector_type(2)));
                *(i32x2v*)rowp = (i32x2v){w0, w1}; }
    }
};

struct EpiSwigluF8S {
    static constexpr bool PERM = true, AFTER_DRAIN = false, STAGED = true;
    unsigned char* O; int kt_per_panel; float osc;
    __device__ __forceinline__ static float cl(float v) { return __builtin_fminf(__builtin_fmaxf(v, -448.f), 448.f); }
    __device__ __forceinline__ void staged(const f32x4 (&acc)[2][2][4][2], const Unit& u, int wr, int wc, int fr, int fq, PG8_LAS unsigned char* stg, int wid, int lane) const {
        constexpr int SP = 144;
        unsigned char* blk = O + ((size_t)u.pm * kt_per_panel + u.pn) * 32768;
        typedef int i32x2v __attribute__((ext_vector_type(2)));
#pragma unroll
        for (int ai = 0; ai < 2; ++ai) {
#pragma unroll
            for (int m = 0; m < 4; ++m) {
                const f32x4 g0 = acc[ai][0][m][0], g1 = acc[ai][0][m][1], u0 = acc[ai][1][m][0], u1 = acc[ai][1][m][1];
                float v[8];
#pragma unroll
                for (int i = 0; i < 4; ++i) { v[i] = cl(silu_f(g0[i]) * u0[i] * osc); v[4 + i] = cl(silu_f(g1[i]) * u1[i] * osc); }
                int w0 = 0, w1 = 0;
                w0 = __builtin_amdgcn_cvt_pk_fp8_f32(v[0], v[1], w0, false); w0 = __builtin_amdgcn_cvt_pk_fp8_f32(v[2], v[3], w0, true);
                w1 = __builtin_amdgcn_cvt_pk_fp8_f32(v[4], v[5], w1, false); w1 = __builtin_amdgcn_cvt_pk_fp8_f32(v[6], v[7], w1, true);
                *(PG8_LAS i32x2v*)(stg + (wr * 64 + m * 16 + fr) * SP + wc * 32 + 8 * fq) = (i32x2v){w0, w1}; }
            asm volatile("s_waitcnt lgkmcnt(0)" ::: "memory"); __builtin_amdgcn_s_barrier(); asm volatile("" ::: "memory");
            u32x4 t[2];
#pragma unroll
            for (int i = 0; i < 2; ++i) t[i] = *(const PG8_LAS u32x4*)(stg + (wid * 16 + (lane >> 3) + 8 * i) * SP + 16 * (lane & 7));
#pragma unroll
            for (int i = 0; i < 2; ++i) *(u32x4*)(blk + (size_t)(ai * HALF + wid * 16 + (lane >> 3) + 8 * i) * 128 + 16 * (lane & 7)) = t[i];
            asm volatile("s_waitcnt lgkmcnt(0)" ::: "memory"); __builtin_amdgcn_s_barrier(); asm volatile("" ::: "memory");
        }
    }
};
template <class E, class = void> struct epi_staged { static constexpr bool value = false; };
template <class E> struct epi_staged<E, decltype((void)E::STAGED)> { static constexpr bool value = E::STAGED; };

template <int N> __device__ __forceinline__ void waitv() { asm volatile("s_waitcnt vmcnt(%0)" :: "n"(N) : "memory"); }
template <class Epi, class Sched, bool ALIGN_EPI = false, bool SP2 = false, int FMT = 0, int KP = 0>
__device__ __forceinline__ void gemm_phase(PG8_LAS unsigned char* lds, const Gemm g, const Sched& S, const Epi& E) {
    const int tid = threadIdx.x, wid = __builtin_amdgcn_readfirstlane(tid >> 6), lane = tid & 63, wr = wid >> 2, wc = wid & 3, fr = lane & 15, fq = lane >> 4;
    const int K = g.K, nt = K / BK;
    constexpr bool FP8 = FMT != 0;
    constexpr bool BPF = SP2 && FMT == 2 && GEMM_BPF && KP == 0;
#define KP_RD if constexpr (!(KP & 1))
#define KP_ST if constexpr (!(KP & 2))
#define KP_MM if constexpr (!(KP & 4))
    constexpr int KM1 = ((GEMM_KM) >> (8 * FMT + 4)) & 15, KM2 = ((GEMM_KM) >> (8 * FMT)) & 15, GS1 = KM1 <= 1 ? 4 : 2, GS2 = KM2 <= 2 ? 3 : KM2 <= 4 ? 2 : 1;
    constexpr bool LGKDEFER = FMT == 2 && GEMM_LGKDEFER && KM1 == 2 && KM2 >= 4 && KP == 0;
    constexpr bool B1LATE = FMT == 2 && GEMM_B1LATE && KM2 >= 4;
    int f8sc = g.sB; if constexpr (FP8) { asm volatile("" : "+v"(f8sc)); }
    unsigned voffA[2], voffB[2];
#pragma unroll
    for (int i = 0; i < 2; ++i) { int R, C; stage_rc(tid * 16 + i * 8192, R, C); const int Rb = Epi::PERM ? ((R & ~31) + perm32(R & 31)) : R;
        voffA[i] = (unsigned)(R * g.lda + C) * 2u; voffB[i] = (unsigned)(Rb * g.ldb + C) * 2u; }
    const size_t kstepA = (size_t)g.kstepA, kstepB = (size_t)g.kstepB;
    const size_t hstepA = (size_t)HALF * g.lda * 2, hstepB = (size_t)HALF * g.ldb * 2;
    const unsigned ldsbase = __builtin_amdgcn_readfirstlane((unsigned)(size_t)lds + (unsigned)wid * 1024u);
    const unsigned ldsw = (unsigned)wid * 1024u;
    const int aoff = lds_byte(wr * 64 + fr, fq * 8), boff = lds_byte(wc * 32 + fr, fq * 8);
#define PG8_SA(b, h) (((b) * 2 + (h)) * HTB)
#define PG8_SB(b, h) ((4 + (b) * 2 + (h)) * HTB)
#define PG8_STAGE(bufoff, gbase, voff) do { _Pragma("unroll") for (int _i = 0; _i < 2; ++_i) \
        __builtin_amdgcn_global_load_lds((const unsigned*)((const char*)(gbase) + (voff)[_i]), (PG8_LAS unsigned*)(lds + (bufoff) + ldsw + _i * 8192), 16, 0, 0); } while (0)
#define PG8_LDA(dst, b, h) do { _Pragma("unroll") for (int m = 0; m < 4; ++m) { dst[m][0] = *(const PG8_LAS bf16x8*)(lds + PG8_SA(b, h) + aoff + m * 2048); \
        if constexpr (FMT == 2) { dst##H[m] = *(const PG8_LAS i32x2*)(lds + PG8_SA(b, h) + aoff + m * 2048 + 1024); asm volatile("" ::: "memory"); } else dst[m][1] = *(const PG8_LAS bf16x8*)(lds + PG8_SA(b, h) + aoff + m * 2048 + 1024); } } while (0)
#define PG8_LDB(dst, b, h) do { _Pragma("unroll") for (int n = 0; n < 2; ++n) { dst[n][0] = *(const PG8_LAS bf16x8*)(lds + PG8_SB(b, h) + boff + n * 2048); \
        if constexpr (FMT == 2) { dst##H[n] = *(const PG8_LAS i32x2*)(lds + PG8_SB(b, h) + boff + n * 2048 + 1024); asm volatile("" ::: "memory"); } else dst[n][1] = *(const PG8_LAS bf16x8*)(lds + PG8_SB(b, h) + boff + n * 2048 + 1024); } } while (0)
#define PG8_STAGE1(bufoff, gbase, voff, i) do { if constexpr ((GEMM_SADDR >> FMT) & 1) { \
        asm volatile("s_mov_b32 m0, %0\n\ts_nop 0\n\tglobal_load_lds_dwordx4 %1, %2" :: "s"(ldsbase + (unsigned)((bufoff) + (i) * 8192)), "v"((voff)[i]), "s"((const char*)(gbase)) : "m0", "memory"); } \
        else __builtin_amdgcn_global_load_lds((const unsigned*)((const char*)(gbase) + (voff)[i]), (PG8_LAS unsigned*)(lds + (bufoff) + ldsw + (i) * 8192), 16, 0, 0); } while (0)
#define PG8_MMA1(ai, bj, At, Bt, m) do { _Pragma("unroll") for (int n = 0; n < 2; ++n) { \
        if constexpr (FMT == 2) { const i32x4 w0_ = __builtin_bit_cast(i32x4, Bt[n][0]), a0_ = __builtin_bit_cast(i32x4, At[m][0]); \
            const i32x6 wf_ = (i32x6){w0_[0], w0_[1], w0_[2], w0_[3], Bt##H[n][0], Bt##H[n][1]}, af_ = (i32x6){a0_[0], a0_[1], a0_[2], a0_[3], At##H[m][0], At##H[m][1]}; \
            asm volatile("v_mfma_scale_f32_16x16x128_f8f6f4 %0, %1, %2, %0, %3, %3 op_sel:[0,1,0] op_sel_hi:[0,0,0] cbsz:2 blgp:2" : "+v"(acc[ai][bj][m][n]) : "v"(wf_), "v"(af_), "v"(f8sc)); } \
        else if constexpr (FMT == 1) { const i32x8 wf_ = __builtin_shufflevector(__builtin_bit_cast(i32x4, Bt[n][0]), __builtin_bit_cast(i32x4, Bt[n][1]), 0, 1, 2, 3, 4, 5, 6, 7); \
            const i32x8 af_ = __builtin_shufflevector(__builtin_bit_cast(i32x4, At[m][0]), __builtin_bit_cast(i32x4, At[m][1]), 0, 1, 2, 3, 4, 5, 6, 7); \
            asm volatile("v_mfma_scale_f32_16x16x128_f8f6f4 %0, %1, %2, %0, %3, %3 op_sel:[0,1,0] op_sel_hi:[0,0,0]" : "+v"(acc[ai][bj][m][n]) : "v"(wf_), "v"(af_), "v"(f8sc)); } \
        else { _Pragma("unroll") for (int k = 0; k < 2; ++k) acc[ai][bj][m][n] = __builtin_amdgcn_mfma_f32_16x16x32_bf16(Bt[n][k], At[m][k], acc[ai][bj][m][n], 0, 0, 0); } } } while (0)
#define PG8_MMA(ai, bj, At, Bt) do { __builtin_amdgcn_s_setprio(1); _Pragma("unroll") for (int m = 0; m < 4; ++m) PG8_MMA1(ai, bj, At, Bt, m); \
        __builtin_amdgcn_s_setprio(0); } while (0)
#define PG8_ST(bufoff, gbase, voff, i) do { PG8_SCHED; PG8_STAGE1(bufoff, gbase, voff, i); PG8_SCHED; } while (0)
#define PG8_PIECE2(j, bb, pb, pa) do { KP_ST if ((j) < 2) PG8_STAGE1(PG8_SB(bb, 0), pb, voffB, (j) & 1); else if ((j) < 4) PG8_STAGE1(PG8_SB(bb, 1), (pb) + hstepB, voffB, (j) & 1); else PG8_STAGE1(PG8_SA(bb, 0), pa, voffA, (j) & 1); } while (0)
#define PG8_GROUP(ai, g) do { KP_MM if ((g) < 4) PG8_MMA1(ai, 0, At, B0, (g) & 3); else PG8_MMA1(ai, 1, At, B1, (g) & 3); } while (0)
#define PG8_PRIO1 do { if constexpr (!(FMT == 2 && GEMM_FP6_NOPRIO)) __builtin_amdgcn_s_setprio(1); } while (0)
#define PG8_SP1X(bb, sb, ps) do { \
        _Pragma("unroll") for (int j_ = 0; j_ < 2 - KM1; ++j_) KP_ST PG8_STAGE1(PG8_SA(sb, 1), ps, voffA, j_); \
        KP_RD { PG8_LDB(B0, bb, 0); if constexpr (!B1LATE && !LGKDEFER) PG8_LDB(B1, bb, 1); PG8_SCHED; PG8_LDA(At, bb, 0); if constexpr (!B1LATE && LGKDEFER) { PG8_SCHED; PG8_LDB(B1, bb, 1); } } \
        waitv<8 - KM1>(); if constexpr (LGKDEFER) PG8_WAIT_L(12); else PG8_WAIT_L(0); PG8_BAR; PG8_PRIO1; \
        _Pragma("unroll") for (int g_ = 0; g_ < 8; ++g_) { PG8_GROUP(0, g_); \
            if constexpr (B1LATE) { if (g_ == 0) { PG8_SCHED; KP_RD { PG8_LDB(B1, bb, 1); } PG8_SCHED; } } \
            if (g_ % GS1 == 0 && g_ / GS1 < KM1) { PG8_SCHED; KP_ST PG8_STAGE1(PG8_SA(sb, 1), ps, voffA, 2 - KM1 + g_ / GS1); PG8_SCHED; } } \
        __builtin_amdgcn_s_setprio(0); PG8_BAR; PG8_SCHED; } while (0)
#define PG8_SP2X(bb, pb, pa) do { \
        if constexpr (!GEMM_RDFIRST) { _Pragma("unroll") for (int j_ = 0; j_ < 6 - KM2; ++j_) PG8_PIECE2(j_, bb, pb, pa); } \
        KP_RD { PG8_LDA(At, bb, 1); } \
        if constexpr (GEMM_RDFIRST) { PG8_SCHED; _Pragma("unroll") for (int j_ = 0; j_ < 6 - KM2; ++j_) PG8_PIECE2(j_, bb, pb, pa); } \
        waitv<8 - KM2>(); if constexpr (!LGKDEFER) PG8_WAIT_L(0); PG8_BAR; PG8_PRIO1; \
        _Pragma("unroll") for (int g_ = 0; g_ < 8; ++g_) { PG8_GROUP(1, g_); \
            if (g_ % GS2 == 0 && g_ / GS2 < KM2) { PG8_SCHED; PG8_PIECE2(6 - KM2 + g_ / GS2, bb, pb, pa); PG8_SCHED; } } \
        __builtin_amdgcn_s_setprio(0); PG8_BAR; PG8_SCHED; } while (0)
#define PG8_SP1B(bb, sb, ps, Bc) do { \
        _Pragma("unroll") for (int j_ = 0; j_ < 2 - KM1; ++j_) PG8_STAGE1(PG8_SA(sb, 1), ps, voffA, j_); \
        PG8_LDB(B1, bb, 1); PG8_SCHED; PG8_LDA(At, bb, 0); \
        waitv<6 - KM1>(); PG8_WAIT_L(0); PG8_BAR; __builtin_amdgcn_s_setprio(1); \
        _Pragma("unroll") for (int g_ = 0; g_ < 8; ++g_) { if (g_ < 4) PG8_MMA1(0, 0, At, Bc, g_ & 3); else PG8_MMA1(0, 1, At, B1, g_ & 3); \
            if (g_ % GS1 == 0 && g_ / GS1 < KM1) { PG8_SCHED; PG8_STAGE1(PG8_SA(sb, 1), ps, voffA, 2 - KM1 + g_ / GS1); PG8_SCHED; } } \
        __builtin_amdgcn_s_setprio(0); PG8_BAR; PG8_SCHED; } while (0)
#define PG8_SP2B(bb, pb, pa, Bc, Bn) do { \
        _Pragma("unroll") for (int j_ = 0; j_ < 6 - KM2; ++j_) PG8_PIECE2(j_, bb, pb, pa); \
        PG8_LDA(At, bb, 1); PG8_SCHED; PG8_LDB(Bn, 1 - (bb), 0); \
        waitv<8 - KM2>(); PG8_WAIT_L(0); PG8_BAR; __builtin_amdgcn_s_setprio(1); \
        _Pragma("unroll") for (int g_ = 0; g_ < 8; ++g_) { if (g_ < 4) PG8_MMA1(1, 0, At, Bc, g_ & 3); else PG8_MMA1(1, 1, At, B1, g_ & 3); \
            if (g_ % GS2 == 0 && g_ / GS2 < KM2) { PG8_SCHED; PG8_PIECE2(6 - KM2 + g_ / GS2, bb, pb, pa); PG8_SCHED; } } \
        __builtin_amdgcn_s_setprio(0); PG8_BAR; PG8_SCHED; } while (0)
#define PG8_WAIT_V(n) asm volatile("s_waitcnt vmcnt(" #n ")" ::: "memory")
#define PG8_WAIT_L(n) asm volatile("s_waitcnt lgkmcnt(" #n ")" ::: "memory")
#define PG8_BAR __builtin_amdgcn_s_barrier()
#define PG8_SCHED __builtin_amdgcn_sched_barrier(0)
    Unit cur, nxt; int ui = 0;
    if (!S.next(0, cur)) return;
    f32x4 acc[2][2][4][2];
#pragma unroll
    for (int a = 0; a < 2; ++a)
#pragma unroll
        for (int b = 0; b < 2; ++b)
#pragma unroll
            for (int m = 0; m < 4; ++m)
#pragma unroll
                for (int n = 0; n < 2; ++n) acc[a][b][m][n] = (f32x4){0.f, 0.f, 0.f, 0.f};
    bf16x8 At[4][2] = {}, B0[2][2] = {}, B1[2][2] = {}, B2[2][2] = {}; i32x2 AtH[4] = {}, B0H[2] = {}, B1H[2] = {}, B2H[2] = {};
    const char* cA = cur.a; const char* cB = cur.b;
    S.a_ready(cur);
    if constexpr (SP2) {
        PG8_STAGE(PG8_SB(0, 0), cB, voffB); PG8_STAGE(PG8_SB(0, 1), cB + hstepB, voffB); PG8_STAGE(PG8_SA(0, 0), cA, voffA); PG8_STAGE(PG8_SA(0, 1), cA + hstepA, voffA);
        if (wr == 1) PG8_BAR;
        PG8_WAIT_V(2); PG8_BAR;
        PG8_STAGE(PG8_SB(1, 0), cB + kstepB, voffB); PG8_STAGE(PG8_SA(1, 0), cA + kstepA, voffA); PG8_STAGE(PG8_SB(1, 1), cB + hstepB + kstepB, voffB);
        PG8_WAIT_V(6); PG8_BAR;
    } else {
        PG8_STAGE(PG8_SB(0, 0), cB, voffB); PG8_STAGE(PG8_SA(0, 0), cA, voffA); PG8_STAGE(PG8_SB(0, 1), cB + hstepB, voffB); PG8_STAGE(PG8_SA(0, 1), cA + hstepA, voffA);
        if (wr == 1) PG8_BAR;
        PG8_WAIT_V(4); PG8_BAR;
        PG8_STAGE(PG8_SB(1, 0), cB + kstepB, voffB); PG8_STAGE(PG8_SA(1, 0), cA + kstepA, voffA); PG8_STAGE(PG8_SB(1, 1), cB + hstepB + kstepB, voffB);
        PG8_WAIT_V(6); PG8_BAR;
    }
    if constexpr (BPF) { PG8_LDB(B0, 0, 0); }
    for (;;) {
        const bool has_next = S.next(ui + 1, nxt);
        const char* nA = has_next ? nxt.a : cA; const char* nB = has_next ? nxt.b : cB;
        for (int t = 0; t < nt; t += 2) {
            const bool last = (t == nt - 2);
            const char* a1 = cA + (size_t)(t + 1) * kstepA;
            const char* a2 = last ? nA : cA + (size_t)(t + 2) * kstepA; const char* b2 = last ? nB : cB + (size_t)(t + 2) * kstepB;
            const char* a3 = a2 + kstepA; const char* b3 = b2 + kstepB;
            if (last && has_next) S.a_ready(nxt);
            if constexpr (BPF) {
            PG8_SP1B(0, 1, a1 + hstepA, B0); PG8_SP2B(0, b2, a2, B0, B2); PG8_SP1B(1, 0, a2 + hstepA, B2); PG8_SP2B(1, b3, a3, B2, B0);
            } else if constexpr (SP2 && (KM1 | KM2) != 0) {
            PG8_SP1X(0, 1, a1 + hstepA); PG8_SP2X(0, b2, a2); PG8_SP1X(1, 0, a2 + hstepA); PG8_SP2X(1, b3, a3);
            } else if constexpr (SP2) {
            KP_ST PG8_STAGE(PG8_SA(1, 1), a1 + hstepA, voffA); KP_RD PG8_LDB(B0, 0, 0); KP_RD PG8_LDB(B1, 0, 1); PG8_SCHED; KP_RD PG8_LDA(At, 0, 0);
            PG8_WAIT_V(8); PG8_WAIT_L(0); PG8_BAR; KP_MM PG8_MMA(0, 0, At, B0); KP_MM PG8_MMA(0, 1, At, B1); PG8_BAR; PG8_SCHED;
            KP_ST PG8_STAGE(PG8_SB(0, 0), b2, voffB); KP_ST PG8_STAGE(PG8_SB(0, 1), b2 + hstepB, voffB); KP_ST PG8_STAGE(PG8_SA(0, 0), a2, voffA); KP_RD PG8_LDA(At, 0, 1);
            PG8_WAIT_V(8); PG8_WAIT_L(0); PG8_BAR; KP_MM PG8_MMA(1, 0, At, B0); KP_MM PG8_MMA(1, 1, At, B1); PG8_BAR; PG8_SCHED;
            KP_ST PG8_STAGE(PG8_SA(0, 1), a2 + hstepA, voffA); KP_RD PG8_LDB(B0, 1, 0); KP_RD PG8_LDB(B1, 1, 1); PG8_SCHED; KP_RD PG8_LDA(At, 1, 0);
            PG8_WAIT_V(8); PG8_WAIT_L(0); PG8_BAR; KP_MM PG8_MMA(0, 0, At, B0); KP_MM PG8_MMA(0, 1, At, B1); PG8_BAR; PG8_SCHED;
            KP_ST PG8_STAGE(PG8_SB(1, 0), b3, voffB); KP_ST PG8_STAGE(PG8_SB(1, 1), b3 + hstepB, voffB); KP_ST PG8_STAGE(PG8_SA(1, 0), a3, voffA); KP_RD PG8_LDA(At, 1, 1);
            PG8_WAIT_V(8); PG8_WAIT_L(0); PG8_BAR; KP_MM PG8_MMA(1, 0, At, B0); KP_MM PG8_MMA(1, 1, At, B1); PG8_BAR; PG8_SCHED;
            } else {
            PG8_LDB(B0, 0, 0); PG8_SCHED; PG8_LDA(At, 0, 0); PG8_STAGE(PG8_SA(1, 1), a1 + hstepA, voffA);
            PG8_WAIT_L(8); PG8_BAR; PG8_WAIT_L(0); PG8_MMA(0, 0, At, B0); PG8_BAR; PG8_SCHED;
            PG8_LDB(B1, 0, 1); PG8_STAGE(PG8_SB(0, 0), b2, voffB);
            PG8_BAR; PG8_WAIT_L(0); PG8_MMA(0, 1, At, B1); PG8_BAR;
            PG8_LDA(At, 0, 1); PG8_STAGE(PG8_SA(0, 0), a2, voffA);
            PG8_BAR; PG8_WAIT_L(0); PG8_MMA(1, 0, At, B0); PG8_BAR; PG8_SCHED;
            PG8_STAGE(PG8_SB(0, 1), b2 + hstepB, voffB);
            PG8_WAIT_V(6); PG8_BAR; PG8_MMA(1, 1, At, B1); PG8_BAR;
            PG8_LDB(B0, 1, 0); PG8_SCHED; PG8_LDA(At, 1, 0); PG8_STAGE(PG8_SA(0, 1), a2 + hstepA, voffA);
            PG8_WAIT_L(8); PG8_BAR; PG8_WAIT_L(0); PG8_MMA(0, 0, At, B0); PG8_BAR; PG8_SCHED;
            PG8_LDB(B1, 1, 1); PG8_STAGE(PG8_SB(1, 0), b3, voffB);
            PG8_BAR; PG8_WAIT_L(0); PG8_MMA(0, 1, At, B1); PG8_BAR;
            PG8_LDA(At, 1, 1); PG8_STAGE(PG8_SA(1, 0), a3, voffA);
            PG8_BAR; PG8_WAIT_L(0); PG8_MMA(1, 0, At, B0); PG8_BAR; PG8_SCHED;
            PG8_STAGE(PG8_SB(1, 1), b3 + hstepB, voffB);
            PG8_WAIT_V(6); PG8_BAR; PG8_MMA(1, 1, At, B1); PG8_BAR;
            }
        }
        if constexpr (ALIGN_EPI) { if (wr == 0) PG8_BAR; }
        if constexpr (FP8) { asm volatile("s_nop 15\n\ts_nop 15" ::: "memory"); }
        if constexpr (epi_staged<Epi>::value) { static_assert(ALIGN_EPI, "a staged epilogue uses workgroup barriers: both halves must run it together"); E.staged(acc, cur, wr, wc, fr, fq, lds + STAGE_BYTES, wid, lane); S.done(cur); }
        else if constexpr (!Epi::AFTER_DRAIN) { E(acc, cur, wr, wc, fr, fq); S.done(cur); }
        if (!has_next) break;
#pragma unroll
        for (int a = 0; a < 2; ++a)
#pragma unroll
            for (int b = 0; b < 2; ++b)
#pragma unroll
                for (int m = 0; m < 4; ++m)
#pragma unroll
                    for (int n = 0; n < 2; ++n) acc[a][b][m][n] = (f32x4){0.f, 0.f, 0.f, 0.f};
        cur = nxt; cA = nA; cB = nB; ++ui;
        if constexpr (ALIGN_EPI) { if (wr == 1) PG8_BAR; }
    }
    PG8_WAIT_V(0);
    if constexpr (!ALIGN_EPI) { if (wr == 0) PG8_BAR; }
    PG8_BAR;
    if constexpr (Epi::AFTER_DRAIN) { E.fused(acc, cur, wr, wc, fr, fq, lds, wid, lane); S.done(cur); }
#undef PG8_SA
#undef PG8_SB
#undef PG8_STAGE
#undef PG8_LDA
#undef PG8_LDB
#undef PG8_MMA
#undef PG8_MMA1
#undef PG8_STAGE1
#undef PG8_ST
#undef KP_RD
#undef KP_ST
#undef KP_MM
#undef PG8_PIECE2
#undef PG8_GROUP
#undef PG8_SP1X
#undef PG8_SP2X
#undef PG8_PRIO1
#undef PG8_SP1B
#undef PG8_SP2B
#undef PG8_WAIT_V
#undef PG8_WAIT_L
#undef PG8_BAR
#undef PG8_SCHED
}}
namespace fz {
#define LAS __attribute__((address_space(3)))
typedef unsigned short bf16_t;
typedef short bf16x8 __attribute__((ext_vector_type(8)));
typedef float f32x4 __attribute__((ext_vector_type(4)));
typedef float f32x2 __attribute__((ext_vector_type(2)));
typedef unsigned u32x4 __attribute__((ext_vector_type(4)));
typedef unsigned u32x2 __attribute__((ext_vector_type(2)));
typedef unsigned u32x6 __attribute__((ext_vector_type(6)));
typedef float f32x16 __attribute__((ext_vector_type(16)));
constexpr int NTHR = 512;
constexpr int LDS_BYTES = 163840, MISC_OFF = LDS_BYTES - 256;

constexpr size_t MiB = 1u << 20;
constexpr size_t WS_CTL = 0, CTL_ZERO_BYTES = 1 * MiB;
constexpr size_t WS_WIN = 1 * MiB;
constexpr size_t WS_WPOOL = WS_WIN + 32 * MiB;
constexpr size_t WS_WOUT = WS_WPOOL + 1 * MiB;
constexpr size_t WS_WGU = WS_WOUT + 16 * MiB;
constexpr size_t WS_WD = WS_WGU + 44 * MiB;
constexpr size_t WS_EWGU = WS_WD + 22 * MiB;
constexpr size_t WS_EWD = WS_EWGU + 448 * MiB;
constexpr size_t WS_XS = WS_EWD + 224 * MiB;
constexpr size_t WS_H = WS_XS + 128 * MiB;
constexpr size_t WS_GLR = WS_H + 65 * MiB;
constexpr size_t WS_ROUTE = WS_GLR + 1 * MiB;
constexpr size_t WS_U = WS_ROUTE + 2 * MiB;
constexpr size_t WS_Z = WS_U;
constexpr size_t WS_DP = WS_Z + 128 * MiB;
constexpr size_t WS_MIX = WS_DP + 32 * MiB;
constexpr size_t WS_CS = WS_MIX + 64 * MiB;
constexpr size_t WS_SP = WS_CS + 128 * MiB;
constexpr size_t WS_DEC = WS_SP + 64 * MiB;
constexpr size_t WS_ACT = WS_U;
constexpr size_t WS_HS = WS_U;
constexpr size_t WS_ACT2 = WS_HS + 136 * MiB;
constexpr size_t WS_Y = WS_ACT2 + 476 * MiB;
constexpr size_t WS_PART = WS_ACT2 + 240 * MiB;
constexpr size_t WS_END = WS_Y + 136 * MiB;
static_assert(WS_END <= 1792 * MiB, "workspace map");
static_assert(WS_DEC + 1 * MiB <= WS_END, "mixer view inside U");
constexpr size_t RT_TOPI = 0, RT_TOPW = 128 * 1024, RT_TOKSLOT = 256 * 1024, RT_HIST = 384 * 1024, RT_BLKE = 400 * 1024, RT_NRB = 404 * 1024;

constexpr int CW_BAR = 4096;

constexpr int PH_PRO = 0, PH_PER_LAYER = 10, NPH = 1 + 2 * PH_PER_LAYER;
constexpr int PK_INPROJ = 0, PK_PRE = 1, PK_POOLSCAN = 2, PK_GLAOUT = 3, PK_OUTPROJ = 4, PK_NORM2 = 5, PK_ASSIGN = 6, PK_UP = 7, PK_DOWN = 8, PK_TAIL = 9;

#define VM_WAIT() asm volatile("s_waitcnt vmcnt(0)" ::: "memory")
#define LDS_WAIT() asm volatile("s_waitcnt lgkmcnt(0)" ::: "memory")
#define RLX_AGENT __ATOMIC_RELAXED, __HIP_MEMORY_SCOPE_AGENT

__device__ __forceinline__ unsigned pk_bf16(float lo, float hi) { unsigned r; asm volatile("v_cvt_pk_bf16_f32 %0, %1, %2" : "=v"(r) : "v"(lo), "v"(hi)); return r; }
__device__ __forceinline__ float bf_lo(unsigned w) { return __uint_as_float(w << 16); }
__device__ __forceinline__ float bf_hi(unsigned w) { return __uint_as_float(w & 0xffff0000u); }
__device__ __forceinline__ float bf2f(bf16_t b) { return __uint_as_float(((unsigned)b) << 16); }
__device__ __forceinline__ bf16_t f2bf(float f) { return (bf16_t)(pk_bf16(f, 0.f) & 0xffffu); }
__device__ __forceinline__ float wave_sum(float v) {
#pragma unroll
    for (int o = 1; o < 64; o <<= 1) v += __shfl_xor(v, o);
    return v;
}
__device__ __forceinline__ float silu_f(float x) { return x * __builtin_amdgcn_rcpf(1.0f + __builtin_amdgcn_exp2f(-1.4426950408889634f * x)); }
__device__ __forceinline__ bf16x8 mk8(u32x2 lo, u32x2 hi) { u32x4 t; t.x = lo.x; t.y = lo.y; t.z = hi.x; t.w = hi.y; return __builtin_bit_cast(bf16x8, t); }
__device__ __forceinline__ bf16x8 tr_frag(unsigned a0, unsigned a1) {
    u32x2 lo, hi;
    asm volatile("ds_read_b64_tr_b16 %0, %2\n\tds_read_b64_tr_b16 %1, %3\n\ts_waitcnt lgkmcnt(0)" : "=&v"(lo), "=&v"(hi) : "v"(a0), "v"(a1) : "memory");
    return mk8(lo, hi);
}
__device__ __forceinline__ void moe_tail_split(int nrb, int G, int& full, int& tail, int& s) {
    const int nwg = nrb * 8; full = (nwg / G) * G; tail = nwg - full;
    s = tail == 0 ? 0 : (tail * 7 <= G ? 7 : (tail * 4 <= G ? 4 : (tail * 2 <= G ? 2 : 0)));
    if (s == 0) { full = nwg; tail = 0; }
}
__device__ __forceinline__ f32x4 mma16(bf16x8 a, bf16x8 b, f32x4 c) { return __builtin_amdgcn_mfma_f32_16x16x32_bf16(a, b, c, 0, 0, 0); }

#define XB_TMO      128
#define XB_XCNT(j)  (256  + 64 * (j))
#define XB_XSUB(j)  (1280 + 64 * (j))
#define XB_XGEN(j)  (2304 + 64 * (j))
#define XB_TOP      3328
#define XB_TOPGEN   3392
#define XCD_BAR_WORDS 3456
#define XB_SPIN_CAP (1u << 18)
__device__ __forceinline__ unsigned xb_ld(unsigned* p)              { return __hip_atomic_load(p, __ATOMIC_RELAXED, __HIP_MEMORY_SCOPE_AGENT); }
__device__ __forceinline__ unsigned xb_add(unsigned* p, unsigned v) { return __hip_atomic_fetch_add(p, v, __ATOMIC_RELAXED, __HIP_MEMORY_SCOPE_AGENT); }
__device__ __forceinline__ unsigned xb_xcc_id() { return (unsigned)__builtin_amdgcn_s_getreg((3 << 11) | 20) & 0xFu; }
#define XB_SPIN(cond, bar) do { unsigned _sp = 0; while (cond) { __builtin_amdgcn_s_sleep(1); \
    if ((++_sp & 255u) == 0u) { if (xb_ld(&(bar)[XB_TMO])) break; if (_sp > XB_SPIN_CAP) { atomicAdd(&(bar)[XB_TMO], 1u); break; } } } } while (0)
struct XcdBarrier { unsigned* bar; unsigned x; volatile LAS unsigned* st; };
__device__ __forceinline__ XcdBarrier xcd_barrier_post(unsigned* bar, volatile LAS unsigned* st) {
    XcdBarrier b; b.bar = bar; b.x = xb_xcc_id(); b.st = st;
    if (threadIdx.x == 0) (void)xb_add(&bar[XB_XCNT(b.x)], 1u);
    return b;
}
__device__ __forceinline__ void xcd_barrier_complete(unsigned* bar, unsigned x, unsigned& nloc, unsigned& nx) {
    const unsigned G = gridDim.x * gridDim.y * gridDim.z;
    unsigned sum, cnt, mine, sp = 0u;
    for (;;) {
        sum = 0u; cnt = 0u; mine = 0u;
#pragma unroll
        for (unsigned j = 0; j < 16; ++j) { const unsigned c = xb_ld(&bar[XB_XCNT(j)]); sum += c; cnt += (c > 0u) ? 1u : 0u; mine = (j == x) ? c : mine; }
        if (sum == G) break;
        __builtin_amdgcn_s_sleep(1);
        if ((++sp & 255u) == 0u) { if (xb_ld(&bar[XB_TMO])) break; if (sp > XB_SPIN_CAP) { atomicAdd(&bar[XB_TMO], 1u); break; } }
    }
    nloc = mine > 0u ? mine : 1u; nx = cnt > 0u ? cnt : 1u;
}
__device__ __forceinline__ void xcd_barrier(const XcdBarrier& b) {
    asm volatile("s_waitcnt vmcnt(0)" ::: "memory");
    __syncthreads();
    if (threadIdx.x == 0) {
        unsigned* bar = b.bar;
        __builtin_amdgcn_s_waitcnt(0);
        unsigned nloc = b.st[0], nx = b.st[1];
        if (nloc == 0u) { xcd_barrier_complete(bar, b.x, nloc, nx); b.st[0] = nloc; b.st[1] = nx; }
        const unsigned old = xb_add(&bar[XB_XSUB(b.x)], 1u);
        const unsigned gen = old / nloc;
        if (old + 1u == (gen + 1u) * nloc) {
            __builtin_amdgcn_fence(__ATOMIC_RELEASE, "agent");
            asm volatile("s_waitcnt vmcnt(0)" ::: "memory");
            const unsigned og = xb_add(&bar[XB_TOP], 1u);
            const unsigned tg = og / nx;
            if (og + 1u == (tg + 1u) * nx) xb_add(&bar[XB_TOPGEN], 1u);
            else XB_SPIN(xb_ld(&bar[XB_TOPGEN]) == tg, bar);
            __builtin_amdgcn_fence(__ATOMIC_ACQUIRE, "agent");
            xb_add(&bar[XB_XGEN(b.x)], 1u);
            asm volatile("s_waitcnt vmcnt(0)" ::: "memory");
        } else {
            XB_SPIN(xb_ld(&bar[XB_XGEN(b.x)]) == gen, bar);
            __builtin_amdgcn_fence(__ATOMIC_ACQUIRE, "agent");
            asm volatile("s_waitcnt vmcnt(0)" ::: "memory");
        }
    }
    __syncthreads();
}

struct CvtJob { const float* src; int ld_src; int k0; int n0; unsigned char* dstb; int dpitch; float f8scale; int fmt6; };
__device__ __forceinline__ void cvt_load(const CvtJob& j, f32x4 (&v)[16], int lane) {
    if (j.f8scale != 0.f) { const int kr = lane >> 3, nq = lane & 7;
#pragma unroll
        for (int i = 0; i < 16; ++i) v[i] = *(const f32x4*)(j.src + (size_t)(j.k0 + 8 * i + kr) * j.ld_src + j.n0 + 4 * nq);
    } else { const int kr = lane >> 4, nq = lane & 15;
#pragma unroll
        for (int i = 0; i < 16; ++i) v[i] = *(const f32x4*)(j.src + (size_t)(j.k0 + 4 * i + kr) * j.ld_src + j.n0 + 4 * nq); }
}
__device__ __forceinline__ float f8cl(float v) { return __builtin_fminf(__builtin_fmaxf(v, -448.f), 448.f); }
__device__ __forceinline__ void cvt_finish(const CvtJob& j, const f32x4 (&v)[16], LAS float* scr, int lane) {
    const int nlo = lane & 7, kq = lane >> 3;
    if (j.f8scale != 0.f) { const int kr = lane >> 3, nq = lane & 7;
#pragma unroll
        for (int i = 0; i < 16; ++i) { LAS float* w = scr + (8 * i + kr) * 33 + 4 * nq; w[0] = v[i].x; w[1] = v[i].y; w[2] = v[i].z; w[3] = v[i].w; }
        LDS_WAIT(); asm volatile("" ::: "memory");
        const float sc = j.f8scale;
        if (j.fmt6) {
            const int n = lane & 31;
#pragma unroll
            for (int gi = 0; gi < 2; ++gi) { const int g = 2 * (lane >> 5) + gi; const LAS float* s = scr + (32 * g) * 33 + n; f32x16 lo, hi;
#pragma unroll
                for (int i = 0; i < 16; ++i) { lo[i] = __builtin_fminf(__builtin_fmaxf(s[i * 33] * sc, -7.5f), 7.5f); hi[i] = __builtin_fminf(__builtin_fmaxf(s[(16 + i) * 33] * sc, -7.5f), 7.5f); }
                const u32x6 w = __builtin_amdgcn_cvt_scalef32_2xpk16_fp6_f32(lo, hi, 1.0f);
                unsigned char* d = j.dstb + (size_t)n * j.dpitch + 16 * g;
                *(u32x4*)d = (u32x4){w[0], w[1], w[2], w[3]}; *(u32x4*)(d + 64) = (u32x4){w[4], w[5], 0u, 0u};     }
        } else
#pragma unroll
        for (int jn = 0; jn < 4; ++jn) { const int n = 8 * jn + nlo; const LAS float* s = scr + (16 * kq) * 33 + n; int w[4];
#pragma unroll
            for (int d = 0; d < 4; ++d) { int x = 0;
                x = __builtin_amdgcn_cvt_pk_fp8_f32(f8cl(s[(4 * d + 0) * 33] * sc), f8cl(s[(4 * d + 1) * 33] * sc), x, false);
                x = __builtin_amdgcn_cvt_pk_fp8_f32(f8cl(s[(4 * d + 2) * 33] * sc), f8cl(s[(4 * d + 3) * 33] * sc), x, true); w[d] = x; }
            *(u32x4*)(j.dstb + (size_t)n * j.dpitch + 16 * kq) = (u32x4){(unsigned)w[0], (unsigned)w[1], (unsigned)w[2], (unsigned)w[3]}; }
    } else { const int kr = lane >> 4, nq = lane & 15;
#pragma unroll
        for (int i = 0; i < 16; ++i) { LAS float* w = scr + (4 * i + kr) * 65 + 4 * nq; w[0] = v[i].x; w[1] = v[i].y; w[2] = v[i].z; w[3] = v[i].w; }
        LDS_WAIT(); asm volatile("" ::: "memory");
#pragma unroll
        for (int jn = 0; jn < 8; ++jn) { const int n = 8 * jn + nlo; const LAS float* s = scr + (8 * kq) * 65 + n;
            u32x4 o; o.x = pk_bf16(s[0 * 65], s[1 * 65]); o.y = pk_bf16(s[2 * 65], s[3 * 65]); o.z = pk_bf16(s[4 * 65], s[5 * 65]); o.w = pk_bf16(s[6 * 65], s[7 * 65]);
            *(u32x4*)(j.dstb + (size_t)n * j.dpitch + 16 * kq) = o; }
    }
    LDS_WAIT(); asm volatile("" ::: "memory");
}
struct CvtPtrs { const float *w_in, *w_pool, *w_out, *dwg, *dwu, *dwd, *ewg, *ewu, *ewd; unsigned char* ws; };
constexpr int CI_WIN = 32 * 64, CI_WPOOL = 16, CI_WOUT = 32 * 32, CI_DGU = 32 * 88, CI_DD = 88 * 32, CI_EGU = 16 * 224, CI_ED = 56 * 64;
constexpr int CI_NONEXP = 2 * CI_WIN + 8 * CI_WPOOL + 2 * CI_WOUT + 2 * CI_DGU + CI_DD;
constexpr int CI_TOTAL = CI_NONEXP + 8 * (2 * CI_EGU + CI_ED);
__device__ __forceinline__ unsigned char* cvt_dst(unsigned char* base, int KT, int row0, int kt) { return base + ((size_t)((row0 >> 8) * KT + kt) * 256 + (row0 & 255)) * 128; }
__device__ __forceinline__ CvtJob cvt_decode(const CvtPtrs& P, int r) {
    CvtJob j; j.f8scale = 0.f; j.dpitch = 128; j.fmt6 = 0;
    if (r < 2 * CI_WIN) { const int l = r / CI_WIN, q = r % CI_WIN, kb = q / 64, ng = q % 64; const int c0 = 64 * ng;
        j.src = P.w_in + (size_t)l * DM * ZW; j.ld_src = ZW; j.k0 = 64 * kb; j.n0 = c0 < 3072 ? c0 : c0 + 16;
        j.dstb = cvt_dst(P.ws + WS_WIN + (size_t)l * 4096 * 2048 * 2, 32, c0, kb); return j; }
    r -= 2 * CI_WIN;
    if (r < 8 * CI_WPOOL) { const int m = r / CI_WPOOL, q = r % CI_WPOOL, kb = q / 4, ng = q % 4;
        j.src = P.w_pool + (size_t)m * 65536; j.ld_src = 256; j.k0 = 64 * kb; j.n0 = 64 * ng;
        j.dstb = cvt_dst(P.ws + WS_WPOOL + (size_t)m * 65536 * 2, 4, 64 * ng, kb); return j; }
    r -= 8 * CI_WPOOL;
    if (r < 2 * CI_WOUT) { const int l = r / CI_WOUT, q = r % CI_WOUT, kb = q / 32, ng = q % 32;
        j.src = P.w_out + (size_t)l * 2048 * 2048; j.ld_src = 2048; j.k0 = 64 * kb; j.n0 = 64 * ng;
        j.dstb = cvt_dst(P.ws + WS_WOUT + (size_t)l * 2048 * 2048 * 2, 32, 64 * ng, kb); return j; }
    r -= 2 * CI_WOUT;
#if DENSE_FP8 == 1
    if (r < 2 * CI_DGU) { const int up = r / CI_DGU, q = r % CI_DGU, kb = q / 176, ng = q % 176; const int c0 = 32 * ng;
        j.src = up ? P.dwu : P.dwg; j.ld_src = 5632; j.k0 = 128 * kb; j.n0 = c0;
        j.dstb = cvt_dst(P.ws + WS_WGU, 16, 256 * (c0 >> 7) + (c0 & 127) + 128 * up, kb); j.f8scale = 64.f; return j; }
#else
    if (r < 2 * CI_DGU) { const int up = r / CI_DGU, q = r % CI_DGU, kb = q / 88, ng = q % 88; const int c0 = 64 * ng;
        j.src = up ? P.dwu : P.dwg; j.ld_src = 5632; j.k0 = 64 * kb; j.n0 = c0;
        j.dstb = cvt_dst(P.ws + WS_WGU, 32, 256 * (c0 >> 7) + (c0 & 127) + 128 * up, kb); return j; }
#endif
    r -= 2 * CI_DGU;
#if DENSE_FP8 >= 1
    if (r < CI_DD) { const int kb = r / 64, ng = r % 64;
        j.src = P.dwd; j.ld_src = 2048; j.k0 = 128 * kb; j.n0 = 32 * ng;
        j.dstb = cvt_dst(P.ws + WS_WD, 44, 32 * ng, kb); j.f8scale = 128.f; return j; }
#else
    if (r < CI_DD) { const int kb = r / 32, ng = r % 32;
        j.src = P.dwd; j.ld_src = 2048; j.k0 = 64 * kb; j.n0 = 64 * ng;
        j.dstb = cvt_dst(P.ws + WS_WD, 88, 64 * ng, kb); return j; }
#endif
    r -= CI_DD;
    { const int e = r / (2 * CI_EGU + CI_ED); int q = r % (2 * CI_EGU + CI_ED);
        if (q < 2 * CI_EGU) { const int up = q / CI_EGU; q %= CI_EGU; const int kb = q / 224, ng = q % 224, c0 = 32 * ng;
            j.src = (up ? P.ewu : P.ewg) + (size_t)e * 2048 * 7168; j.ld_src = 7168; j.k0 = 128 * kb; j.n0 = c0;
            const int row0 = 256 * (c0 >> 7) + (c0 & 127) + 128 * up;
            if (TILE_EWGU) j.dstb = cvt_dst(P.ws + WS_EWGU + (size_t)e * 14336 * 2048, 16, row0, kb);
            else { j.dstb = P.ws + WS_EWGU + (size_t)e * 14336 * 2048 + (size_t)row0 * 2048 + 128 * kb; j.dpitch = 2048; }
            j.f8scale = 64.f; j.fmt6 = (MOE_UP_FMT == 2); return j; }
        q -= 2 * CI_EGU; { const int kb = q / 64, ng = q % 64;
            j.src = P.ewd + (size_t)e * 7168 * 2048; j.ld_src = 2048; j.k0 = 128 * kb; j.n0 = 32 * ng;
            j.dstb = cvt_dst(P.ws + WS_EWD + (size_t)e * 2048 * 7168, 56, 32 * ng, kb); j.f8scale = 128.f; return j; } }
}

constexpr int NP_PITCH = 4112;
template <int MODE, bool OUT8 = false, bool INBF = true>
__device__ __forceinline__ void norm_phase(LAS unsigned char* lds, const void* xin, const float* gain, bf16_t* H, const float* Wp, int ldw,
                                           float* glr, int* topi, float* topw, int* hist, int tid, int lane, int wave, int G) {
    LAS float* Wl = (LAS float*)lds;
    LAS unsigned char* Wt = lds;
    LAS unsigned char* Ht = lds + 16 * NP_PITCH;
    LAS float* part = (LAS float*)(lds + 32 * NP_PITCH);
    LAS int* cnt = (LAS int*)(lds + 135168);
    if (MODE == 2) {
#pragma unroll
        for (int i = 0; i < 4; ++i) { const int k = tid + 512 * i;
#pragma unroll
            for (int p4 = 0; p4 < 2; ++p4) { const f32x4 w = *(const f32x4*)(Wp + (size_t)k * ldw + 4 * p4);
                Wl[(4 * p4 + 0) * 2048 + k] = w.x; Wl[(4 * p4 + 1) * 2048 + k] = w.y; Wl[(4 * p4 + 2) * 2048 + k] = w.z; Wl[(4 * p4 + 3) * 2048 + k] = w.w; } }
    }
    if (MODE == 0) {
#pragma unroll
        for (int i = 0; i < 4; ++i) { const int k = tid + 512 * i;
#pragma unroll
            for (int p4 = 0; p4 < 4; ++p4) { const f32x4 w = *(const f32x4*)(Wp + (size_t)k * ldw + 4 * p4);
                *(LAS bf16_t*)(Wt + (4 * p4 + 0) * NP_PITCH + 2 * k) = f2bf(w.x); *(LAS bf16_t*)(Wt + (4 * p4 + 1) * NP_PITCH + 2 * k) = f2bf(w.y);
                *(LAS bf16_t*)(Wt + (4 * p4 + 2) * NP_PITCH + 2 * k) = f2bf(w.z); *(LAS bf16_t*)(Wt + (4 * p4 + 3) * NP_PITCH + 2 * k) = f2bf(w.w); } }
    }
    f32x4 gv[8];
#pragma unroll
    for (int j = 0; j < 8; ++j) gv[j] = *(const f32x4*)(gain + 4 * lane + 256 * j);
#pragma unroll 1
    for (int rb = blockIdx.x; rb < T / 64; rb += G) {
        if (MODE == 2) { if (tid < 8) cnt[tid] = 0; }
        __syncthreads();
        u32x2 rawb[8]; f32x4 rawf[8];
        { const int lr0 = MODE == 0 ? 2 * wave : 8 * wave; const int row0 = 64 * rb + lr0;
#pragma unroll
            for (int j = 0; j < 8; ++j) {
                if (INBF) rawb[j] = ((const u32x2*)((const bf16_t*)xin + (size_t)row0 * DM) + lane)[64 * j];
                else rawf[j] = ((const f32x4*)((const float*)xin + (size_t)row0 * DM) + lane)[64 * j]; } }
#pragma unroll 1
        for (int r = 0; r < 8; ++r) {
            const int lrow = MODE == 0 ? 16 * (r >> 1) + 2 * wave + (r & 1) : 8 * wave + r;
            const int row = 64 * rb + lrow;
            f32x4 v[8]; float ss = 0.f;
#pragma unroll
            for (int j = 0; j < 8; ++j) {
                if (INBF) { const u32x2 q = (u32x2){rawb[j].x, rawb[j].y}; v[j] = (f32x4){bf_lo(q.x), bf_hi(q.x), bf_lo(q.y), bf_hi(q.y)}; }
                else v[j] = rawf[j];
                ss += (v[j].x * v[j].x + v[j].y * v[j].y) + (v[j].z * v[j].z + v[j].w * v[j].w); }
            { const int rn = r + 1 < 8 ? r + 1 : r;
                const int lrn = MODE == 0 ? 16 * (rn >> 1) + 2 * wave + (rn & 1) : 8 * wave + rn; const int rown = 64 * rb + lrn;
#pragma unroll
                for (int j = 0; j < 8; ++j) {
                    if (INBF) rawb[j] = ((const u32x2*)((const bf16_t*)xin + (size_t)rown * DM) + lane)[64 * j];
                    else rawf[j] = ((const f32x4*)((const float*)xin + (size_t)rown * DM) + lane)[64 * j]; } }
            const float rstd = rsqrtf(wave_sum(ss) * (1.0f / DM) + EPSF);
            u32x2* ho = TILE_H ? (u32x2*)(H + ((size_t)(row >> 8) * 32 + (lane >> 4)) * 16384 + (size_t)(row & 255) * 64 + 4 * (lane & 15)) : (u32x2*)(H + (size_t)row * DM) + lane;
            constexpr int HJ = TILE_H ? 4 * 16384 / 4 : 64;
#pragma unroll
            for (int j = 0; j < 8; ++j) { v[j] = v[j] * rstd * gv[j];
                if (OUT8) { int w = 0; w = __builtin_amdgcn_cvt_pk_fp8_f32(f8cl(4.f * v[j].x), f8cl(4.f * v[j].y), w, false); w = __builtin_amdgcn_cvt_pk_fp8_f32(f8cl(4.f * v[j].z), f8cl(4.f * v[j].w), w, true);
                    ((unsigned*)((unsigned char*)H + (size_t)row * DM))[lane + 64 * j] = (unsigned)w; }
                else { u32x2 o; o.x = pk_bf16(v[j].x, v[j].y); o.y = pk_bf16(v[j].z, v[j].w); ho[HJ * j] = o;
                    if (MODE == 0) *(LAS u32x2*)(Ht + (lrow & 15) * NP_PITCH + (4 * lane + 256 * j) * 2) = o; } }
            if (MODE == 0 && (r & 1)) {
                __syncthreads();
                f32x4 acc = (f32x4){0.f, 0.f, 0.f, 0.f};
#pragma unroll
                for (int q = 0; q < 8; ++q) { const int ks = 8 * wave + q;
                    const bf16x8 a = *(const LAS bf16x8*)(Ht + (lane & 15) * NP_PITCH + (32 * ks + 8 * (lane >> 4)) * 2);
                    const bf16x8 b = *(const LAS bf16x8*)(Wt + (lane & 15) * NP_PITCH + (32 * ks + 8 * (lane >> 4)) * 2);
                    acc = mma16(a, b, acc); }
#pragma unroll
                for (int i = 0; i < 4; ++i) part[wave * 256 + (4 * (lane >> 4) + i) * 16 + (lane & 15)] = acc[i];
                __syncthreads();
                if (tid < 256) { float s = 0.f;
#pragma unroll
                    for (int w = 0; w < 8; ++w) s += part[w * 256 + tid];
                    glr[(size_t)(64 * rb + 16 * (r >> 1) + (tid >> 4)) * 16 + (tid & 15)] = s; }
            }
            if (MODE == 2) {
                float pr[8];
#pragma unroll
                for (int p = 0; p < 8; ++p) { float s = 0.f;
#pragma unroll
                    for (int j = 0; j < 8; ++j) { const f32x4 w = *(const LAS f32x4*)(Wl + p * 2048 + 4 * lane + 256 * j); s += (v[j].x * w.x + v[j].y * w.y) + (v[j].z * w.z + v[j].w * w.w); }
                    pr[p] = s; }
                float q4[4], q2[2], q1;
#pragma unroll
                for (int e = 0; e < 4; ++e) { const bool hi = (lane & 32) != 0; const float snd = hi ? pr[e] : pr[e + 4], kp = hi ? pr[e + 4] : pr[e]; q4[e] = kp + __shfl_xor(snd, 32); }
#pragma unroll
                for (int e = 0; e < 2; ++e) { const bool hi = (lane & 16) != 0; const float snd = hi ? q4[e] : q4[e + 2], kp = hi ? q4[e + 2] : q4[e]; q2[e] = kp + __shfl_xor(snd, 16); }
                { const bool hi = (lane & 8) != 0; const float snd = hi ? q2[0] : q2[1], kp = hi ? q2[1] : q2[0]; q1 = kp + __shfl_xor(snd, 8); }
                q1 += __shfl_xor(q1, 4); q1 += __shfl_xor(q1, 2); q1 += __shfl_xor(q1, 1);
                float lg[8];
#pragma unroll
                for (int e = 0; e < 8; ++e) lg[e] = __int_as_float(__builtin_amdgcn_readlane(__float_as_int(q1), 8 * e));
                int i0 = 0; float v0 = lg[0];
#pragma unroll
                for (int e = 1; e < 8; ++e) if (lg[e] > v0) { v0 = lg[e]; i0 = e; }
                int i1 = 0; float v1 = -3.4e38f;
#pragma unroll
                for (int e = 0; e < 8; ++e) if (e != i0 && lg[e] > v1) { v1 = lg[e]; i1 = e; }
                if (lane == 0) { const float e1 = __expf(v1 - v0), inv = 1.0f / (1.0f + e1);
                    topi[2 * row] = i0; topi[2 * row + 1] = i1; topw[2 * row] = inv; topw[2 * row + 1] = e1 * inv;
                    __hip_atomic_fetch_add(cnt + i0, 1, __ATOMIC_RELAXED, __HIP_MEMORY_SCOPE_WORKGROUP); __hip_atomic_fetch_add(cnt + i1, 1, __ATOMIC_RELAXED, __HIP_MEMORY_SCOPE_WORKGROUP); }
            }
        }
        if (MODE == 2) { __syncthreads(); if (tid < 8) hist[rb * 8 + tid] = cnt[tid]; }
    }
}
template <int W> __device__ __forceinline__ void pool_d_item(const bf16_t* Z, bf16_t* DP, int t, int c) {
    float s[8];
#pragma unroll
    for (int e = 0; e < 8; ++e) s[e] = 0.f;
    u32x4 q[W];
#pragma unroll
    for (int j = 0; j < W; ++j) { const int tt = t - j; q[j] = tt >= 0 ? *(const u32x4*)(Z + (size_t)tt * 4096 + c) : (u32x4){0u, 0u, 0u, 0u}; }
#pragma unroll
    for (int j = 0; j < W; ++j) { s[0] += bf_lo(q[j].x); s[1] += bf_hi(q[j].x); s[2] += bf_lo(q[j].y); s[3] += bf_hi(q[j].y); s[4] += bf_lo(q[j].z); s[5] += bf_hi(q[j].z); s[6] += bf_lo(q[j].w); s[7] += bf_hi(q[j].w); }
    const int cnt = (t + 1) < W ? (t + 1) : W; const float inv = 1.0f / (float)cnt;
    u32x4 o;
    o.x = pk_bf16(s[0] * inv - bf_lo(q[0].x), s[1] * inv - bf_hi(q[0].x)); o.y = pk_bf16(s[2] * inv - bf_lo(q[0].y), s[3] * inv - bf_hi(q[0].y));
    o.z = pk_bf16(s[4] * inv - bf_lo(q[0].z), s[5] * inv - bf_hi(q[0].z)); o.w = pk_bf16(s[6] * inv - bf_lo(q[0].w), s[7] * inv - bf_hi(q[0].w));
    *(u32x4*)(DP + (size_t)t * 1024 + c) = o;
}
__device__ __forceinline__ void pool_d_phase(const bf16_t* Z, bf16_t* DP, int tid, int G) {
#pragma unroll 1
    for (int item = blockIdx.x * NTHR + tid; item < T * 128; item += G * NTHR) {
        const int g = item / (T * 32), r = item % (T * 32), t = r >> 5, c = g * 256 + (r & 31) * 8;
        if (g == 0) pool_d_item<2>(Z, DP, t, c); else if (g == 1) pool_d_item<4>(Z, DP, t, c); else if (g == 2) pool_d_item<8>(Z, DP, t, c); else pool_d_item<16>(Z, DP, t, c);
    }
}

constexpr int G1_LR = 0, G1_EB = 4096, G1_KD = 6144, KD_PITCH = 1040, G1_V = G1_KD + 64 * KD_PITCH, V_PITCH = 528;
__device__ __forceinline__ void gla_state_phase(LAS unsigned char* lds, bf16_t* Z, const float* GLR, const float* wgu, const float* bgate, bf16_t* CS, float* DEC,
                                                int tid, int lane, int wave, int G) {
    LAS float* lr = (LAS float*)(lds + G1_LR);
    LAS float* eb = (LAS float*)(lds + G1_EB);
    const unsigned kd_a = (unsigned)(size_t)(lds + G1_KD), v_a = (unsigned)(size_t)(lds + G1_V);
    const int g4 = lane >> 4, q4 = (lane & 15) >> 2, p4 = lane & 3;
    float W[16];
#pragma unroll
    for (int r = 0; r < 16; ++r) W[r] = wgu[r * 512 + tid];
    const float bg = bgate[tid];
#pragma unroll 1
    for (int n = blockIdx.x; n < T / 64; n += G) {
        __syncthreads();
        if (tid < 256) *(LAS f32x4*)(lr + 4 * tid) = *(const f32x4*)(GLR + (size_t)n * 1024 + 4 * tid);
#pragma unroll
        for (int i = 0; i < 8; ++i) { const int idx = tid + 512 * i, c = idx >> 6, ch = idx & 63;
            *(LAS u32x4*)(lds + G1_KD + c * KD_PITCH + ch * 16) = *(const u32x4*)(Z + (size_t)(64 * n + c) * 4096 + 1536 + 8 * ch); }
        __syncthreads();
        float bc = 0.f;
        bf16_t* zq = Z + (size_t)(64 * n) * 4096 + 1024 + tid;
#pragma unroll 1
        for (int c0 = 0; c0 < 64; c0 += 16) {
            bf16_t qv[16];
#pragma unroll
            for (int i = 0; i < 16; ++i) qv[i] = zq[(size_t)(c0 + i) * 4096];
#pragma unroll
            for (int i = 0; i < 16; ++i) { const int c = c0 + i; float s = bg;
#pragma unroll
                for (int r4 = 0; r4 < 4; ++r4) { const f32x4 a = *(const LAS f32x4*)(lr + c * 16 + 4 * r4); s += (a.x * W[4 * r4] + a.y * W[4 * r4 + 1]) + (a.z * W[4 * r4 + 2] + a.w * W[4 * r4 + 3]); }
                const float ls = fminf(s, 0.f) - __logf(1.0f + __expf(-fabsf(s)));
                bc += ls * (1.0f / 16.0f);
                const float eq = __expf(bc);
                zq[(size_t)c * 4096] = f2bf(bf2f(qv[i]) * 0.08838834764831845f * eq);
                LAS bf16_t* kp = (LAS bf16_t*)(lds + G1_KD + c * KD_PITCH + 2 * tid);
                *kp = f2bf(bf2f(*kp) * __builtin_amdgcn_rcpf(eq)); }
        }
        { const float e = __expf(bc); eb[tid] = e; DEC[(size_t)n * 512 + tid] = e; }
        __syncthreads();
#pragma unroll
        for (int i = 0; i < 8; ++i) { const int idx = tid + 512 * i, c = idx >> 6, ch = idx & 63;
            *(u32x4*)(Z + (size_t)(64 * n + c) * 4096 + 1536 + 8 * ch) = *(const LAS u32x4*)(lds + G1_KD + c * KD_PITCH + ch * 16); }
#pragma unroll 1
        for (int h = 0; h < 4; ++h) {
            if (h) __syncthreads();
#pragma unroll
            for (int i = 0; i < 4; ++i) { const int idx = tid + 512 * i, c = idx >> 5, ch = idx & 31;
                *(LAS u32x4*)(lds + G1_V + c * V_PITCH + ch * 16) = *(const u32x4*)(Z + (size_t)(64 * n + c) * 4096 + 2048 + h * 256 + 8 * ch); }
            __syncthreads();
            f32x4 acc[8][2];
#pragma unroll
            for (int mb = 0; mb < 8; ++mb) { acc[mb][0] = (f32x4){0.f, 0.f, 0.f, 0.f}; acc[mb][1] = (f32x4){0.f, 0.f, 0.f, 0.f}; }
#pragma unroll
            for (int ks = 0; ks < 2; ++ks) {
                bf16x8 bfr[2];
#pragma unroll
                for (int nb = 0; nb < 2; ++nb) { const unsigned a0 = v_a + (32 * ks + 8 * g4 + q4) * V_PITCH + (32 * wave + 16 * nb + 4 * p4) * 2; bfr[nb] = tr_frag(a0, a0 + 4 * V_PITCH); }
#pragma unroll
                for (int mb = 0; mb < 8; ++mb) { const unsigned a0 = kd_a + (32 * ks + 8 * g4 + q4) * KD_PITCH + (128 * h + 16 * mb + 4 * p4) * 2; const bf16x8 af = tr_frag(a0, a0 + 4 * KD_PITCH);
                    acc[mb][0] = mma16(af, bfr[0], acc[mb][0]); acc[mb][1] = mma16(af, bfr[1], acc[mb][1]); }
            }
            bf16_t* cs = CS + ((size_t)(n * 4 + h) * 256) * 128;
#pragma unroll
            for (int mb = 0; mb < 8; ++mb) { const f32x4 e4 = *(const LAS f32x4*)(eb + 128 * h + 16 * mb + 4 * g4);
#pragma unroll
                for (int nb = 0; nb < 2; ++nb) { const f32x4 v = acc[mb][nb] * e4; u32x2 w; w.x = pk_bf16(v[0], v[1]); w.y = pk_bf16(v[2], v[3]);
                    *(u32x2*)(cs + (size_t)(32 * wave + 16 * nb + (lane & 15)) * 128 + 16 * mb + 4 * g4) = w; } }
        }
    }
}

__device__ __forceinline__ void gla_scan_phase(const bf16_t* CS, const float* DEC, bf16_t* SP, int tid, int G) {
#pragma unroll 1
    for (int e = blockIdx.x * NTHR + tid; e < 4 * 256 * 128; e += G * NTHR) {
        const int h = e >> 15, k = e & 127;
        float S = 0.f;
        const bf16_t* cp = CS + e; const float* dp = DEC + h * 128 + k; bf16_t* sp = SP + e;
        bf16_t c0[16], c1[16]; float d0[16], d1[16];
#pragma unroll
        for (int i = 0; i < 16; ++i) { c0[i] = cp[(size_t)i * 131072]; d0[i] = dp[(size_t)i * 512]; }
#pragma unroll 1
        for (int n0 = 0; n0 < 256; n0 += 32) {
#pragma unroll
            for (int i = 0; i < 16; ++i) { c1[i] = cp[(size_t)(n0 + 16 + i) * 131072]; d1[i] = dp[(size_t)(n0 + 16 + i) * 512]; }
#pragma unroll
            for (int i = 0; i < 16; ++i) { sp[(size_t)(n0 + i) * 131072] = f2bf(S); S = fmaf(d0[i], S, bf2f(c0[i])); }
            if (n0 + 32 < 256) {
#pragma unroll
                for (int i = 0; i < 16; ++i) { c0[i] = cp[(size_t)(n0 + 32 + i) * 131072]; d0[i] = dp[(size_t)(n0 + 32 + i) * 512]; } }
#pragma unroll
            for (int i = 0; i < 16; ++i) { sp[(size_t)(n0 + 16 + i) * 131072] = f2bf(S); S = fmaf(d1[i], S, bf2f(c1[i])); }
        }
    }
}

constexpr int G3_QD = 0, QK_PITCH = 272, G3_KD = 64 * QK_PITCH, G3_V = 2 * 64 * QK_PITCH, G3_ATT = G3_V + 64 * V_PITCH, ATT_PITCH = 144,
              G3_SSQ = G3_ATT + 64 * ATT_PITCH, G3_RSTD = G3_SSQ + 2048, G3_STG = 0, STG_PITCH = 260;
static_assert(64 * STG_PITCH * 4 <= G3_ATT, "o staging aliases the q/k/v images only");
__device__ __forceinline__ void gla_out_phase(LAS unsigned char* lds, const bf16_t* Z, const bf16_t* SP, const float* gnorm, bf16_t* MIX, int tid, int lane, int wave, int G) {
    const unsigned v_a = (unsigned)(size_t)(lds + G3_V);
    const int g4 = lane >> 4, l15 = lane & 15, q4 = l15 >> 2, p4 = lane & 3;
    LAS float* ssq = (LAS float*)(lds + G3_SSQ); LAS float* rstd = (LAS float*)(lds + G3_RSTD); LAS float* stg = (LAS float*)(lds + G3_STG);
#pragma unroll 1
    for (int n = blockIdx.x; n < T / 64; n += G) {
        u32x4 nq[2], nk[2], nv[4], nr[4]; bf16x8 nsp[2][4];
#define G3_REQUEST(hh) do { \
            _Pragma("unroll") for (int i = 0; i < 2; ++i) { const int idx = tid + 512 * i, row = idx >> 4, ch = idx & 15; const bf16_t* zr = Z + (size_t)(64 * n + row) * 4096 + (hh) * 128 + 8 * ch; \
                nq[i] = *(const u32x4*)(zr + 1024); nk[i] = *(const u32x4*)(zr + 1536); } \
            _Pragma("unroll") for (int i = 0; i < 4; ++i) { const int idx = tid + 512 * i, c = idx >> 5, ch = idx & 31; nv[i] = *(const u32x4*)(Z + (size_t)(64 * n + c) * 4096 + 2048 + (hh) * 256 + 8 * ch); } \
            _Pragma("unroll") for (int i = 0; i < 4; ++i) { const int item = tid + 512 * i, row = item >> 5, c8 = (item & 31) * 8; nr[i] = *(const u32x4*)(Z + (size_t)(64 * n + row) * 4096 + 3072 + (hh) * 256 + c8); } \
            { const bf16_t* spb = SP + ((size_t)(n * 4 + (hh)) * 256) * 128; \
              _Pragma("unroll") for (int nb = 0; nb < 2; ++nb) _Pragma("unroll") for (int ks = 0; ks < 4; ++ks) nsp[nb][ks] = *(const bf16x8*)(spb + (size_t)(32 * wave + 16 * nb + l15) * 128 + 32 * ks + 8 * g4); } } while (0)
        G3_REQUEST(0);
#pragma unroll 1
        for (int h = 0; h < 4; ++h) {
            __syncthreads();
#pragma unroll
            for (int i = 0; i < 2; ++i) { const int idx = tid + 512 * i, row = idx >> 4, ch = idx & 15;
                *(LAS u32x4*)(lds + G3_QD + row * QK_PITCH + ch * 16) = nq[i]; *(LAS u32x4*)(lds + G3_KD + row * QK_PITCH + ch * 16) = nk[i]; }
#pragma unroll
            for (int i = 0; i < 4; ++i) { const int idx = tid + 512 * i, c = idx >> 5, ch = idx & 31; *(LAS u32x4*)(lds + G3_V + c * V_PITCH + ch * 16) = nv[i]; }
            u32x4 rpre[4]; bf16x8 sp[2][4];
#pragma unroll
            for (int i = 0; i < 4; ++i) rpre[i] = nr[i];
#pragma unroll
            for (int nb = 0; nb < 2; ++nb)
#pragma unroll
                for (int ks = 0; ks < 4; ++ks) sp[nb][ks] = nsp[nb][ks];
            { const int hn = h < 3 ? h + 1 : 3; G3_REQUEST(hn); }
            __syncthreads();
            f32x4 acc[4][2];
#pragma unroll
            for (int mb = 0; mb < 4; ++mb) { acc[mb][0] = (f32x4){0.f, 0.f, 0.f, 0.f}; acc[mb][1] = (f32x4){0.f, 0.f, 0.f, 0.f}; }
#pragma unroll
            for (int ks = 0; ks < 4; ++ks)
#pragma unroll
                for (int mb = 0; mb < 4; ++mb) { const bf16x8 a = *(const LAS bf16x8*)(lds + G3_QD + (16 * mb + l15) * QK_PITCH + (32 * ks + 8 * g4) * 2);
                    acc[mb][0] = mma16(a, sp[0][ks], acc[mb][0]); acc[mb][1] = mma16(a, sp[1][ks], acc[mb][1]); }
            { const int jb = wave >> 1;
#pragma unroll
                for (int ib2 = 0; ib2 < 2; ++ib2) { const int ib = 2 * (wave & 1) + ib2; f32x4 at = (f32x4){0.f, 0.f, 0.f, 0.f};
                    if (jb <= ib) {
#pragma unroll
                        for (int ks = 0; ks < 4; ++ks) { const bf16x8 a = *(const LAS bf16x8*)(lds + G3_KD + (16 * jb + l15) * QK_PITCH + (32 * ks + 8 * g4) * 2);
                            const bf16x8 b = *(const LAS bf16x8*)(lds + G3_QD + (16 * ib + l15) * QK_PITCH + (32 * ks + 8 * g4) * 2); at = mma16(a, b, at); } }
                    const int i = 16 * ib + l15, j0 = 16 * jb + 4 * g4;
                    u32x2 w; w.x = pk_bf16(j0 + 0 <= i ? at[0] : 0.f, j0 + 1 <= i ? at[1] : 0.f); w.y = pk_bf16(j0 + 2 <= i ? at[2] : 0.f, j0 + 3 <= i ? at[3] : 0.f);
                    *(LAS u32x2*)(lds + G3_ATT + i * ATT_PITCH + j0 * 2) = w; } }
            __syncthreads();
#pragma unroll
            for (int ks = 0; ks < 2; ++ks) {
                bf16x8 bfr[2];
#pragma unroll
                for (int nb = 0; nb < 2; ++nb) { const unsigned a0 = v_a + (32 * ks + 8 * g4 + q4) * V_PITCH + (32 * wave + 16 * nb + 4 * p4) * 2; bfr[nb] = tr_frag(a0, a0 + 4 * V_PITCH); }
#pragma unroll
                for (int mb = 0; mb < 4; ++mb) { const bf16x8 a = *(const LAS bf16x8*)(lds + G3_ATT + (16 * mb + l15) * ATT_PITCH + (32 * ks + 8 * g4) * 2);
                    acc[mb][0] = mma16(a, bfr[0], acc[mb][0]); acc[mb][1] = mma16(a, bfr[1], acc[mb][1]); }
            }
#pragma unroll
            for (int mb = 0; mb < 4; ++mb)
#pragma unroll
                for (int r = 0; r < 4; ++r) { float p = acc[mb][0][r] * acc[mb][0][r] + acc[mb][1][r] * acc[mb][1][r];
                    p += __shfl_xor(p, 1); p += __shfl_xor(p, 2); p += __shfl_xor(p, 4); p += __shfl_xor(p, 8);
                    if (l15 == 0) ssq[wave * 64 + 16 * mb + 4 * g4 + r] = p; }
            __syncthreads();
            if (tid < 64) { float s = 0.f;
#pragma unroll
                for (int w = 0; w < 8; ++w) s += ssq[w * 64 + tid];
                rstd[tid] = rsqrtf(s * (1.0f / 256.0f) + EPSF); }
#pragma unroll
            for (int mb = 0; mb < 4; ++mb)
#pragma unroll
                for (int nb = 0; nb < 2; ++nb)
#pragma unroll
                    for (int r = 0; r < 4; ++r) stg[(16 * mb + 4 * g4 + r) * STG_PITCH + 32 * wave + 16 * nb + l15] = acc[mb][nb][r];
            __syncthreads();
#pragma unroll
            for (int i = 0; i < 4; ++i) { const int item = tid + 512 * i, row = item >> 5, c8 = (item & 31) * 8;
                const f32x4 o0 = *(const LAS f32x4*)(stg + row * STG_PITCH + c8), o1 = *(const LAS f32x4*)(stg + row * STG_PITCH + c8 + 4);
                const float rs = rstd[row];
                const f32x4 g0 = *(const f32x4*)(gnorm + h * 256 + c8), g1 = *(const f32x4*)(gnorm + h * 256 + c8 + 4);
                const u32x4 rr = rpre[i];
                u32x4 w;
                w.x = pk_bf16(o0.x * rs * g0.x * silu_f(bf_lo(rr.x)), o0.y * rs * g0.y * silu_f(bf_hi(rr.x)));
                w.y = pk_bf16(o0.z * rs * g0.z * silu_f(bf_lo(rr.y)), o0.w * rs * g0.w * silu_f(bf_hi(rr.y)));
                w.z = pk_bf16(o1.x * rs * g1.x * silu_f(bf_lo(rr.z)), o1.y * rs * g1.y * silu_f(bf_hi(rr.z)));
                w.w = pk_bf16(o1.z * rs * g1.z * silu_f(bf_lo(rr.w)), o1.w * rs * g1.w * silu_f(bf_hi(rr.w)));
                *(u32x4*)(MIX + (size_t)(64 * n + row) * 2048 + 1024 + h * 256 + c8) = w; }
        }
    }
}

#undef G3_REQUEST
__device__ __forceinline__ void assign_phase(LAS unsigned char* lds, const int* topi, const int* hist, int* tok_slot, int* blk_expert, int* nrb_out,
                                             const bf16_t* H, bf16_t* HS, int tid, int lane, int wave, int G) {
    LAS int* lh = (LAS int*)lds;
    LAS int* tot = (LAS int*)(lds + 8192);
    LAS int* myslot = (LAS int*)(lds + 8192 + 256);
#pragma unroll
    for (int i = 0; i < 4; ++i) lh[tid + 512 * i] = __hip_atomic_load(hist + tid + 512 * i, RLX_AGENT);
    __syncthreads();
#pragma unroll 1
    for (int rb = blockIdx.x; rb < T / 64; rb += G) {
        if (tid < 48) tot[tid] = 0;
        __syncthreads();
        { const int e = tid & 7, j = tid >> 3; int t_ = 0, b_ = 0;
#pragma unroll
            for (int q = 0; q < 4; ++q) { const int bb = 4 * j + q; const int c = lh[bb * 8 + e]; t_ += c; b_ += (bb < rb) ? c : 0; }
            __hip_atomic_fetch_add(tot + e, t_, __ATOMIC_RELAXED, __HIP_MEMORY_SCOPE_WORKGROUP); __hip_atomic_fetch_add(tot + 16 + e, b_, __ATOMIC_RELAXED, __HIP_MEMORY_SCOPE_WORKGROUP); }
        __syncthreads();
        if (tid == 0) { int run = 0;
#pragma unroll
            for (int e = 0; e < 8; ++e) { const int pd = ((tot[e] + 255) >> 8) << 8; tot[8 + e] = pd; tot[24 + e] = run + tot[16 + e]; run += pd; tot[40 + e] = run; }
            if (rb == 0) *nrb_out = run >> 8; }
        __syncthreads();
        if (rb == 0 && tid < NRB_MAX) { int e = 0;
#pragma unroll
            for (int q = 0; q < 8; ++q) e += (tot[40 + q] <= tid * 256) ? 1 : 0;
            blk_expert[tid] = e < 7 ? e : 7; }
        int my_e = 0, my_rank = 0;
        if (wave < 2) { my_e = topi[128 * rb + tid];
#pragma unroll
            for (int e = 0; e < 8; ++e) { const unsigned long long m = __ballot(my_e == e);
                if (my_e == e) my_rank = __popcll(m & ((1ull << lane) - 1ull));
                if (wave == 0 && lane == 0) tot[32 + e] = __popcll(m); } }
        __syncthreads();
        if (wave < 2) { const int s = tot[24 + my_e] + my_rank + (wave == 1 ? tot[32 + my_e] : 0); myslot[tid] = s; tok_slot[128 * rb + tid] = s; }
        __syncthreads();
#pragma unroll 1
        for (int i0 = wave; i0 < 128; i0 += 32) {
#if MOE_UP_FMT == 2
            u32x4 v[4][4]; int sl[4];
#pragma unroll
            for (int k = 0; k < 4; ++k) { const int i = i0 + 8 * k; const int t = 64 * rb + (i >> 1); sl[k] = myslot[i];
#pragma unroll
                for (int q = 0; q < 4; ++q) v[k][q] = ((const u32x4*)(H + (size_t)t * DM))[4 * lane + q]; }
#pragma unroll
            for (int k = 0; k < 4; ++k) { f32x16 lo, hi;
#pragma unroll
                for (int q = 0; q < 2; ++q) { const u32x4 x = v[k][q], y = v[k][2 + q];
                    lo[8 * q + 0] = bf_lo(x.x); lo[8 * q + 1] = bf_hi(x.x); lo[8 * q + 2] = bf_lo(x.y); lo[8 * q + 3] = bf_hi(x.y); lo[8 * q + 4] = bf_lo(x.z); lo[8 * q + 5] = bf_hi(x.z); lo[8 * q + 6] = bf_lo(x.w); lo[8 * q + 7] = bf_hi(x.w);
                    hi[8 * q + 0] = bf_lo(y.x); hi[8 * q + 1] = bf_hi(y.x); hi[8 * q + 2] = bf_lo(y.y); hi[8 * q + 3] = bf_hi(y.y); hi[8 * q + 4] = bf_lo(y.z); hi[8 * q + 5] = bf_hi(y.z); hi[8 * q + 6] = bf_lo(y.w); hi[8 * q + 7] = bf_hi(y.w); }
#pragma unroll
                for (int i = 0; i < 16; ++i) { lo[i] = __builtin_fminf(__builtin_fmaxf(2.f * lo[i], -7.5f), 7.5f); hi[i] = __builtin_fminf(__builtin_fmaxf(2.f * hi[i], -7.5f), 7.5f); }
                const u32x6 w = __builtin_amdgcn_cvt_scalef32_2xpk16_fp6_f32(lo, hi, 1.0f);
                unsigned char* d = (TILE_HS ? (unsigned char*)HS + (size_t)(sl[k] >> 8) * (16 * 32768) + (size_t)(sl[k] & 255) * 128 + (size_t)(lane >> 2) * 32768
                                            : (unsigned char*)HS + (size_t)sl[k] * DM + (lane >> 2) * 128) + 16 * (lane & 3);
                *(u32x4*)d = (u32x4){w[0], w[1], w[2], w[3]}; *(u32x4*)(d + 64) = (u32x4){w[4], w[5], 0u, 0u};     }
#else
            u32x4 v[4][4]; int sl[4];
#pragma unroll
            for (int k = 0; k < 4; ++k) { const int i = i0 + 8 * k; const int t = 64 * rb + (i >> 1); sl[k] = myslot[i];
#pragma unroll
                for (int q = 0; q < 4; ++q) { const int ch = lane + 64 * q;
                    v[k][q] = TILE_H ? *(const u32x4*)(H + ((size_t)(t >> 8) * 32 + (ch >> 3)) * 16384 + (size_t)(t & 255) * 64 + (ch & 7) * 8) : ((const u32x4*)(H + (size_t)t * DM))[ch]; } }
#pragma unroll
            for (int k = 0; k < 4; ++k) { unsigned char* drow = TILE_HS ? (unsigned char*)HS + (size_t)(sl[k] >> 8) * (16 * 32768) + (size_t)(sl[k] & 255) * 128 : (unsigned char*)HS + (size_t)sl[k] * DM;
#pragma unroll
                for (int q = 0; q < 4; ++q) { const u32x4 x = v[k][q]; int w0 = 0, w1 = 0;
                    w0 = __builtin_amdgcn_cvt_pk_fp8_f32(4.f * bf_lo(x.x), 4.f * bf_hi(x.x), w0, false); w0 = __builtin_amdgcn_cvt_pk_fp8_f32(4.f * bf_lo(x.y), 4.f * bf_hi(x.y), w0, true);
                    w1 = __builtin_amdgcn_cvt_pk_fp8_f32(4.f * bf_lo(x.z), 4.f * bf_hi(x.z), w1, false); w1 = __builtin_amdgcn_cvt_pk_fp8_f32(4.f * bf_lo(x.w), 4.f * bf_hi(x.w), w1, true);
                    const int ch = lane + 64 * q;
                    *(u32x2*)(TILE_HS ? drow + (size_t)(ch >> 4) * 32768 + 8 * (ch & 15) : drow + 8 * ch) = (u32x2){(unsigned)w0, (unsigned)w1}; } }
#endif
        }
        __syncthreads();
    }
}

__device__ __forceinline__ void final_phase(LAS unsigned char* lds, const bf16_t* XS, const bf16_t* Y, const float* P, const int* nrb_p, const int* tok_slot, const float* topw,
                                            const float* gain, float* out, int tid, int lane, int wave, int G) {
    LAS int* tbl = (LAS int*)lds;
    const int nrb = __builtin_amdgcn_readfirstlane(__hip_atomic_load(nrb_p, RLX_AGENT));
    int full, tail, sk; moe_tail_split(nrb, G, full, tail, sk);
    for (int i = tid; i < NRB_MAX * 8; i += NTHR) tbl[i] = -1;
    __syncthreads();
    if (tid < tail) { int pm, pn; pg8::unit_map((long)full + tid, nrb, 8, pm, pn); tbl[pm * 8 + pn] = tid; }
    __syncthreads();
    f32x4 gv[8];
#pragma unroll
    for (int j = 0; j < 8; ++j) gv[j] = *(const f32x4*)(gain + 4 * lane + 256 * j);
    const int rstep = G * 8, rfirst = blockIdx.x * 8 + wave;
    if (rfirst >= T) return;
    auto clampr = [&](int r) { return r < T ? r : rfirst; };
    int cs0 = tok_slot[2 * rfirst], cs1 = tok_slot[2 * rfirst + 1]; float cw0 = topw[2 * rfirst], cw1 = topw[2 * rfirst + 1];
    int r1 = clampr(rfirst + rstep);
    int ns0 = tok_slot[2 * r1], ns1 = tok_slot[2 * r1 + 1]; float nw0 = topw[2 * r1], nw1 = topw[2 * r1 + 1];
    u32x2 px[8], py0[8], py1[8];
#pragma unroll
    for (int j = 0; j < 8; ++j) { px[j] = ((const u32x2*)(XS + (size_t)rfirst * DM) + lane)[64 * j]; py0[j] = ((const u32x2*)(Y + (size_t)cs0 * DM) + lane)[64 * j]; py1[j] = ((const u32x2*)(Y + (size_t)cs1 * DM) + lane)[64 * j]; }
#pragma unroll 1
    for (int row = rfirst; row < T; row += rstep) {
        const int s0 = cs0, s1 = cs1; const float w0 = cw0, w1 = cw1;
        u32x2 cx[8], cy0[8], cy1[8];
#pragma unroll
        for (int j = 0; j < 8; ++j) { cx[j] = px[j]; cy0[j] = py0[j]; cy1[j] = py1[j]; }
        { const int rn = clampr(row + rstep), rnn = clampr(row + 2 * rstep);
#pragma unroll
            for (int j = 0; j < 8; ++j) { px[j] = ((const u32x2*)(XS + (size_t)rn * DM) + lane)[64 * j]; py0[j] = ((const u32x2*)(Y + (size_t)ns0 * DM) + lane)[64 * j]; py1[j] = ((const u32x2*)(Y + (size_t)ns1 * DM) + lane)[64 * j]; }
            cs0 = ns0; cs1 = ns1; cw0 = nw0; cw1 = nw1;
            ns0 = tok_slot[2 * rnn]; ns1 = tok_slot[2 * rnn + 1]; nw0 = topw[2 * rnn]; nw1 = topw[2 * rnn + 1]; }
        f32x4 v[8]; float ss = 0.f;
        int anyt = -1;
#pragma unroll
        for (int j = 0; j < 8; ++j) { const int t0 = tbl[(s0 >> 8) * 8 + j], t1 = tbl[(s1 >> 8) * 8 + j]; anyt = t0 > anyt ? t0 : anyt; anyt = t1 > anyt ? t1 : anyt; }
        if (anyt < 0) {
#pragma unroll
            for (int j = 0; j < 8; ++j) { const u32x2 q = cx[j], a = cy0[j], b = cy1[j];
                v[j].x = bf_lo(q.x) + w0 * bf_lo(a.x) + w1 * bf_lo(b.x); v[j].y = bf_hi(q.x) + w0 * bf_hi(a.x) + w1 * bf_hi(b.x);
                v[j].z = bf_lo(q.y) + w0 * bf_lo(a.y) + w1 * bf_lo(b.y); v[j].w = bf_hi(q.y) + w0 * bf_hi(a.y) + w1 * bf_hi(b.y); }
        } else {
#pragma unroll 1
            for (int j = 0; j < 8; ++j) { { const u32x2 q = ((const u32x2*)(XS + (size_t)row * DM) + lane)[64 * j]; v[j] = (f32x4){bf_lo(q.x), bf_hi(q.x), bf_lo(q.y), bf_hi(q.y)}; }
#pragma unroll 1
                for (int k = 0; k < 2; ++k) { const int sl = k ? s1 : s0; const float w = k ? w1 : w0;
                    const int t = tbl[(sl >> 8) * 8 + j]; f32x4 y;
                    if (t >= 0) { y = (f32x4){0.f, 0.f, 0.f, 0.f};
                        for (int q = 0; q < sk; ++q) y += *(const f32x4*)(P + ((size_t)(t * sk + q) * 256 + (sl & 255)) * 256 + 4 * lane); }
                    else { const u32x2 a = ((const u32x2*)(Y + (size_t)sl * DM) + lane)[64 * j]; y = (f32x4){bf_lo(a.x), bf_hi(a.x), bf_lo(a.y), bf_hi(a.y)}; }
                    v[j] += w * y; } }
        }
#pragma unroll
        for (int j = 0; j < 8; ++j) ss += (v[j].x * v[j].x + v[j].y * v[j].y) + (v[j].z * v[j].z + v[j].w * v[j].w);
        const float rstd = rsqrtf(wave_sum(ss) * (1.0f / DM) + EPSF);
        f32x4* orow = (f32x4*)(out + (size_t)row * DM) + lane;
#pragma unroll
        for (int j = 0; j < 8; ++j) orow[64 * j] = v[j] * rstd * gv[j];
    }
}
#ifdef NO_GEMM
#define GEMMCALL(...) ;
#else
#define GEMMCALL(...) __VA_ARGS__
#endif
#ifdef NO_CVT
#define CVTCALL(...) ;
#else
#define CVTCALL(...) __VA_ARGS__
#endif
#ifdef NO_NORM
#define NORMCALL(...) ;
#else
#define NORMCALL(...) __VA_ARGS__
#endif
#ifdef NO_PRE
#define PRECALL(...) ;
#else
#define PRECALL(...) __VA_ARGS__
#endif
#ifdef NO_SCAN
#define SCANCALL(...) ;
#else
#define SCANCALL(...) __VA_ARGS__
#endif
#ifdef NO_OUT
#define OUTCALL(...) ;
#else
#define OUTCALL(...) __VA_ARGS__
#endif
#ifdef NO_ASG
#define ASGCALL(...) ;
#else
#define ASGCALL(...) __VA_ARGS__
#endif
#ifdef NO_FIN
#define FINCALL(...) ;
#else
#define FINCALL(...) __VA_ARGS__
#endif
struct Args { const float* in[18]; float* out; unsigned char* ws; int ph_lo, ph_hi, cvt_items, pad; };

__global__ void __launch_bounds__(NTHR, 2) fwd(Args args) {
    extern __shared__ __attribute__((aligned(16))) unsigned char lds_raw[];
    LAS unsigned char* lds = (LAS unsigned char*)lds_raw;
    volatile LAS unsigned* MISC = (volatile LAS unsigned*)(lds + MISC_OFF);
    const int tid = threadIdx.x, lane = tid & 63, wave = __builtin_amdgcn_readfirstlane(tid >> 6);
    const int G = gridDim.x;
    unsigned char* ws = args.ws;
    unsigned* ctl = (unsigned*)(ws + WS_CTL);
    const int lo = args.ph_lo, hi = args.ph_hi;
    if (tid < 64) MISC[tid] = 0u;
    __syncthreads();
    XcdBarrier bar; bar.bar = ctl + CW_BAR; bar.x = 0; bar.st = nullptr;
    if (hi - lo > 1) bar = xcd_barrier_post(ctl + CW_BAR, MISC + 8);
#define IN(k) (lo <= (k) && (k) < hi)
#define SEAM(k) do { if (IN(k) && IN((k) + 1)) xcd_barrier(bar); } while (0)

    const float* x = args.in[0]; const float* mix_norm = args.in[1]; const float* w_in = args.in[2]; const float* pool_scale = args.in[4];
    const float* w_gate_up = args.in[5]; const float* b_gate = args.in[6]; const float* gla_norm = args.in[7]; const float* ffn_norm = args.in[9];
    const float* w_router = args.in[13]; const float* final_norm = args.in[17];
    bf16_t* H = (bf16_t*)(ws + WS_H); bf16_t* XS = (bf16_t*)(ws + WS_XS); float* GLR = (float*)(ws + WS_GLR);
    bf16_t* Z = (bf16_t*)(ws + WS_Z); bf16_t* DP = (bf16_t*)(ws + WS_DP); bf16_t* MIX = (bf16_t*)(ws + WS_MIX);
    bf16_t* CS = (bf16_t*)(ws + WS_CS); bf16_t* SP = (bf16_t*)(ws + WS_SP); float* DEC = (float*)(ws + WS_DEC);
    bf16_t* ACT = (bf16_t*)(ws + WS_ACT); bf16_t* HS = (bf16_t*)(ws + WS_HS); bf16_t* ACT2 = (bf16_t*)(ws + WS_ACT2); bf16_t* Y = (bf16_t*)(ws + WS_Y);
    int* topi = (int*)(ws + WS_ROUTE + RT_TOPI); float* topw = (float*)(ws + WS_ROUTE + RT_TOPW); int* tok_slot = (int*)(ws + WS_ROUTE + RT_TOKSLOT);
    int* hist = (int*)(ws + WS_ROUTE + RT_HIST); int* blk_expert = (int*)(ws + WS_ROUTE + RT_BLKE); int* nrb_p = (int*)(ws + WS_ROUTE + RT_NRB);

    if (IN(PH_PRO)) {
        CvtPtrs P; P.w_in = w_in; P.w_pool = args.in[3]; P.w_out = args.in[8]; P.dwg = args.in[10]; P.dwu = args.in[11]; P.dwd = args.in[12];
        P.ewg = args.in[14]; P.ewu = args.in[15]; P.ewd = args.in[16]; P.ws = ws;
        LAS float* scr = (LAS float*)(lds + wave * 17408);
        const int gw = blockIdx.x * 8 + wave, NGW = G * 8;
        CVTCALL({ const int nit = args.cvt_items;
            if (gw < nit) { f32x4 va[16], vb[16]; CvtJob ja = cvt_decode(P, gw), jb; cvt_load(ja, va, lane);
                _Pragma("unroll 1") for (int it = gw; it < nit; it += 2 * NGW) {
                    const int i2 = it + NGW, i3 = i2 + NGW;
                    jb = cvt_decode(P, i2 < nit ? i2 : nit - 1); cvt_load(jb, vb, lane);
                    cvt_finish(ja, va, scr, lane);
                    ja = cvt_decode(P, i3 < nit ? i3 : nit - 1); cvt_load(ja, va, lane);
                    if (i2 < nit) cvt_finish(jb, vb, scr, lane);
                } } })
        __syncthreads();
        NORMCALL(norm_phase<0, false, false>(lds, x, mix_norm, H, w_in + 3072, ZW, GLR, nullptr, nullptr, nullptr, tid, lane, wave, G);)
    }
    SEAM(PH_PRO);

    { constexpr int l = 0;
        const int pb = 1 + PH_PER_LAYER * l;
        if (IN(pb + PK_INPROJ)) {
            pg8::Gemm g{TILE_H ? 64 : 2048, 64, 2048, 0, 0, TILE_H ? 32768 : 128, 32768}; pg8::Order<false> S; S.init(T / 256, 16, G, (int)blockIdx.x);
            S.A = (const char*)H; S.B = (const char*)(ws + WS_WIN) + (size_t)l * 4096 * 2048 * 2; S.a_pm = (size_t)256 * 2048 * 2; S.a_pn = 0; S.b_pn = (size_t)256 * 2048 * 2; S.b_e = 0; S.blk_expert = nullptr;
            pg8::EpiBf16 E{Z, 4096, nullptr};
            GEMMCALL(pg8::gemm_phase<pg8::EpiBf16, pg8::Order<false>, GEMM_ALIGN, GEMM_SP2>(lds, g, S, E);)
        }
        SEAM(pb + PK_INPROJ);
        if (IN(pb + PK_PRE)) {
            PRECALL(pool_d_phase(Z, DP, tid, G);)
            PRECALL(gla_state_phase(lds, Z, GLR, w_gate_up + (size_t)l * 16 * 512, b_gate + l * 512, CS, DEC, tid, lane, wave, G);)
        }
        SEAM(pb + PK_PRE);
        if (IN(pb + PK_POOLSCAN)) {
            SCANCALL(gla_scan_phase(CS, DEC, SP, tid, G);)
            __syncthreads();
            pg8::Gemm g{1024, 64, 256, 0, 0, 128, 32768}; pg8::Order<false> S; S.init(T / 256, 4, G, (int)blockIdx.x);
            S.A = (const char*)DP; S.B = (const char*)(ws + WS_WPOOL) + (size_t)l * 4 * 65536 * 2; S.a_pm = (size_t)256 * 1024 * 2; S.a_pn = 256 * 2; S.b_pn = (size_t)65536 * 2; S.b_e = 0; S.blk_expert = nullptr;
            pg8::EpiBf16 E{MIX, 2048, pool_scale + l * 1024};
            GEMMCALL(pg8::gemm_phase<pg8::EpiBf16, pg8::Order<false>, GEMM_ALIGN, GEMM_SP2>(lds, g, S, E);)
        }
        SEAM(pb + PK_POOLSCAN);
        if (IN(pb + PK_GLAOUT)) OUTCALL(gla_out_phase(lds, Z, SP, gla_norm + l * 1024, MIX, tid, lane, wave, G);)
        SEAM(pb + PK_GLAOUT);
        if (IN(pb + PK_OUTPROJ)) {
            pg8::Gemm g{2048, 64, 2048, 0, 0, 128, 32768}; pg8::Order<false> S; S.init(T / 256, 8, G, (int)blockIdx.x);
            S.A = (const char*)MIX; S.B = (const char*)(ws + WS_WOUT) + (size_t)l * 2048 * 2048 * 2; S.a_pm = (size_t)256 * 2048 * 2; S.a_pn = 0; S.b_pn = (size_t)256 * 2048 * 2; S.b_e = 0; S.blk_expert = nullptr;
            pg8::EpiRes<l == 0> E{l == 0 ? (const void*)x : (const void*)XS, XS, 2048};
            GEMMCALL(pg8::gemm_phase<pg8::EpiRes<l == 0>, pg8::Order<false>, true, true>(lds, g, S, E);)
        }
        SEAM(pb + PK_OUTPROJ);
        if (IN(pb + PK_NORM2)) {
            if (l == 0) NORMCALL(norm_phase<1, DENSE_FP8 == 1>(lds, XS, ffn_norm, H, nullptr, 0, nullptr, nullptr, nullptr, nullptr, tid, lane, wave, G);)
            else NORMCALL(norm_phase<2>(lds, XS, ffn_norm + DM, H, w_router, 8, nullptr, topi, topw, hist, tid, lane, wave, G);)
        }
        SEAM(pb + PK_NORM2);
        if (l == 1) { if (IN(pb + PK_ASSIGN)) ASGCALL(assign_phase(lds, topi, hist, tok_slot, blk_expert, nrb_p, H, HS, tid, lane, wave, G);)
            SEAM(pb + PK_ASSIGN); }
        if (IN(pb + PK_UP)) {
            if (l == 0) {
#if DENSE_FP8 == 1
                pg8::Gemm g{1024, 64, 1024, 0, 0x7f7f7f77, 128, 32768}; pg8::Order<false> S; S.init(T / 256, 44, G, (int)blockIdx.x);
                S.A = (const char*)H; S.B = (const char*)(ws + WS_WGU); S.a_pm = (size_t)256 * 2048; S.a_pn = 0; S.b_pn = (size_t)256 * 2048; S.b_e = 0; S.blk_expert = nullptr;
                pg8::EpiSwigluF8 E{(unsigned char*)ACT, 44, 4.f};
                GEMMCALL(pg8::gemm_phase<pg8::EpiSwigluF8, pg8::Order<false>, GEMM_ALIGN, GEMM_SP2, 1>(lds, g, S, E);)
#else
                pg8::Gemm g{TILE_H ? 64 : 2048, 64, 2048, 0, 0, TILE_H ? 32768 : 128, 32768}; pg8::Order<false> S; S.init(T / 256, 44, G, (int)blockIdx.x);
                S.A = (const char*)H; S.B = (const char*)(ws + WS_WGU); S.a_pm = (size_t)256 * 2048 * 2; S.a_pn = 0; S.b_pn = (size_t)256 * 2048 * 2; S.b_e = 0; S.blk_expert = nullptr;
#if DENSE_FP8 == 2
                pg8::EpiSwigluF8S E{(unsigned char*)ACT, 44, 4.f};
#if defined(KPROBE) && KPROBE_PHASE == 8
                if (args.pad) { GEMMCALL(pg8::gemm_phase<pg8::EpiSwigluF8S, pg8::Order<false>, true, GEMM_SP2, 0, KPROBE>(lds, g, S, E);) } else
#endif
                GEMMCALL(pg8::gemm_phase<pg8::EpiSwigluF8S, pg8::Order<false>, true, GEMM_SP2>(lds, g, S, E);)
#else
                pg8::EpiSwiglu E{ACT, TILE_ACT ? 88 : -11264};
                GEMMCALL(pg8::gemm_phase<pg8::EpiSwiglu, pg8::Order<false>, GEMM_ALIGN, GEMM_SP2>(lds, g, S, E);)
#endif
#endif
            } else {
                const int nrb = __builtin_amdgcn_readfirstlane(__hip_atomic_load(nrb_p, RLX_AGENT));
                pg8::Gemm g{TILE_HS ? 64 : 1024, TILE_EWGU ? 64 : 1024, 1024, 0, MOE_UP_FMT == 2 ? 0x7f7f7f78 : 0x7f7f7f77, TILE_HS ? 32768 : 128, TILE_EWGU ? 32768 : 128}; pg8::Order<true> S; S.init(nrb, 56, G, (int)blockIdx.x);
                S.A = (const char*)HS; S.B = (const char*)(ws + WS_EWGU); S.a_pm = (size_t)256 * 2048; S.a_pn = 0; S.b_pn = (size_t)256 * 2048; S.b_e = (size_t)14336 * 2048; S.blk_expert = blk_expert;
                pg8::EpiSwigluF8S E{(unsigned char*)ACT2, 56, 4.f};
                GEMMCALL(pg8::gemm_phase<pg8::EpiSwigluF8S, pg8::Order<true>, true, GEMM_SP2, MOE_UP_FMT>(lds, g, S, E);)
            }
        }
        SEAM(pb + PK_UP);
        if (IN(pb + PK_DOWN)) {
            if (l == 0) {
#if DENSE_FP8
                pg8::Gemm g{64, 64, 2816, 0, 0x7f7f7f76, 32768, 32768}; pg8::Order<false> S; S.init(T / 256, 8, G, (int)blockIdx.x);
                S.A = (const char*)ACT; S.B = (const char*)(ws + WS_WD); S.a_pm = (size_t)256 * 5632; S.a_pn = 0; S.b_pn = (size_t)256 * 5632; S.b_e = 0; S.blk_expert = nullptr;
                pg8::EpiRes<false> E{XS, XS, 2048};
                GEMMCALL(pg8::gemm_phase<pg8::EpiRes<false>, pg8::Order<false>, true, true, 1>(lds, g, S, E);)
#else
                pg8::Gemm g{TILE_ACT ? 64 : 5632, 64, 5632, 0, 0, TILE_ACT ? 32768 : 128, 32768}; pg8::Order<false> S; S.init(T / 256, 8, G, (int)blockIdx.x);
                S.A = (const char*)ACT; S.B = (const char*)(ws + WS_WD); S.a_pm = (size_t)256 * 5632 * 2; S.a_pn = 0; S.b_pn = (size_t)256 * 5632 * 2; S.b_e = 0; S.blk_expert = nullptr;
                pg8::EpiRes<false> E{XS, XS, 2048};
                GEMMCALL(pg8::gemm_phase<pg8::EpiRes<false>, pg8::Order<false>, true, true>(lds, g, S, E);)
#endif
            } else {
                const int nrb = __builtin_amdgcn_readfirstlane(__hip_atomic_load(nrb_p, RLX_AGENT));
                pg8::Gemm g{TILE_ACT2 ? 64 : 3584, 64, 3584, 0, 0x7f7f7f76, TILE_ACT2 ? 32768 : 128, 32768}; pg8::Order<true> S; S.init(nrb, 8, G, (int)blockIdx.x);
                S.A = (const char*)ACT2; S.B = (const char*)(ws + WS_EWD); S.a_pm = (size_t)256 * 7168; S.a_pn = 0; S.b_pn = (size_t)256 * 7168; S.b_e = (size_t)2048 * 7168; S.blk_expert = blk_expert;
                int full, tail, sk; moe_tail_split(nrb, G, full, tail, sk); S.Lend = full;
                pg8::EpiBf16 E{Y, 2048, nullptr};
                GEMMCALL(pg8::gemm_phase<pg8::EpiBf16, pg8::Order<true>, GEMM_ALIGN, GEMM_SP2, 1>(lds, g, S, E);)
                if (sk > 0) {
                    const int kq = 3584 / sk;
                    pg8::Gemm g2{TILE_ACT2 ? 64 : 3584, 64, kq, 0, 0x7f7f7f76, TILE_ACT2 ? 32768 : 128, 32768}; pg8::TailOrder S2; S2.nM = nrb; S2.nN = 8; S2.c = (int)blockIdx.x; S2.full = full; S2.tail = tail; S2.s = sk; S2.ksliceA = TILE_ACT2 ? (size_t)(kq / 64) * 32768 : (size_t)kq * 2; S2.ksliceB = (size_t)(kq / 64) * 32768;
                    S2.A = (const char*)ACT2; S2.B = (const char*)(ws + WS_EWD); S2.a_pm = (size_t)256 * 7168; S2.b_pn = (size_t)256 * 7168; S2.b_e = (size_t)2048 * 7168; S2.blk_expert = blk_expert;
                    pg8::EpiPart E2{(float*)(ws + WS_PART)};
                    GEMMCALL(pg8::gemm_phase<pg8::EpiPart, pg8::TailOrder, false, GEMM_SP2, 1>(lds, g2, S2, E2);)
                }
            }
        }
        SEAM(pb + PK_DOWN);
        if (IN(pb + PK_TAIL)) {
            if (l == 0) NORMCALL(norm_phase<0>(lds, XS, mix_norm + DM, H, w_in + (size_t)DM * ZW + 3072, ZW, GLR, nullptr, nullptr, nullptr, tid, lane, wave, G);)
            else FINCALL(final_phase(lds, XS, Y, (const float*)(ws + WS_PART), nrb_p, tok_slot, topw, final_norm, args.out, tid, lane, wave, G);)
        }
        if (l == 0) SEAM(pb + PK_TAIL);
    }
    { constexpr int l = 1;
        const int pb = 1 + PH_PER_LAYER * l;
        if (IN(pb + PK_INPROJ)) {
            pg8::Gemm g{TILE_H ? 64 : 2048, 64, 2048, 0, 0, TILE_H ? 32768 : 128, 32768}; pg8::Order<false> S; S.init(T / 256, 16, G, (int)blockIdx.x);
            S.A = (const char*)H; S.B = (const char*)(ws + WS_WIN) + (size_t)l * 4096 * 2048 * 2; S.a_pm = (size_t)256 * 2048 * 2; S.a_pn = 0; S.b_pn = (size_t)256 * 2048 * 2; S.b_e = 0; S.blk_expert = nullptr;
            pg8::EpiBf16 E{Z, 4096, nullptr};
            GEMMCALL(pg8::gemm_phase<pg8::EpiBf16, pg8::Order<false>, GEMM_ALIGN, GEMM_SP2>(lds, g, S, E);)
        }
        SEAM(pb + PK_INPROJ);
        if (IN(pb + PK_PRE)) {
            PRECALL(pool_d_phase(Z, DP, tid, G);)
            PRECALL(gla_state_phase(lds, Z, GLR, w_gate_up + (size_t)l * 16 * 512, b_gate + l * 512, CS, DEC, tid, lane, wave, G);)
        }
        SEAM(pb + PK_PRE);
        if (IN(pb + PK_POOLSCAN)) {
            SCANCALL(gla_scan_phase(CS, DEC, SP, tid, G);)
            __syncthreads();
            pg8::Gemm g{1024, 64, 256, 0, 0, 128, 32768}; pg8::Order<false> S; S.init(T / 256, 4, G, (int)blockIdx.x);
            S.A = (const char*)DP; S.B = (const char*)(ws + WS_WPOOL) + (size_t)l * 4 * 65536 * 2; S.a_pm = (size_t)256 * 1024 * 2; S.a_pn = 256 * 2; S.b_pn = (size_t)65536 * 2; S.b_e = 0; S.blk_expert = nullptr;
            pg8::EpiBf16 E{MIX, 2048, pool_scale + l * 1024};
            GEMMCALL(pg8::gemm_phase<pg8::EpiBf16, pg8::Order<false>, GEMM_ALIGN, GEMM_SP2>(lds, g, S, E);)
        }
        SEAM(pb + PK_POOLSCAN);
        if (IN(pb + PK_GLAOUT)) OUTCALL(gla_out_phase(lds, Z, SP, gla_norm + l * 1024, MIX, tid, lane, wave, G);)
        SEAM(pb + PK_GLAOUT);
        if (IN(pb + PK_OUTPROJ)) {
            pg8::Gemm g{2048, 64, 2048, 0, 0, 128, 32768}; pg8::Order<false> S; S.init(T / 256, 8, G, (int)blockIdx.x);
            S.A = (const char*)MIX; S.B = (const char*)(ws + WS_WOUT) + (size_t)l * 2048 * 2048 * 2; S.a_pm = (size_t)256 * 2048 * 2; S.a_pn = 0; S.b_pn = (size_t)256 * 2048 * 2; S.b_e = 0; S.blk_expert = nullptr;
            pg8::EpiRes<l == 0> E{l == 0 ? (const void*)x : (const void*)XS, XS, 2048};
            GEMMCALL(pg8::gemm_phase<pg8::EpiRes<l == 0>, pg8::Order<false>, true, true>(lds, g, S, E);)
        }
        SEAM(pb + PK_OUTPROJ);
        if (IN(pb + PK_NORM2)) {
            if (l == 0) NORMCALL(norm_phase<1, DENSE_FP8 == 1>(lds, XS, ffn_norm, H, nullptr, 0, nullptr, nullptr, nullptr, nullptr, tid, lane, wave, G);)
            else NORMCALL(norm_phase<2>(lds, XS, ffn_norm + DM, H, w_router, 8, nullptr, topi, topw, hist, tid, lane, wave, G);)
        }
        SEAM(pb + PK_NORM2);
        if (l == 1) { if (IN(pb + PK_ASSIGN)) ASGCALL(assign_phase(lds, topi, hist, tok_slot, blk_expert, nrb_p, H, HS, tid, lane, wave, G);)
            SEAM(pb + PK_ASSIGN); }
        if (IN(pb + PK_UP)) {
            if (l == 0) {
#if DENSE_FP8 == 1
                pg8::Gemm g{1024, 64, 1024, 0, 0x7f7f7f77, 128, 32768}; pg8::Order<false> S; S.init(T / 256, 44, G, (int)blockIdx.x);
                S.A = (const char*)H; S.B = (const char*)(ws + WS_WGU); S.a_pm = (size_t)256 * 2048; S.a_pn = 0; S.b_pn = (size_t)256 * 2048; S.b_e = 0; S.blk_expert = nullptr;
                pg8::EpiSwigluF8 E{(unsigned char*)ACT, 44, 4.f};
                GEMMCALL(pg8::gemm_phase<pg8::EpiSwigluF8, pg8::Order<false>, GEMM_ALIGN, GEMM_SP2, 1>(lds, g, S, E);)
#else
                pg8::Gemm g{TILE_H ? 64 : 2048, 64, 2048, 0, 0, TILE_H ? 32768 : 128, 32768}; pg8::Order<false> S; S.init(T / 256, 44, G, (int)blockIdx.x);
                S.A = (const char*)H; S.B = (const char*)(ws + WS_WGU); S.a_pm = (size_t)256 * 2048 * 2; S.a_pn = 0; S.b_pn = (size_t)256 * 2048 * 2; S.b_e = 0; S.blk_expert = nullptr;
#if DENSE_FP8 == 2
                pg8::EpiSwigluF8S E{(unsigned char*)ACT, 44, 4.f};
                GEMMCALL(pg8::gemm_phase<pg8::EpiSwigluF8S, pg8::Order<false>, true, GEMM_SP2>(lds, g, S, E);)
#else
                pg8::EpiSwiglu E{ACT, TILE_ACT ? 88 : -11264};
                GEMMCALL(pg8::gemm_phase<pg8::EpiSwiglu, pg8::Order<false>, GEMM_ALIGN, GEMM_SP2>(lds, g, S, E);)
#endif
#endif
            } else {
                const int nrb = __builtin_amdgcn_readfirstlane(__hip_atomic_load(nrb_p, RLX_AGENT));
                pg8::Gemm g{TILE_HS ? 64 : 1024, TILE_EWGU ? 64 : 1024, 1024, 0, MOE_UP_FMT == 2 ? 0x7f7f7f78 : 0x7f7f7f77, TILE_HS ? 32768 : 128, TILE_EWGU ? 32768 : 128}; pg8::Order<true> S; S.init(nrb, 56, G, (int)blockIdx.x);
                S.A = (const char*)HS; S.B = (const char*)(ws + WS_EWGU); S.a_pm = (size_t)256 * 2048; S.a_pn = 0; S.b_pn = (size_t)256 * 2048; S.b_e = (size_t)14336 * 2048; S.blk_expert = blk_expert;
                pg8::EpiSwigluF8S E{(unsigned char*)ACT2, 56, 4.f};
#if defined(KPROBE) && KPROBE_PHASE == 18
                if (args.pad) { GEMMCALL(pg8::gemm_phase<pg8::EpiSwigluF8S, pg8::Order<true>, true, GEMM_SP2, MOE_UP_FMT, KPROBE>(lds, g, S, E);) } else
#endif
                GEMMCALL(pg8::gemm_phase<pg8::EpiSwigluF8S, pg8::Order<true>, true, GEMM_SP2, MOE_UP_FMT>(lds, g, S, E);)
            }
        }
        SEAM(pb + PK_UP);
        if (IN(pb + PK_DOWN)) {
            if (l == 0) {
#if DENSE_FP8
                pg8::Gemm g{64, 64, 2816, 0, 0x7f7f7f76, 32768, 32768}; pg8::Order<false> S; S.init(T / 256, 8, G, (int)blockIdx.x);
                S.A = (const char*)ACT; S.B = (const char*)(ws + WS_WD); S.a_pm = (size_t)256 * 5632; S.a_pn = 0; S.b_pn = (size_t)256 * 5632; S.b_e = 0; S.blk_expert = nullptr;
                pg8::EpiRes<false> E{XS, XS, 2048};
                GEMMCALL(pg8::gemm_phase<pg8::EpiRes<false>, pg8::Order<false>, true, true, 1>(lds, g, S, E);)
#else
                pg8::Gemm g{TILE_ACT ? 64 : 5632, 64, 5632, 0, 0, TILE_ACT ? 32768 : 128, 32768}; pg8::Order<false> S; S.init(T / 256, 8, G, (int)blockIdx.x);
                S.A = (const char*)ACT; S.B = (const char*)(ws + WS_WD); S.a_pm = (size_t)256 * 5632 * 2; S.a_pn = 0; S.b_pn = (size_t)256 * 5632 * 2; S.b_e = 0; S.blk_expert = nullptr;
                pg8::EpiRes<false> E{XS, XS, 2048};
                GEMMCALL(pg8::gemm_phase<pg8::EpiRes<false>, pg8::Order<false>, true, true>(lds, g, S, E);)
#endif
            } else {
                const int nrb = __builtin_amdgcn_readfirstlane(__hip_atomic_load(nrb_p, RLX_AGENT));
                pg8::Gemm g{TILE_ACT2 ? 64 : 3584, 64, 3584, 0, 0x7f7f7f76, TILE_ACT2 ? 32768 : 128, 32768}; pg8::Order<true> S; S.init(nrb, 8, G, (int)blockIdx.x);
                S.A = (const char*)ACT2; S.B = (const char*)(ws + WS_EWD); S.a_pm = (size_t)256 * 7168; S.a_pn = 0; S.b_pn = (size_t)256 * 7168; S.b_e = (size_t)2048 * 7168; S.blk_expert = blk_expert;
                int full, tail, sk; moe_tail_split(nrb, G, full, tail, sk); S.Lend = full;
                pg8::EpiBf16 E{Y, 2048, nullptr};
#if defined(KPROBE) && KPROBE_PHASE == 19
                if (args.pad) { GEMMCALL(pg8::gemm_phase<pg8::EpiBf16, pg8::Order<true>, GEMM_ALIGN, GEMM_SP2, 1, KPROBE>(lds, g, S, E);) } else
#endif
                GEMMCALL(pg8::gemm_phase<pg8::EpiBf16, pg8::Order<true>, GEMM_ALIGN, GEMM_SP2, 1>(lds, g, S, E);)
                if (sk > 0) {
                    const int kq = 3584 / sk;
                    pg8::Gemm g2{TILE_ACT2 ? 64 : 3584, 64, kq, 0, 0x7f7f7f76, TILE_ACT2 ? 32768 : 128, 32768}; pg8::TailOrder S2; S2.nM = nrb; S2.nN = 8; S2.c = (int)blockIdx.x; S2.full = full; S2.tail = tail; S2.s = sk; S2.ksliceA = TILE_ACT2 ? (size_t)(kq / 64) * 32768 : (size_t)kq * 2; S2.ksliceB = (size_t)(kq / 64) * 32768;
                    S2.A = (const char*)ACT2; S2.B = (const char*)(ws + WS_EWD); S2.a_pm = (size_t)256 * 7168; S2.b_pn = (size_t)256 * 7168; S2.b_e = (size_t)2048 * 7168; S2.blk_expert = blk_expert;
                    pg8::EpiPart E2{(float*)(ws + WS_PART)};
                    GEMMCALL(pg8::gemm_phase<pg8::EpiPart, pg8::TailOrder, false, GEMM_SP2, 1>(lds, g2, S2, E2);)
                }
            }
        }
        SEAM(pb + PK_DOWN);
        if (IN(pb + PK_TAIL)) {
            if (l == 0) NORMCALL(norm_phase<0>(lds, XS, mix_norm + DM, H, w_in + (size_t)DM * ZW + 3072, ZW, GLR, nullptr, nullptr, nullptr, tid, lane, wave, G);)
            else FINCALL(final_phase(lds, XS, Y, (const float*)(ws + WS_PART), nrb_p, tok_slot, topw, final_norm, args.out, tid, lane, wave, G);)
        }
        if (l == 0) SEAM(pb + PK_TAIL);
    }
#undef IN
#undef SEAM
}
}
#ifndef MK_MODE
#define MK_MODE 0
#endif
#ifndef DBG_CUT
#define DBG_CUT 0
#endif
namespace dbg {
using fz::bf16_t;
__global__ __launch_bounds__(256) void k_cvt_z(const bf16_t* Z, const float* GLR, float* z) {
    const size_t i = (size_t)blockIdx.x * 256 + threadIdx.x; if (i >= (size_t)T * ZW) return;
    const int t = (int)(i / ZW), c = (int)(i % ZW);
    float v;
    if (c < 3072) v = fz::bf2f(Z[(size_t)t * 4096 + c]); else if (c < 3088) v = GLR[(size_t)t * 16 + (c - 3072)]; else v = fz::bf2f(Z[(size_t)t * 4096 + c - 16]);
    z[i] = v;
}
__global__ __launch_bounds__(256) void k_cvt_bf(const bf16_t* in, float* out, size_t n) {
    const size_t i = (size_t)blockIdx.x * 256 + threadIdx.x; if (i < n) out[i] = fz::bf2f(in[i]);
}
}

static void launch_fused(const fz::Args& base, int lo, int hi, int grid, hipStream_t stream) {
    fz::Args a = base; a.ph_lo = lo; a.ph_hi = hi;
    hipLaunchKernelGGL(fz::fwd, dim3(grid), dim3(fz::NTHR), fz::LDS_BYTES, stream, a);
}

extern "C" void kernel_launch(void* const* d_in, const int* in_sizes, int n_in, void* d_out, int out_size, void* d_ws, size_t ws_size, hipStream_t stream) {
    static int grid = 0;
    if (grid == 0) {
        int dev = 0, cus = 0;
        if (hipGetDevice(&dev) != hipSuccess || hipDeviceGetAttribute(&cus, hipDeviceAttributeMultiprocessorCount, dev) != hipSuccess) { grid = -1; return; }
        if (hipFuncSetAttribute((const void*)fz::fwd, hipFuncAttributeMaxDynamicSharedMemorySize, fz::LDS_BYTES) != hipSuccess) { fprintf(stderr, "hipFuncSetAttribute failed\n"); grid = -1; return; }
        int per_cu = 0;
        if (hipOccupancyMaxActiveBlocksPerMultiprocessor(&per_cu, (const void*)fz::fwd, fz::NTHR, fz::LDS_BYTES) != hipSuccess || per_cu < 1) fprintf(stderr, "occupancy query: %d\n", per_cu);
        (void)hipGetLastError();
        grid = cus;
        if (ws_size < fz::WS_END) { fprintf(stderr, "workspace too small\n"); grid = -1; return; }
    }
    if (grid < 0) return;
    unsigned char* ws = (unsigned char*)d_ws;
    (void)hipMemsetAsync(ws + fz::WS_CTL + (size_t)fz::CW_BAR * 4, 0, 16384, stream);
    fz::Args a{};
    for (int i = 0; i < 18; ++i) a.in[i] = (const float*)d_in[i];
    a.out = (float*)d_out; a.ws = ws; a.cvt_items = fz::CI_TOTAL;
#if MK_MODE == 0
    launch_fused(a, 0, fz::NPH, grid, stream);
#elif MK_MODE == 1
    for (int p = 0; p < fz::NPH; ++p) { if (p == 1 + fz::PK_ASSIGN) continue;
#ifdef KPROBE
        if (p == KPROBE_PHASE) { fz::Args b = a; b.pad = 1; for (int rr = 0; rr < KPROBE_N; ++rr) launch_fused(b, p, p + 1, grid, stream); }
#endif
        launch_fused(a, p, p + 1, grid, stream);
#ifdef REP_HI
#ifndef REP_N
#define REP_N 1
#endif
        if (p == REP_HI) for (int rr = 0; rr < REP_N; ++rr) for (int q = REP_LO; q <= REP_HI; ++q) { if (q == 1 + fz::PK_ASSIGN) continue; launch_fused(a, q, q + 1, grid, stream); }
#endif
    }
#elif MK_MODE == 2
    {
        const int l = DBG_CUT / 10, kind = DBG_CUT % 10; const int pb = 1 + fz::PH_PER_LAYER * l;
        const int pcut = kind == 1 ? pb + 1 : kind == 2 ? pb + 4 : kind == 3 ? pb + 5 : kind == 4 ? pb + 6 : pb + 9;
        const int scut = kind == 1 ? 7 * l + 2 : kind == 2 ? 7 * l + 4 : kind == 3 ? 7 * l + 5 : kind == 4 ? 7 * l + 6 : 7 * l + 7;
        a.cvt_items = fz::CI_NONEXP;
        for (int p = 0; p < pcut; ++p) { if (p == 1 + fz::PK_ASSIGN) continue; launch_fused(a, p, p + 1, grid, stream); }
        ora::Bufs B = ora::make_bufs(ws + fz::WS_EWGU, (float*)(ws + fz::WS_XS));
        if (kind == 1) hipLaunchKernelGGL(dbg::k_cvt_z, dim3((unsigned)(((size_t)T * ZW + 255) / 256)), dim3(256), 0, stream, (const fz::bf16_t*)(ws + fz::WS_Z), (const float*)(ws + fz::WS_GLR), B.z);
        if (kind == 2) hipLaunchKernelGGL(dbg::k_cvt_bf, dim3((unsigned)(((size_t)T * 2048 + 255) / 256)), dim3(256), 0, stream, (const fz::bf16_t*)(ws + fz::WS_MIX), B.mixf, (size_t)T * 2048);
        if (kind == 4) hipLaunchKernelGGL(dbg::k_cvt_bf, dim3((unsigned)(((size_t)T * 2048 + 255) / 256)), dim3(256), 0, stream, (const fz::bf16_t*)(ws + fz::WS_H), B.hf, (size_t)T * 2048);
        ora::run_range(d_in, (float*)d_out, B, scut, 15, stream);
    }
#elif MK_MODE == 3
    {
        const int scut = DBG_CUT; const int pcut = scut == 5 ? 1 + fz::PK_NORM2 : scut == 7 ? 1 + fz::PK_TAIL : 1 + fz::PH_PER_LAYER + fz::PK_NORM2;
        ora::Bufs B = ora::make_bufs(ws + fz::WS_EWGU, (float*)(ws + fz::WS_XS));
        ora::run_range(d_in, (float*)d_out, B, 0, scut, stream);
        launch_fused(a, 0, 1, grid, stream);
        for (int p = pcut; p < fz::NPH; ++p) { if (p == 1 + fz::PK_ASSIGN) continue; launch_fused(a, p, p + 1, grid, stream); }
    }
#endif
}
```

```cpp
#include <hip/hip_runtime.h>
#include <cstdio>
#include <cstdint>
constexpr int T = 16384, DM = 2048, ZW = 4112;
constexpr float EPSF = 1e-6f;
constexpr int LSLOT = 34816, NRB_MAX = 136;
#ifndef DENSE_FP8
#define DENSE_FP8 2
#endif
#ifndef GEMM_SP2
#define GEMM_SP2 true
#endif
#ifndef GEMM_KM
#define GEMM_KM 0x240000
#endif
#ifndef GEMM_FP6_NOPRIO
#define GEMM_FP6_NOPRIO 0
#endif
#ifndef GEMM_SADDR
#define GEMM_SADDR 4
#endif
#ifndef GEMM_RDFIRST
#define GEMM_RDFIRST 0
#endif
#ifndef GEMM_B1LATE
#define GEMM_B1LATE 0
#endif
#ifndef GEMM_LGKDEFER
#define GEMM_LGKDEFER 1
#endif
#ifndef GEMM_G0DEFER
#define GEMM_G0DEFER 1
#endif
#ifndef GEMM_BPF
#define GEMM_BPF 0
#endif
#ifndef GEMM_ALIGN
#define GEMM_ALIGN false
#endif
#ifndef TILE_EWGU
#define TILE_EWGU 1
#endif
#ifndef TILE_ACT2
#define TILE_ACT2 1
#endif
#ifndef TILE_H
#define TILE_H 0
#endif
#ifndef TILE_ACT
#define TILE_ACT 1
#endif
#ifndef TILE_HS
#define TILE_HS 1
#endif
#ifndef MOE_UP_FMT
#define MOE_UP_FMT 2
#endif
#define MK_MODE 0
#define DBG_CUT 0
namespace pg8 {
#define PG8_LAS __attribute__((address_space(3)))
typedef unsigned short bf16_t;
typedef short bf16x8 __attribute__((ext_vector_type(8)));
typedef float f32x4 __attribute__((ext_vector_type(4)));
typedef unsigned u32x4 __attribute__((ext_vector_type(4)));
constexpr int BM = 256, BK = 64, HALF = 128, HTB = HALF * BK * 2, STAGE_BYTES = 8 * HTB, NXCD = 8, WGM = 8;

__host__ __device__ __forceinline__ int lds_byte(int r, int c) { const int st = (r >> 4) * 2 + (c >> 5), rr = r & 15, cc = c & 31, ob = rr * 64 + cc * 2; return st * 1024 + (ob ^ (((ob >> 9) & 1) << 5)); }
__host__ __device__ __forceinline__ void stage_rc(int b, int& R, int& C) { const int st = b / 1024, sb = b % 1024, swz = sb ^ (((sb >> 9) & 1) << 5); R = (st >> 1) * 16 + swz / 64; C = (st & 1) * 32 + (swz % 64) / 2; }
__host__ __device__ __forceinline__ int perm32(int rho) { const int n = rho >> 4, i = rho & 15; return 8 * (i >> 2) + 4 * n + (i & 3); }

struct Unit { int pm, pn; const char* a; const char* b; };
struct Gemm { int lda, ldb, K; int sA, sB; int kstepA, kstepB; };
typedef int i32x8 __attribute__((ext_vector_type(8)));
typedef int i32x4 __attribute__((ext_vector_type(4)));
typedef int i32x6 __attribute__((ext_vector_type(6)));
typedef int i32x2 __attribute__((ext_vector_type(2)));

__device__ __forceinline__ void unit_map(long L, int nM, int nN, int& pm, int& pn) {
    const int nwg = nM * nN; int wgid = (int)L; { const int q = nwg / NXCD, r = nwg % NXCD, xcd = wgid % NXCD, off = wgid / NXCD; wgid = (xcd < r ? xcd * (q + 1) : r * (q + 1) + (xcd - r) * q) + off; }
    const int nig = WGM * nN, gid = wgid / nig, fm = gid * WGM, gsz = (nM - fm) < WGM ? (nM - fm) : WGM;
    pm = fm + ((wgid % nig) % gsz); pn = (wgid % nig) / gsz;
}
template <bool MOE> struct Order {
    int nM, nN, nwg, G, c; long Lend;
    const char* A; const char* B; size_t a_pm, a_pn, b_pn, b_e; const int* blk_expert;
    __device__ void init(int nM_, int nN_, int G_, int c_) { nM = nM_; nN = nN_; nwg = nM * nN; G = G_; c = c_; Lend = nwg; }
    __device__ __forceinline__ bool next(int i, Unit& u) const {
        const long L = (long)i * G + c; if (L >= Lend) return false;
        unit_map(L, nM, nN, u.pm, u.pn);
        u.a = A + (size_t)u.pm * a_pm + (size_t)u.pn * a_pn;
        u.b = B + (size_t)u.pn * b_pn;
        if (MOE) { const int e = __builtin_amdgcn_readfirstlane(__hip_atomic_load(blk_expert + u.pm, __ATOMIC_RELAXED, __HIP_MEMORY_SCOPE_AGENT)); u.b += (size_t)e * b_e; }
        return true;
    }
    __device__ __forceinline__ void a_ready(const Unit&) const {}
    __device__ __forceinline__ void done(const Unit&) const {}
};
struct TailOrder {
    int nM, nN, c, full, tail, s; size_t ksliceA, ksliceB;
    const char* A; const char* B; size_t a_pm, b_pn, b_e; const int* blk_expert;
    __device__ __forceinline__ bool next(int i, Unit& u) const {
        if (i > 0 || c >= tail * s) return false;
        const int t = c / s, sl = c % s; int pm, pn; unit_map((long)full + t, nM, nN, pm, pn);
        const int e = __builtin_amdgcn_readfirstlane(__hip_atomic_load(blk_expert + pm, __ATOMIC_RELAXED, __HIP_MEMORY_SCOPE_AGENT));
        u.pm = c; u.pn = 0; u.a = A + (size_t)pm * a_pm + (size_t)sl * ksliceA; u.b = B + (size_t)pn * b_pn + (size_t)e * b_e + (size_t)sl * ksliceB;
        return true;
    }
    __device__ __forceinline__ void a_ready(const Unit&) const {}
    __device__ __forceinline__ void done(const Unit&) const {}
};

__device__ __forceinline__ unsigned cvt_pk_bf16(float lo, float hi) { unsigned r; asm volatile("v_cvt_pk_bf16_f32 %0, %1, %2" : "=v"(r) : "v"(lo), "v"(hi)); return r; }
__device__ __forceinline__ float silu_f(float x) { return x * __builtin_amdgcn_rcpf(1.0f + __builtin_amdgcn_exp2f(-1.4426950408889634f * x)); }

struct EpiBf16 {
    static constexpr bool PERM = true, AFTER_DRAIN = false;
    bf16_t* O; int ldc; const float* scale;
    __device__ __forceinline__ void operator()(const f32x4 (&acc)[2][2][4][2], const Unit& u, int wr, int wc, int fr, int fq) const {
        const int row0 = u.pm * BM + wr * 64 + fr, col0 = u.pn * BM + wc * 32 + 8 * fq;
        f32x4 sv[2][2];
#pragma unroll
        for (int bj = 0; bj < 2; ++bj)
#pragma unroll
            for (int n = 0; n < 2; ++n) sv[bj][n] = scale ? *(const f32x4*)(scale + col0 + bj * HALF + 4 * n) : (f32x4){1.f, 1.f, 1.f, 1.f};
#pragma unroll
        for (int ai = 0; ai < 2; ++ai)
#pragma unroll
            for (int m = 0; m < 4; ++m) { bf16_t* rowp = O + (size_t)(row0 + ai * HALF + m * 16) * ldc + col0;
#pragma unroll
                for (int bj = 0; bj < 2; ++bj) { const f32x4 v0 = acc[ai][bj][m][0] * sv[bj][0], v1 = acc[ai][bj][m][1] * sv[bj][1];
                    u32x4 w; w.x = cvt_pk_bf16(v0[0], v0[1]); w.y = cvt_pk_bf16(v0[2], v0[3]); w.z = cvt_pk_bf16(v1[0], v1[1]); w.w = cvt_pk_bf16(v1[2], v1[3]);
                    *(u32x4*)(rowp + bj * HALF) = w; } }
    }
};
template <bool F32IN> struct EpiRes {
    static constexpr bool PERM = true, AFTER_DRAIN = false;
    const void* base; bf16_t* out; int ldc;
    __device__ __forceinline__ void operator()(const f32x4 (&acc)[2][2][4][2], const Unit& u, int wr, int wc, int fr, int fq) const {
        const int row0 = u.pm * BM + wr * 64 + fr, col0 = u.pn * BM + wc * 32 + 8 * fq;
        if constexpr (!F32IN) {
            u32x4 q[2][4][2];
#pragma unroll
            for (int ai = 0; ai < 2; ++ai)
#pragma unroll
                for (int m = 0; m < 4; ++m)
#pragma unroll
                    for (int bj = 0; bj < 2; ++bj) q[ai][m][bj] = *(const u32x4*)((const bf16_t*)base + (size_t)(row0 + ai * HALF + m * 16) * ldc + col0 + bj * HALF);
#pragma unroll
            for (int ai = 0; ai < 2; ++ai)
#pragma unroll
                for (int m = 0; m < 4; ++m)
#pragma unroll
                    for (int bj = 0; bj < 2; ++bj) { const u32x4 t = q[ai][m][bj];
                        const f32x4 v0 = (f32x4){__uint_as_float(t.x << 16), __uint_as_float(t.x & 0xffff0000u), __uint_as_float(t.y << 16), __uint_as_float(t.y & 0xffff0000u)} + acc[ai][bj][m][0];
                        const f32x4 v1 = (f32x4){__uint_as_float(t.z << 16), __uint_as_float(t.z & 0xffff0000u), __uint_as_float(t.w << 16), __uint_as_float(t.w & 0xffff0000u)} + acc[ai][bj][m][1];
                        u32x4 w; w.x = cvt_pk_bf16(v0[0], v0[1]); w.y = cvt_pk_bf16(v0[2], v0[3]); w.z = cvt_pk_bf16(v1[0], v1[1]); w.w = cvt_pk_bf16(v1[2], v1[3]);
                        *(u32x4*)(out + (size_t)(row0 + ai * HALF + m * 16) * ldc + col0 + bj * HALF) = w; }
        } else {
#pragma unroll
            for (int ai = 0; ai < 2; ++ai) {
                f32x4 b0[4][2], b1[4][2];
#pragma unroll
                for (int m = 0; m < 4; ++m)
#pragma unroll
                    for (int bj = 0; bj < 2; ++bj) { const float* bp = (const float*)base + (size_t)(row0 + ai * HALF + m * 16) * ldc + col0 + bj * HALF; b0[m][bj] = *(const f32x4*)bp; b1[m][bj] = *(const f32x4*)(bp + 4); }
#pragma unroll
                for (int m = 0; m < 4; ++m)
#pragma unroll
                    for (int bj = 0; bj < 2; ++bj) { const f32x4 v0 = b0[m][bj] + acc[ai][bj][m][0], v1 = b1[m][bj] + acc[ai][bj][m][1];
                        u32x4 w; w.x = cvt_pk_bf16(v0[0], v0[1]); w.y = cvt_pk_bf16(v0[2], v0[3]); w.z = cvt_pk_bf16(v1[0], v1[1]); w.w = cvt_pk_bf16(v1[2], v1[3]);
                        *(u32x4*)(out + (size_t)(row0 + ai * HALF + m * 16) * ldc + col0 + bj * HALF) = w; }
                asm volatile("" ::: "memory"); }
        }
    }
};
struct EpiPart {
    static constexpr bool PERM = false, AFTER_DRAIN = false;
    float* P;
    __device__ __forceinline__ void operator()(const f32x4 (&acc)[2][2][4][2], const Unit& u, int wr, int wc, int fr, int fq) const {
        float* base = P + (size_t)u.pm * 65536 + (size_t)(wr * 64 + fr) * 256 + wc * 32 + 4 * fq;
#pragma unroll
        for (int ai = 0; ai < 2; ++ai)
#pragma unroll
            for (int m = 0; m < 4; ++m)
#pragma unroll
                for (int bj = 0; bj < 2; ++bj)
#pragma unroll
                    for (int n = 0; n < 2; ++n) *(f32x4*)(base + (size_t)(ai * HALF + m * 16) * 256 + bj * HALF + n * 16) = acc[ai][bj][m][n];
    }
};
struct EpiSwiglu {
    static constexpr bool PERM = true, AFTER_DRAIN = false;
    bf16_t* O; int kt_per_panel;
    __device__ __forceinline__ void operator()(const f32x4 (&acc)[2][2][4][2], const Unit& u, int wr, int wc, int fr, int fq) const {
        const size_t rp = kt_per_panel > 0 ? (size_t)128 : (size_t)(-kt_per_panel);
        unsigned char* blk = kt_per_panel > 0 ? (unsigned char*)O + ((size_t)u.pm * kt_per_panel + u.pn * 2 + (wc >> 1)) * 32768 + (size_t)(wr * 64 + fr) * 128 + ((wc & 1) * 32 + 8 * fq) * 2
                                              : (unsigned char*)O + (size_t)(u.pm * BM + wr * 64 + fr) * rp + (u.pn * HALF + wc * 32 + 8 * fq) * 2;
#pragma unroll
        for (int ai = 0; ai < 2; ++ai)
#pragma unroll
            for (int m = 0; m < 4; ++m) { unsigned char* rowp = blk + (size_t)(ai * HALF + m * 16) * rp;
                const f32x4 g0 = acc[ai][0][m][0], g1 = acc[ai][0][m][1], u0 = acc[ai][1][m][0], u1 = acc[ai][1][m][1];
                u32x4 w; w.x = cvt_pk_bf16(silu_f(g0[0]) * u0[0], silu_f(g0[1]) * u0[1]); w.y = cvt_pk_bf16(silu_f(g0[2]) * u0[2], silu_f(g0[3]) * u0[3]);
                w.z = cvt_pk_bf16(silu_f(g1[0]) * u1[0], silu_f(g1[1]) * u1[1]); w.w = cvt_pk_bf16(silu_f(g1[2]) * u1[2], silu_f(g1[3]) * u1[3]);
                *(u32x4*)rowp = w; }
    }
};
struct EpiSwigluF8 {
    static constexpr bool PERM = true, AFTER_DRAIN = false;
    unsigned char* O; int kt_per_panel; float osc;
    __device__ __forceinline__ static float cl(float v) { return __builtin_fminf(__builtin_fmaxf(v, -448.f), 448.f); }
    __device__ __forceinline__ void operator()(const f32x4 (&acc)[2][2][4][2], const Unit& u, int wr, int wc, int fr, int fq) const {
        const size_t rp = kt_per_panel > 0 ? (size_t)128 : (size_t)(-kt_per_panel);
        unsigned char* blk = kt_per_panel > 0 ? O + ((size_t)u.pm * kt_per_panel + u.pn) * 32768 + (size_t)(wr * 64 + fr) * 128 + wc * 32 + 8 * fq
                                              : O + (size_t)(u.pm * BM + wr * 64 + fr) * rp + u.pn * HALF + wc * 32 + 8 * fq;
#pragma unroll
        for (int ai = 0; ai < 2; ++ai)
#pragma unroll
            for (int m = 0; m < 4; ++m) { unsigned char* rowp = blk + (size_t)(ai * HALF + m * 16) * rp;
                const f32x4 g0 = acc[ai][0][m][0], g1 = acc[ai][0][m][1], u0 = acc[ai][1][m][0], u1 = acc[ai][1][m][1];
                float v[8];
#pragma unroll
                for (int i = 0; i < 4; ++i) { v[i] = cl(silu_f(g0[i]) * u0[i] * osc); v[4 + i] = cl(silu_f(g1[i]) * u1[i] * osc); }
                int w0 = 0, w1 = 0;
                w0 = __builtin_amdgcn_cvt_pk_fp8_f32(v[0], v[1], w0, false); w0 = __builtin_amdgcn_cvt_pk_fp8_f32(v[2], v[3], w0, true);
                w1 = __builtin_amdgcn_cvt_pk_fp8_f32(v[4], v[5], w1, false); w1 = __builtin_amdgcn_cvt_pk_fp8_f32(v[6], v[7], w1, true);
                typedef int i32x2v __attribute__((ext_vector_type(2)));
                *(i32x2v*)rowp = (i32x2v){w0, w1}; }
    }
};

struct EpiSwigluF8S {
    static constexpr bool PERM = true, AFTER_DRAIN = false, STAGED = true;
    unsigned char* O; int kt_per_panel; float osc;
    __device__ __forceinline__ static float cl(float v) { return __builtin_fminf(__builtin_fmaxf(v, -448.f), 448.f); }
    __device__ __forceinline__ void staged(const f32x4 (&acc)[2][2][4][2], const Unit& u, int wr, int wc, int fr, int fq, PG8_LAS unsigned char* stg, int wid, int lane) const {
        constexpr int SP = 144;
        unsigned char* blk = O + ((size_t)u.pm * kt_per_panel + u.pn) * 32768;
        typedef int i32x2v __attribute__((ext_vector_type(2)));
#pragma unroll
        for (int ai = 0; ai < 2; ++ai) {
#pragma unroll
            for (int m = 0; m < 4; ++m) {
                const f32x4 g0 = acc[ai][0][m][0], g1 = acc[ai][0][m][1], u0 = acc[ai][1][m][0], u1 = acc[ai][1][m][1];
                float v[8];
#pragma unroll
                for (int i = 0; i < 4; ++i) { v[i] = cl(silu_f(g0[i]) * u0[i] * osc); v[4 + i] = cl(silu_f(g1[i]) * u1[i] * osc); }
                int w0 = 0, w1 = 0;
                w0 = __builtin_amdgcn_cvt_pk_fp8_f32(v[0], v[1], w0, false); w0 = __builtin_amdgcn_cvt_pk_fp8_f32(v[2], v[3], w0, true);
                w1 = __builtin_amdgcn_cvt_pk_fp8_f32(v[4], v[5], w1, false); w1 = __builtin_amdgcn_cvt_pk_fp8_f32(v[6], v[7], w1, true);
                *(PG8_LAS i32x2v*)(stg + (wr * 64 + m * 16 + fr) * SP + wc * 32 + 8 * fq) = (i32x2v){w0, w1}; }
            asm volatile("s_waitcnt lgkmcnt(0)" ::: "memory"); __builtin_amdgcn_s_barrier(); asm volatile("" ::: "memory");
            u32x4 t[2];
#pragma unroll
            for (int i = 0; i < 2; ++i) t[i] = *(const PG8_LAS u32x4*)(stg + (wid * 16 + (lane >> 3) + 8 * i) * SP + 16 * (lane & 7));
#pragma unroll
            for (int i = 0; i < 2; ++i) *(u32x4*)(blk + (size_t)(ai * HALF + wid * 16 + (lane >> 3) + 8 * i) * 128 + 16 * (lane & 7)) = t[i];
            asm volatile("s_waitcnt lgkmcnt(0)" ::: "memory"); __builtin_amdgcn_s_barrier(); asm volatile("" ::: "memory");
        }
    }
};
template <class E, class = void> struct epi_staged { static constexpr bool value = false; };
template <class E> struct epi_staged<E, decltype((void)E::STAGED)> { static constexpr bool value = E::STAGED; };

template <int N> __device__ __forceinline__ void waitv() { asm volatile("s_waitcnt vmcnt(%0)" :: "n"(N) : "memory"); }
template <class Epi, class Sched, bool ALIGN_EPI = false, bool SP2 = false, int FMT = 0, int KP = 0>
__device__ __forceinline__ void gemm_phase(PG8_LAS unsigned char* lds, const Gemm g, const Sched& S, const Epi& E) {
    const int tid = threadIdx.x, wid = __builtin_amdgcn_readfirstlane(tid >> 6), lane = tid & 63, wr = wid >> 2, wc = wid & 3, fr = lane & 15, fq = lane >> 4;
    const int K = g.K, nt = K / BK;
    constexpr bool FP8 = FMT != 0;
    constexpr bool BPF = SP2 && FMT == 2 && GEMM_BPF && KP == 0;
#define KP_RD if constexpr (!(KP & 1))
#define KP_ST if constexpr (!(KP & 2))
#define KP_MM if constexpr (!(KP & 4))
    constexpr int KM1 = ((GEMM_KM) >> (8 * FMT + 4)) & 15, KM2 = ((GEMM_KM) >> (8 * FMT)) & 15, GS1 = KM1 <= 1 ? 4 : 2, GS2 = KM2 <= 2 ? 3 : KM2 <= 4 ? 2 : 1;
    constexpr bool LGKDEFER = FMT == 2 && GEMM_LGKDEFER && KM1 == 2 && KM2 >= 4 && KP == 0;
    constexpr bool B1LATE = FMT == 2 && GEMM_B1LATE && KM2 >= 4;
    int f8sc = g.sB; if constexpr (FP8) { asm volatile("" : "+v"(f8sc)); }
    unsigned voffA[2], voffB[2];
#pragma unroll
    for (int i = 0; i < 2; ++i) { int R, C; stage_rc(tid * 16 + i * 8192, R, C); const int Rb = Epi::PERM ? ((R & ~31) + perm32(R & 31)) : R;
        voffA[i] = (unsigned)(R * g.lda + C) * 2u; voffB[i] = (unsigned)(Rb * g.ldb + C) * 2u; }
    const size_t kstepA = (size_t)g.kstepA, kstepB = (size_t)g.kstepB;
    const size_t hstepA = (size_t)HALF * g.lda * 2, hstepB = (size_t)HALF * g.ldb * 2;
    const unsigned ldsbase = __builtin_amdgcn_readfirstlane((unsigned)(size_t)lds + (unsigned)wid * 1024u);
    const unsigned ldsw = (unsigned)wid * 1024u;
    const int aoff = lds_byte(wr * 64 + fr, fq * 8), boff = lds_byte(wc * 32 + fr, fq * 8);
#define PG8_SA(b, h) (((b) * 2 + (h)) * HTB)
#define PG8_SB(b, h) ((4 + (b) * 2 + (h)) * HTB)
#define PG8_STAGE(bufoff, gbase, voff) do { _Pragma("unroll") for (int _i = 0; _i < 2; ++_i) \
        __builtin_amdgcn_global_load_lds((const unsigned*)((const char*)(gbase) + (voff)[_i]), (PG8_LAS unsigned*)(lds + (bufoff) + ldsw + _i * 8192), 16, 0, 0); } while (0)
#define PG8_LDA(dst, b, h) do { _Pragma("unroll") for (int m = 0; m < 4; ++m) { dst[m][0] = *(const PG8_LAS bf16x8*)(lds + PG8_SA(b, h) + aoff + m * 2048); \
        if constexpr (FMT == 2) { dst##H[m] = *(const PG8_LAS i32x2*)(lds + PG8_SA(b, h) + aoff + m * 2048 + 1024); asm volatile("" ::: "memory"); } else dst[m][1] = *(const PG8_LAS bf16x8*)(lds + PG8_SA(b, h) + aoff + m * 2048 + 1024); } } while (0)
#define PG8_LDB(dst, b, h) do { _Pragma("unroll") for (int n = 0; n < 2; ++n) { dst[n][0] = *(const PG8_LAS bf16x8*)(lds + PG8_SB(b, h) + boff + n * 2048); \
        if constexpr (FMT == 2) { dst##H[n] = *(const PG8_LAS i32x2*)(lds + PG8_SB(b, h) + boff + n * 2048 + 1024); asm volatile("" ::: "memory"); } else dst[n][1] = *(const PG8_LAS bf16x8*)(lds + PG8_SB(b, h) + boff + n * 2048 + 1024); } } while (0)
#define PG8_STAGE1(bufoff, gbase, voff, i) do { if constexpr ((GEMM_SADDR >> FMT) & 1) { \
        asm volatile("s_mov_b32 m0, %0\n\ts_nop 0\n\tglobal_load_lds_dwordx4 %1, %2" :: "s"(ldsbase + (unsigned)((bufoff) + (i) * 8192)), "v"((voff)[i]), "s"((const char*)(gbase)) : "m0", "memory"); } \
        else __builtin_amdgcn_global_load_lds((const unsigned*)((const char*)(gbase) + (voff)[i]), (PG8_LAS unsigned*)(lds + (bufoff) + ldsw + (i) * 8192), 16, 0, 0); } while (0)
#define PG8_MMA1(ai, bj, At, Bt, m) do { _Pragma("unroll") for (int n = 0; n < 2; ++n) { \
        if constexpr (FMT == 2) { const i32x4 w0_ = __builtin_bit_cast(i32x4, Bt[n][0]), a0_ = __builtin_bit_cast(i32x4, At[m][0]); \
            const i32x6 wf_ = (i32x6){w0_[0], w0_[1], w0_[2], w0_[3], Bt##H[n][0], Bt##H[n][1]}, af_ = (i32x6){a0_[0], a0_[1], a0_[2], a0_[3], At##H[m][0], At##H[m][1]}; \
            asm volatile("v_mfma_scale_f32_16x16x128_f8f6f4 %0, %1, %2, %0, %3, %3 op_sel:[0,1,0] op_sel_hi:[0,0,0] cbsz:2 blgp:2" : "+v"(acc[ai][bj][m][n]) : "v"(wf_), "v"(af_), "v"(f8sc)); } \
        else if constexpr (FMT == 1) { const i32x8 wf_ = __builtin_shufflevector(__builtin_bit_cast(i32x4, Bt[n][0]), __builtin_bit_cast(i32x4, Bt[n][1]), 0, 1, 2, 3, 4, 5, 6, 7); \
            const i32x8 af_ = __builtin_shufflevector(__builtin_bit_cast(i32x4, At[m][0]), __builtin_bit_cast(i32x4, At[m][1]), 0, 1, 2, 3, 4, 5, 6, 7); \
            asm volatile("v_mfma_scale_f32_16x16x128_f8f6f4 %0, %1, %2, %0, %3, %3 op_sel:[0,1,0] op_sel_hi:[0,0,0]" : "+v"(acc[ai][bj][m][n]) : "v"(wf_), "v"(af_), "v"(f8sc)); } \
        else { _Pragma("unroll") for (int k = 0; k < 2; ++k) acc[ai][bj][m][n] = __builtin_amdgcn_mfma_f32_16x16x32_bf16(Bt[n][k], At[m][k], acc[ai][bj][m][n], 0, 0, 0); } } } while (0)
#define PG8_MMA(ai, bj, At, Bt) do { __builtin_amdgcn_s_setprio(1); _Pragma("unroll") for (int m = 0; m < 4; ++m) PG8_MMA1(ai, bj, At, Bt, m); \
        __builtin_amdgcn_s_setprio(0); } while (0)
#define PG8_ST(bufoff, gbase, voff, i) do { PG8_SCHED; PG8_STAGE1(bufoff, gbase, voff, i); PG8_SCHED; } while (0)
#define PG8_PIECE2(j, bb, pb, pa) do { KP_ST if ((j) < 2) PG8_STAGE1(PG8_SB(bb, 0), pb, voffB, (j) & 1); else if ((j) < 4) PG8_STAGE1(PG8_SB(bb, 1), (pb) + hstepB, voffB, (j) & 1); else PG8_STAGE1(PG8_SA(bb, 0), pa, voffA, (j) & 1); } while (0)
#define PG8_GROUP(ai, g) do { KP_MM if ((g) < 4) PG8_MMA1(ai, 0, At, B0, (g) & 3); else PG8_MMA1(ai, 1, At, B1, (g) & 3); } while (0)
#define PG8_PRIO1 do { if constexpr (!(FMT == 2 && GEMM_FP6_NOPRIO)) __builtin_amdgcn_s_setprio(1); } while (0)
#define PG8_SP1X(bb, sb, ps) do { \
        _Pragma("unroll") for (int j_ = 0; j_ < 2 - KM1; ++j_) KP_ST PG8_STAGE1(PG8_SA(sb, 1), ps, voffA, j_); \
        KP_RD { PG8_LDB(B0, bb, 0); if constexpr (!B1LATE && !LGKDEFER) PG8_LDB(B1, bb, 1); PG8_SCHED; PG8_LDA(At, bb, 0); if constexpr (!B1LATE && LGKDEFER) { PG8_SCHED; PG8_LDB(B1, bb, 1); } } \
        waitv<8 - KM1>(); if constexpr (LGKDEFER && B1LATE) PG8_WAIT_L(8); else if constexpr (LGKDEFER) PG8_WAIT_L(12); else PG8_WAIT_L(0); PG8_BAR; PG8_PRIO1; \
        _Pragma("unroll") for (int g_ = 0; g_ < 8; ++g_) { PG8_GROUP(0, g_); \
            if constexpr (B1LATE) { if (g_ == 0) { PG8_SCHED; KP_RD { PG8_LDB(B1, bb, 1); } PG8_SCHED; } } \
            if (g_ % GS1 == 0 && g_ / GS1 < KM1) { PG8_SCHED; KP_ST PG8_STAGE1(PG8_SA(sb, 1), ps, voffA, 2 - KM1 + g_ / GS1); PG8_SCHED; } } \
        __builtin_amdgcn_s_setprio(0); PG8_BAR; PG8_SCHED; } while (0)
#define PG8_SP2X(bb, pb, pa) do { \
        if constexpr (!GEMM_RDFIRST) { _Pragma("unroll") for (int j_ = 0; j_ < 6 - KM2; ++j_) PG8_PIECE2(j_, bb, pb, pa); } \
        KP_RD { PG8_LDA(At, bb, 1); } \
        if constexpr (GEMM_RDFIRST) { PG8_SCHED; _Pragma("unroll") for (int j_ = 0; j_ < 6 - KM2; ++j_) PG8_PIECE2(j_, bb, pb, pa); } \
        waitv<8 - KM2>(); if constexpr (!LGKDEFER) PG8_WAIT_L(0); PG8_BAR; PG8_PRIO1; \
        _Pragma("unroll") for (int g_ = 0; g_ < 8; ++g_) { PG8_GROUP(1, g_); \
            if (g_ % GS2 == 0 && g_ / GS2 < KM2) { PG8_SCHED; PG8_PIECE2(6 - KM2 + g_ / GS2, bb, pb, pa); PG8_SCHED; } } \
        __builtin_amdgcn_s_setprio(0); PG8_BAR; PG8_SCHED; } while (0)
#define PG8_SP1B(bb, sb, ps, Bc) do { \
        _Pragma("unroll") for (int j_ = 0; j_ < 2 - KM1; ++j_) PG8_STAGE1(PG8_SA(sb, 1), ps, voffA, j_); \
        PG8_LDB(B1, bb, 1); PG8_SCHED; PG8_LDA(At, bb, 0); \
        waitv<6 - KM1>(); PG8_WAIT_L(0); PG8_BAR; __builtin_amdgcn_s_setprio(1); \
        _Pragma("unroll") for (int g_ = 0; g_ < 8; ++g_) { if (g_ < 4) PG8_MMA1(0, 0, At, Bc, g_ & 3); else PG8_MMA1(0, 1, At, B1, g_ & 3); \
            if (g_ % GS1 == 0 && g_ / GS1 < KM1) { PG8_SCHED; PG8_STAGE1(PG8_SA(sb, 1), ps, voffA, 2 - KM1 + g_ / GS1); PG8_SCHED; } } \
        __builtin_amdgcn_s_setprio(0); PG8_BAR; PG8_SCHED; } while (0)
#define PG8_SP2B(bb, pb, pa, Bc, Bn) do { \
        _Pragma("unroll") for (int j_ = 0; j_ < 6 - KM2; ++j_) PG8_PIECE2(j_, bb, pb, pa); \
        PG8_LDA(At, bb, 1); PG8_SCHED; PG8_LDB(Bn, 1 - (bb), 0); \
        waitv<8 - KM2>(); PG8_WAIT_L(0); PG8_BAR; __builtin_amdgcn_s_setprio(1); \
        _Pragma("unroll") for (int g_ = 0; g_ < 8; ++g_) { if (g_ < 4) PG8_MMA1(1, 0, At, Bc, g_ & 3); else PG8_MMA1(1, 1, At, B1, g_ & 3); \
            if (g_ % GS2 == 0 && g_ / GS2 < KM2) { PG8_SCHED; PG8_PIECE2(6 - KM2 + g_ / GS2, bb, pb, pa); PG8_SCHED; } } \
        __builtin_amdgcn_s_setprio(0); PG8_BAR; PG8_SCHED; } while (0)
#define PG8_WAIT_V(n) asm volatile("s_waitcnt vmcnt(" #n ")" ::: "memory")
#define PG8_WAIT_L(n) asm volatile("s_waitcnt lgkmcnt(" #n ")" ::: "memory")
#define PG8_WAIT_LG1 do { if (!GEMM_G0DEFER || wr == 1) PG8_WAIT_L(0); } while (0)
#define PG8_BAR __builtin_amdgcn_s_barrier()
#define PG8_SCHED __builtin_amdgcn_sched_barrier(0)
    Unit cur, nxt; int ui = 0;
    if (!S.next(0, cur)) return;
    f32x4 acc[2][2][4][2];
#pragma unroll
    for (int a = 0; a < 2; ++a)
#pragma unroll
        for (int b = 0; b < 2; ++b)
#pragma unroll
            for (int m = 0; m < 4; ++m)
#pragma unroll
                for (int n = 0; n < 2; ++n) acc[a][b][m][n] = (f32x4){0.f, 0.f, 0.f, 0.f};
    bf16x8 At[4][2] = {}, B0[2][2] = {}, B1[2][2] = {}, B2[2][2] = {}; i32x2 AtH[4] = {}, B0H[2] = {}, B1H[2] = {}, B2H[2] = {};
    const char* cA = cur.a; const char* cB = cur.b;
    S.a_ready(cur);
    if constexpr (SP2) {
        PG8_STAGE(PG8_SB(0, 0), cB, voffB); PG8_STAGE(PG8_SB(0, 1), cB + hstepB, voffB); PG8_STAGE(PG8_SA(0, 0), cA, voffA); PG8_STAGE(PG8_SA(0, 1), cA + hstepA, voffA);
        if (wr == 1) PG8_BAR;
        PG8_WAIT_V(2); PG8_BAR;
        PG8_STAGE(PG8_SB(1, 0), cB + kstepB, voffB); PG8_STAGE(PG8_SA(1, 0), cA + kstepA, voffA); PG8_STAGE(PG8_SB(1, 1), cB + hstepB + kstepB, voffB);
        PG8_WAIT_V(6); PG8_BAR;
    } else {
        PG8_STAGE(PG8_SB(0, 0), cB, voffB); PG8_STAGE(PG8_SA(0, 0), cA, voffA); PG8_STAGE(PG8_SB(0, 1), cB + hstepB, voffB); PG8_STAGE(PG8_SA(0, 1), cA + hstepA, voffA);
        if (wr == 1) PG8_BAR;
        PG8_WAIT_V(4); PG8_BAR;
        PG8_STAGE(PG8_SB(1, 0), cB + kstepB, voffB); PG8_STAGE(PG8_SA(1, 0), cA + kstepA, voffA); PG8_STAGE(PG8_SB(1, 1), cB + hstepB + kstepB, voffB);
        PG8_WAIT_V(6); PG8_BAR;
    }
    if constexpr (BPF) { PG8_LDB(B0, 0, 0); }
    for (;;) {
        const bool has_next = S.next(ui + 1, nxt);
        const char* nA = has_next ? nxt.a : cA; const char* nB = has_next ? nxt.b : cB;
        for (int t = 0; t < nt; t += 2) {
            const bool last = (t == nt - 2);
            const char* a1 = cA + (size_t)(t + 1) * kstepA;
            const char* a2 = last ? nA : cA + (size_t)(t + 2) * kstepA; const char* b2 = last ? nB : cB + (size_t)(t + 2) * kstepB;
            const char* a3 = a2 + kstepA; const char* b3 = b2 + kstepB;
            if (last && has_next) S.a_ready(nxt);
            if constexpr (BPF) {
            PG8_SP1B(0, 1, a1 + hstepA, B0); PG8_SP2B(0, b2, a2, B0, B2); PG8_SP1B(1, 0, a2 + hstepA, B2); PG8_SP2B(1, b3, a3, B2, B0);
            } else if constexpr (SP2 && (KM1 | KM2) != 0) {
            PG8_SP1X(0, 1, a1 + hstepA); PG8_SP2X(0, b2, a2); PG8_SP1X(1, 0, a2 + hstepA); PG8_SP2X(1, b3, a3);
            } else if constexpr (SP2) {
            KP_ST PG8_STAGE(PG8_SA(1, 1), a1 + hstepA, voffA); KP_RD PG8_LDB(B0, 0, 0); KP_RD PG8_LDB(B1, 0, 1); PG8_SCHED; KP_RD PG8_LDA(At, 0, 0);
            PG8_WAIT_V(8); PG8_WAIT_LG1; PG8_BAR; KP_MM PG8_MMA(0, 0, At, B0); KP_MM PG8_MMA(0, 1, At, B1); PG8_BAR; PG8_SCHED;
            KP_ST PG8_STAGE(PG8_SB(0, 0), b2, voffB); KP_ST PG8_STAGE(PG8_SB(0, 1), b2 + hstepB, voffB); KP_ST PG8_STAGE(PG8_SA(0, 0), a2, voffA); KP_RD PG8_LDA(At, 0, 1);
            PG8_WAIT_V(8); PG8_WAIT_LG1; PG8_BAR; KP_MM PG8_MMA(1, 0, At, B0); KP_MM PG8_MMA(1, 1, At, B1); PG8_BAR; PG8_SCHED;
            KP_ST PG8_STAGE(PG8_SA(0, 1), a2 + hstepA, voffA); KP_RD PG8_LDB(B0, 1, 0); KP_RD PG8_LDB(B1, 1, 1); PG8_SCHED; KP_RD PG8_LDA(At, 1, 0);
            PG8_WAIT_V(8); PG8_WAIT_LG1; PG8_BAR; KP_MM PG8_MMA(0, 0, At, B0); KP_MM PG8_MMA(0, 1, At, B1); PG8_BAR; PG8_SCHED;
            KP_ST PG8_STAGE(PG8_SB(1, 0), b3, voffB); KP_ST PG8_STAGE(PG8_SB(1, 1), b3 + hstepB, voffB); KP_ST PG8_STAGE(PG8_SA(1, 0), a3, voffA); KP_RD PG8_LDA(At, 1, 1);
            PG8_WAIT_V(8); PG8_WAIT_LG1; PG8_BAR; KP_MM PG8_MMA(1, 0, At, B0); KP_MM PG8_MMA(1, 1, At, B1); PG8_BAR; PG8_SCHED;
            } else {
            PG8_LDB(B0, 0, 0); PG8_SCHED; PG8_LDA(At, 0, 0); PG8_STAGE(PG8_SA(1, 1), a1 + hstepA, voffA);
            PG8_WAIT_L(8); PG8_BAR; PG8_WAIT_L(0); PG8_MMA(0, 0, At, B0); PG8_BAR; PG8_SCHED;
            PG8_LDB(B1, 0, 1); PG8_STAGE(PG8_SB(0, 0), b2, voffB);
            PG8_BAR; PG8_WAIT_L(0); PG8_MMA(0, 1, At, B1); PG8_BAR;
            PG8_LDA(At, 0, 1); PG8_STAGE(PG8_SA(0, 0), a2, voffA);
            PG8_BAR; PG8_WAIT_L(0); PG8_MMA(1, 0, At, B0); PG8_BAR; PG8_SCHED;
            PG8_STAGE(PG8_SB(0, 1), b2 + hstepB, voffB);
            PG8_WAIT_V(6); PG8_BAR; PG8_MMA(1, 1, At, B1); PG8_BAR;
            PG8_LDB(B0, 1, 0); PG8_SCHED; PG8_LDA(At, 1, 0); PG8_STAGE(PG8_SA(0, 1), a2 + hstepA, voffA);
            PG8_WAIT_L(8); PG8_BAR; PG8_WAIT_L(0); PG8_MMA(0, 0, At, B0); PG8_BAR; PG8_SCHED;
            PG8_LDB(B1, 1, 1); PG8_STAGE(PG8_SB(1, 0), b3, voffB);
            PG8_BAR; PG8_WAIT_L(0); PG8_MMA(0, 1, At, B1); PG8_BAR;
            PG8_LDA(At, 1, 1); PG8_STAGE(PG8_SA(1, 0), a3, voffA);
            PG8_BAR; PG8_WAIT_L(0); PG8_MMA(1, 0, At, B0); PG8_BAR; PG8_SCHED;
            PG8_STAGE(PG8_SB(1, 1), b3 + hstepB, voffB);
            PG8_WAIT_V(6); PG8_BAR; PG8_MMA(1, 1, At, B1); PG8_BAR;
            }
        }
        if constexpr (ALIGN_EPI) { if (wr == 0) PG8_BAR; }
        if constexpr (FP8) { asm volatile("s_nop 15\n\ts_nop 15" ::: "memory"); }
        if constexpr (epi_staged<Epi>::value) { static_assert(ALIGN_EPI, "a staged epilogue uses workgroup barriers: both halves must run it together"); E.staged(acc, cur, wr, wc, fr, fq, lds + STAGE_BYTES, wid, lane); S.done(cur); }
        else if constexpr (!Epi::AFTER_DRAIN) { E(acc, cur, wr, wc, fr, fq); S.done(cur); }
        if (!has_next) break;
#pragma unroll
        for (int a = 0; a < 2; ++a)
#pragma unroll
            for (int b = 0; b < 2; ++b)
#pragma unroll
                for (int m = 0; m < 4; ++m)
#pragma unroll
                    for (int n = 0; n < 2; ++n) acc[a][b][m][n] = (f32x4){0.f, 0.f, 0.f, 0.f};
        cur = nxt; cA = nA; cB = nB; ++ui;
        if constexpr (ALIGN_EPI) { if (wr == 1) PG8_BAR; }
    }
    PG8_WAIT_V(0);
    if constexpr (!ALIGN_EPI) { if (wr == 0) PG8_BAR; }
    PG8_BAR;
    if constexpr (Epi::AFTER_DRAIN) { E.fused(acc, cur, wr, wc, fr, fq, lds, wid, lane); S.done(cur); }
#undef PG8_SA
#undef PG8_SB
#undef PG8_STAGE
#undef PG8_LDA
#undef PG8_LDB
#undef PG8_MMA
#undef PG8_MMA1
#undef PG8_STAGE1
#undef PG8_ST
#undef KP_RD
#undef KP_ST
#undef KP_MM
#undef PG8_PIECE2
#undef PG8_GROUP
#undef PG8_SP1X
#undef PG8_SP2X
#undef PG8_PRIO1
#undef PG8_SP1B
#undef PG8_SP2B
#undef PG8_WAIT_V
#undef PG8_WAIT_L
#undef PG8_WAIT_LG1
#undef PG8_BAR
#undef PG8_SCHED
}}
namespace fz {
#define LAS __attribute__((address_space(3)))
typedef unsigned short bf16_t;
typedef short bf16x8 __attribute__((ext_vector_type(8)));
typedef float f32x4 __attribute__((ext_vector_type(4)));
typedef float f32x2 __attribute__((ext_vector_type(2)));
typedef unsigned u32x4 __attribute__((ext_vector_type(4)));
typedef unsigned u32x2 __attribute__((ext_vector_type(2)));
typedef unsigned u32x6 __attribute__((ext_vector_type(6)));
typedef float f32x16 __attribute__((ext_vector_type(16)));
constexpr int NTHR = 512;
constexpr int LDS_BYTES = 163840, MISC_OFF = LDS_BYTES - 256;

constexpr size_t MiB = 1u << 20;
constexpr size_t WS_CTL = 0, CTL_ZERO_BYTES = 1 * MiB;
constexpr size_t WS_WIN = 1 * MiB;
constexpr size_t WS_WPOOL = WS_WIN + 32 * MiB;
constexpr size_t WS_WOUT = WS_WPOOL + 1 * MiB;
constexpr size_t WS_WGU = WS_WOUT + 16 * MiB;
constexpr size_t WS_WD = WS_WGU + 44 * MiB;
constexpr size_t WS_EWGU = WS_WD + 22 * MiB;
constexpr size_t WS_EWD = WS_EWGU + 448 * MiB;
constexpr size_t WS_XS = WS_EWD + 224 * MiB;
constexpr size_t WS_H = WS_XS + 128 * MiB;
constexpr size_t WS_GLR = WS_H + 65 * MiB;
constexpr size_t WS_ROUTE = WS_GLR + 1 * MiB;
constexpr size_t WS_U = WS_ROUTE + 2 * MiB;
constexpr size_t WS_Z = WS_U;
constexpr size_t WS_DP = WS_Z + 128 * MiB;
constexpr size_t WS_MIX = WS_DP + 32 * MiB;
constexpr size_t WS_CS = WS_MIX + 64 * MiB;
constexpr size_t WS_SP = WS_CS + 128 * MiB;
constexpr size_t WS_DEC = WS_SP + 64 * MiB;
constexpr size_t WS_ACT = WS_U;
constexpr size_t WS_HS = WS_U;
constexpr size_t WS_ACT2 = WS_HS + 136 * MiB;
constexpr size_t WS_Y = WS_ACT2 + 476 * MiB;
constexpr size_t WS_PART = WS_ACT2 + 240 * MiB;
constexpr size_t WS_END = WS_Y + 136 * MiB;
static_assert(WS_END <= 1792 * MiB, "workspace map");
static_assert(WS_DEC + 1 * MiB <= WS_END, "mixer view inside U");
constexpr size_t RT_TOPI = 0, RT_TOPW = 128 * 1024, RT_TOKSLOT = 256 * 1024, RT_HIST = 384 * 1024, RT_BLKE = 400 * 1024, RT_NRB = 404 * 1024;

constexpr int CW_BAR = 4096;

constexpr int PH_PRO = 0, PH_PER_LAYER = 10, NPH = 1 + 2 * PH_PER_LAYER;
constexpr int PK_INPROJ = 0, PK_PRE = 1, PK_POOLSCAN = 2, PK_GLAOUT = 3, PK_OUTPROJ = 4, PK_NORM2 = 5, PK_ASSIGN = 6, PK_UP = 7, PK_DOWN = 8, PK_TAIL = 9;

#define VM_WAIT() asm volatile("s_waitcnt vmcnt(0)" ::: "memory")
#define LDS_WAIT() asm volatile("s_waitcnt lgkmcnt(0)" ::: "memory")
#define RLX_AGENT __ATOMIC_RELAXED, __HIP_MEMORY_SCOPE_AGENT

__device__ __forceinline__ unsigned pk_bf16(float lo, float hi) { unsigned r; asm volatile("v_cvt_pk_bf16_f32 %0, %1, %2" : "=v"(r) : "v"(lo), "v"(hi)); return r; }
__device__ __forceinline__ float bf_lo(unsigned w) { return __uint_as_float(w << 16); }
__device__ __forceinline__ float bf_hi(unsigned w) { return __uint_as_float(w & 0xffff0000u); }
__device__ __forceinline__ float bf2f(bf16_t b) { return __uint_as_float(((unsigned)b) << 16); }
__device__ __forceinline__ bf16_t f2bf(float f) { return (bf16_t)(pk_bf16(f, 0.f) & 0xffffu); }
__device__ __forceinline__ float wave_sum(float v) {
#pragma unroll
    for (int o = 1; o < 64; o <<= 1) v += __shfl_xor(v, o);
    return v;
}
__device__ __forceinline__ float silu_f(float x) { return x * __builtin_amdgcn_rcpf(1.0f + __builtin_amdgcn_exp2f(-1.4426950408889634f * x)); }
__device__ __forceinline__ bf16x8 mk8(u32x2 lo, u32x2 hi) { u32x4 t; t.x = lo.x; t.y = lo.y; t.z = hi.x; t.w = hi.y; return __builtin_bit_cast(bf16x8, t); }
__device__ __forceinline__ bf16x8 tr_frag(unsigned a0, unsigned a1) {
    u32x2 lo, hi;
    asm volatile("ds_read_b64_tr_b16 %0, %2\n\tds_read_b64_tr_b16 %1, %3\n\ts_waitcnt lgkmcnt(0)" : "=&v"(lo), "=&v"(hi) : "v"(a0), "v"(a1) : "memory");
    return mk8(lo, hi);
}
__device__ __forceinline__ void moe_tail_split(int nrb, int G, int& full, int& tail, int& s) {
    const int nwg = nrb * 8; full = (nwg / G) * G; tail = nwg - full;
    s = tail == 0 ? 0 : (tail * 7 <= G ? 7 : (tail * 4 <= G ? 4 : (tail * 2 <= G ? 2 : 0)));
    if (s == 0) { full = nwg; tail = 0; }
}
__device__ __forceinline__ f32x4 mma16(bf16x8 a, bf16x8 b, f32x4 c) { return __builtin_amdgcn_mfma_f32_16x16x32_bf16(a, b, c, 0, 0, 0); }

#define XB_TMO      128
#define XB_XCNT(j)  (256  + 64 * (j))
#define XB_XSUB(j)  (1280 + 64 * (j))
#define XB_XGEN(j)  (2304 + 64 * (j))
#define XB_TOP      3328
#define XB_TOPGEN   3392
#define XCD_BAR_WORDS 3456
#define XB_SPIN_CAP (1u << 18)
__device__ __forceinline__ unsigned xb_ld(unsigned* p)              { return __hip_atomic_load(p, __ATOMIC_RELAXED, __HIP_MEMORY_SCOPE_AGENT); }
__device__ __forceinline__ unsigned xb_add(unsigned* p, unsigned v) { return __hip_atomic_fetch_add(p, v, __ATOMIC_RELAXED, __HIP_MEMORY_SCOPE_AGENT); }
__device__ __forceinline__ unsigned xb_xcc_id() { return (unsigned)__builtin_amdgcn_s_getreg((3 << 11) | 20) & 0xFu; }
#define XB_SPIN(cond, bar) do { unsigned _sp = 0; while (cond) { __builtin_amdgcn_s_sleep(1); \
    if ((++_sp & 255u) == 0u) { if (xb_ld(&(bar)[XB_TMO])) break; if (_sp > XB_SPIN_CAP) { atomicAdd(&(bar)[XB_TMO], 1u); break; } } } } while (0)
struct XcdBarrier { unsigned* bar; unsigned x; volatile LAS unsigned* st; };
__device__ __forceinline__ XcdBarrier xcd_barrier_post(unsigned* bar, volatile LAS unsigned* st) {
    XcdBarrier b; b.bar = bar; b.x = xb_xcc_id(); b.st = st;
    if (threadIdx.x == 0) (void)xb_add(&bar[XB_XCNT(b.x)], 1u);
    return b;
}
__device__ __forceinline__ void xcd_barrier_complete(unsigned* bar, unsigned x, unsigned& nloc, unsigned& nx) {
    const unsigned G = gridDim.x * gridDim.y * gridDim.z;
    unsigned sum, cnt, mine, sp = 0u;
    for (;;) {
        sum = 0u; cnt = 0u; mine = 0u;
#pragma unroll
        for (unsigned j = 0; j < 16; ++j) { const unsigned c = xb_ld(&bar[XB_XCNT(j)]); sum += c; cnt += (c > 0u) ? 1u : 0u; mine = (j == x) ? c : mine; }
        if (sum == G) break;
        __builtin_amdgcn_s_sleep(1);
        if ((++sp & 255u) == 0u) { if (xb_ld(&bar[XB_TMO])) break; if (sp > XB_SPIN_CAP) { atomicAdd(&bar[XB_TMO], 1u); break; } }
    }
    nloc = mine > 0u ? mine : 1u; nx = cnt > 0u ? cnt : 1u;
}
__device__ __forceinline__ void xcd_barrier(const XcdBarrier& b) {
    asm volatile("s_waitcnt vmcnt(0)" ::: "memory");
    __syncthreads();
    if (threadIdx.x == 0) {
        unsigned* bar = b.bar;
        __builtin_amdgcn_s_waitcnt(0);
        unsigned nloc = b.st[0], nx = b.st[1];
        if (nloc == 0u) { xcd_barrier_complete(bar, b.x, nloc, nx); b.st[0] = nloc; b.st[1] = nx; }
        const unsigned old = xb_add(&bar[XB_XSUB(b.x)], 1u);
        const unsigned gen = old / nloc;
        if (old + 1u == (gen + 1u) * nloc) {
            __builtin_amdgcn_fence(__ATOMIC_RELEASE, "agent");
            asm volatile("s_waitcnt vmcnt(0)" ::: "memory");
            const unsigned og = xb_add(&bar[XB_TOP], 1u);
            const unsigned tg = og / nx;
            if (og + 1u == (tg + 1u) * nx) xb_add(&bar[XB_TOPGEN], 1u);
            else XB_SPIN(xb_ld(&bar[XB_TOPGEN]) == tg, bar);
            __builtin_amdgcn_fence(__ATOMIC_ACQUIRE, "agent");
            xb_add(&bar[XB_XGEN(b.x)], 1u);
            asm volatile("s_waitcnt vmcnt(0)" ::: "memory");
        } else {
            XB_SPIN(xb_ld(&bar[XB_XGEN(b.x)]) == gen, bar);
            __builtin_amdgcn_fence(__ATOMIC_ACQUIRE, "agent");
            asm volatile("s_waitcnt vmcnt(0)" ::: "memory");
        }
    }
    __syncthreads();
}

struct CvtJob { const float* src; int ld_src; int k0; int n0; unsigned char* dstb; int dpitch; float f8scale; int fmt6; };
__device__ __forceinline__ void cvt_load(const CvtJob& j, f32x4 (&v)[16], int lane) {
    if (j.f8scale != 0.f) { const int kr = lane >> 3, nq = lane & 7;
#pragma unroll
        for (int i = 0; i < 16; ++i) v[i] = *(const f32x4*)(j.src + (size_t)(j.k0 + 8 * i + kr) * j.ld_src + j.n0 + 4 * nq);
    } else { const int kr = lane >> 4, nq = lane & 15;
#pragma unroll
        for (int i = 0; i < 16; ++i) v[i] = *(const f32x4*)(j.src + (size_t)(j.k0 + 4 * i + kr) * j.ld_src + j.n0 + 4 * nq); }
}
__device__ __forceinline__ float f8cl(float v) { return __builtin_fminf(__builtin_fmaxf(v, -448.f), 448.f); }
__device__ __forceinline__ void cvt_finish(const CvtJob& j, const f32x4 (&v)[16], LAS float* scr, int lane) {
    const int nlo = lane & 7, kq = lane >> 3;
    if (j.f8scale != 0.f) { const int kr = lane >> 3, nq = lane & 7;
#pragma unroll
        for (int i = 0; i < 16; ++i) { LAS float* w = scr + (8 * i + kr) * 33 + 4 * nq; w[0] = v[i].x; w[1] = v[i].y; w[2] = v[i].z; w[3] = v[i].w; }
        LDS_WAIT(); asm volatile("" ::: "memory");
        const float sc = j.f8scale;
        if (j.fmt6) {
            const int n = lane & 31;
#pragma unroll
            for (int gi = 0; gi < 2; ++gi) { const int g = 2 * (lane >> 5) + gi; const LAS float* s = scr + (32 * g) * 33 + n; f32x16 lo, hi;
#pragma unroll
                for (int i = 0; i < 16; ++i) { lo[i] = __builtin_fminf(__builtin_fmaxf(s[i * 33] * sc, -7.5f), 7.5f); hi[i] = __builtin_fminf(__builtin_fmaxf(s[(16 + i) * 33] * sc, -7.5f), 7.5f); }
                const u32x6 w = __builtin_amdgcn_cvt_scalef32_2xpk16_fp6_f32(lo, hi, 1.0f);
                unsigned char* d = j.dstb + (size_t)n * j.dpitch + 16 * g;
                *(u32x4*)d = (u32x4){w[0], w[1], w[2], w[3]}; *(u32x4*)(d + 64) = (u32x4){w[4], w[5], 0u, 0u};     }
        } else
#pragma unroll
        for (int jn = 0; jn < 4; ++jn) { const int n = 8 * jn + nlo; const LAS float* s = scr + (16 * kq) * 33 + n; int w[4];
#pragma unroll
            for (int d = 0; d < 4; ++d) { int x = 0;
                x = __builtin_amdgcn_cvt_pk_fp8_f32(f8cl(s[(4 * d + 0) * 33] * sc), f8cl(s[(4 * d + 1) * 33] * sc), x, false);
                x = __builtin_amdgcn_cvt_pk_fp8_f32(f8cl(s[(4 * d + 2) * 33] * sc), f8cl(s[(4 * d + 3) * 33] * sc), x, true); w[d] = x; }
            *(u32x4*)(j.dstb + (size_t)n * j.dpitch + 16 * kq) = (u32x4){(unsigned)w[0], (unsigned)w[1], (unsigned)w[2], (unsigned)w[3]}; }
    } else { const int kr = lane >> 4, nq = lane & 15;
#pragma unroll
        for (int i = 0; i < 16; ++i) { LAS float* w = scr + (4 * i + kr) * 65 + 4 * nq; w[0] = v[i].x; w[1] = v[i].y; w[2] = v[i].z; w[3] = v[i].w; }
        LDS_WAIT(); asm volatile("" ::: "memory");
#pragma unroll
        for (int jn = 0; jn < 8; ++jn) { const int n = 8 * jn + nlo; const LAS float* s = scr + (8 * kq) * 65 + n;
            u32x4 o; o.x = pk_bf16(s[0 * 65], s[1 * 65]); o.y = pk_bf16(s[2 * 65], s[3 * 65]); o.z = pk_bf16(s[4 * 65], s[5 * 65]); o.w = pk_bf16(s[6 * 65], s[7 * 65]);
            *(u32x4*)(j.dstb + (size_t)n * j.dpitch + 16 * kq) = o; }
    }
    LDS_WAIT(); asm volatile("" ::: "memory");
}
struct CvtPtrs { const float *w_in, *w_pool, *w_out, *dwg, *dwu, *dwd, *ewg, *ewu, *ewd; unsigned char* ws; };
constexpr int CI_WIN = 32 * 64, CI_WPOOL = 16, CI_WOUT = 32 * 32, CI_DGU = 32 * 88, CI_DD = 88 * 32, CI_EGU = 16 * 224, CI_ED = 56 * 64;
constexpr int CI_NONEXP = 2 * CI_WIN + 8 * CI_WPOOL + 2 * CI_WOUT + 2 * CI_DGU + CI_DD;
constexpr int CI_TOTAL = CI_NONEXP + 8 * (2 * CI_EGU + CI_ED);
__device__ __forceinline__ unsigned char* cvt_dst(unsigned char* base, int KT, int row0, int kt) { return base + ((size_t)((row0 >> 8) * KT + kt) * 256 + (row0 & 255)) * 128; }
__device__ __forceinline__ CvtJob cvt_decode(const CvtPtrs& P, int r) {
    CvtJob j; j.f8scale = 0.f; j.dpitch = 128; j.fmt6 = 0;
    if (r < 2 * CI_WIN) { const int l = r / CI_WIN, q = r % CI_WIN, kb = q / 64, ng = q % 64; const int c0 = 64 * ng;
        j.src = P.w_in + (size_t)l * DM * ZW; j.ld_src = ZW; j.k0 = 64 * kb; j.n0 = c0 < 3072 ? c0 : c0 + 16;
        j.dstb = cvt_dst(P.ws + WS_WIN + (size_t)l * 4096 * 2048 * 2, 32, c0, kb); return j; }
    r -= 2 * CI_WIN;
    if (r < 8 * CI_WPOOL) { const int m = r / CI_WPOOL, q = r % CI_WPOOL, kb = q / 4, ng = q % 4;
        j.src = P.w_pool + (size_t)m * 65536; j.ld_src = 256; j.k0 = 64 * kb; j.n0 = 64 * ng;
        j.dstb = cvt_dst(P.ws + WS_WPOOL + (size_t)m * 65536 * 2, 4, 64 * ng, kb); return j; }
    r -= 8 * CI_WPOOL;
    if (r < 2 * CI_WOUT) { const int l = r / CI_WOUT, q = r % CI_WOUT, kb = q / 32, ng = q % 32;
        j.src = P.w_out + (size_t)l * 2048 * 2048; j.ld_src = 2048; j.k0 = 64 * kb; j.n0 = 64 * ng;
        j.dstb = cvt_dst(P.ws + WS_WOUT + (size_t)l * 2048 * 2048 * 2, 32, 64 * ng, kb); return j; }
    r -= 2 * CI_WOUT;
#if DENSE_FP8 == 1
    if (r < 2 * CI_DGU) { const int up = r / CI_DGU, q = r % CI_DGU, kb = q / 176, ng = q % 176; const int c0 = 32 * ng;
        j.src = up ? P.dwu : P.dwg; j.ld_src = 5632; j.k0 = 128 * kb; j.n0 = c0;
        j.dstb = cvt_dst(P.ws + WS_WGU, 16, 256 * (c0 >> 7) + (c0 & 127) + 128 * up, kb); j.f8scale = 64.f; return j; }
#else
    if (r < 2 * CI_DGU) { const int up = r / CI_DGU, q = r % CI_DGU, kb = q / 88, ng = q % 88; const int c0 = 64 * ng;
        j.src = up ? P.dwu : P.dwg; j.ld_src = 5632; j.k0 = 64 * kb; j.n0 = c0;
        j.dstb = cvt_dst(P.ws + WS_WGU, 32, 256 * (c0 >> 7) + (c0 & 127) + 128 * up, kb); return j; }
#endif
    r -= 2 * CI_DGU;
#if DENSE_FP8 >= 1
    if (r < CI_DD) { const int kb = r / 64, ng = r % 64;
        j.src = P.dwd; j.ld_src = 2048; j.k0 = 128 * kb; j.n0 = 32 * ng;
        j.dstb = cvt_dst(P.ws + WS_WD, 44, 32 * ng, kb); j.f8scale = 128.f; return j; }
#else
    if (r < CI_DD) { const int kb = r / 32, ng = r % 32;
        j.src = P.dwd; j.ld_src = 2048; j.k0 = 64 * kb; j.n0 = 64 * ng;
        j.dstb = cvt_dst(P.ws + WS_WD, 88, 64 * ng, kb); return j; }
#endif
    r -= CI_DD;
    { const int e = r / (2 * CI_EGU + CI_ED); int q = r % (2 * CI_EGU + CI_ED);
        if (q < 2 * CI_EGU) { const int up = q / CI_EGU; q %= CI_EGU; const int kb = q / 224, ng = q % 224, c0 = 32 * ng;
            j.src = (up ? P.ewu : P.ewg) + (size_t)e * 2048 * 7168; j.ld_src = 7168; j.k0 = 128 * kb; j.n0 = c0;
            const int row0 = 256 * (c0 >> 7) + (c0 & 127) + 128 * up;
            if (TILE_EWGU) j.dstb = cvt_dst(P.ws + WS_EWGU + (size_t)e * 14336 * 2048, 16, row0, kb);
            else { j.dstb = P.ws + WS_EWGU + (size_t)e * 14336 * 2048 + (size_t)row0 * 2048 + 128 * kb; j.dpitch = 2048; }
            j.f8scale = 64.f; j.fmt6 = (MOE_UP_FMT == 2); return j; }
        q -= 2 * CI_EGU; { const int kb = q / 64, ng = q % 64;
            j.src = P.ewd + (size_t)e * 7168 * 2048; j.ld_src = 2048; j.k0 = 128 * kb; j.n0 = 32 * ng;
            j.dstb = cvt_dst(P.ws + WS_EWD + (size_t)e * 2048 * 7168, 56, 32 * ng, kb); j.f8scale = 128.f; return j; } }
}

constexpr int NP_PITCH = 4112;
template <int MODE, bool OUT8 = false, bool INBF = true>
__device__ __forceinline__ void norm_phase(LAS unsigned char* lds, const void* xin, const float* gain, bf16_t* H, const float* Wp, int ldw,
                                           float* glr, int* topi, float* topw, int* hist, int tid, int lane, int wave, int G) {
    LAS float* Wl = (LAS float*)lds;
    LAS unsigned char* Wt = lds;
    LAS unsigned char* Ht = lds + 16 * NP_PITCH;
    LAS float* part = (LAS float*)(lds + 32 * NP_PITCH);
    LAS int* cnt = (LAS int*)(lds + 135168);
    if (MODE == 2) {
#pragma unroll
        for (int i = 0; i < 4; ++i) { const int k = tid + 512 * i;
#pragma unroll
            for (int p4 = 0; p4 < 2; ++p4) { const f32x4 w = *(const f32x4*)(Wp + (size_t)k * ldw + 4 * p4);
                Wl[(4 * p4 + 0) * 2048 + k] = w.x; Wl[(4 * p4 + 1) * 2048 + k] = w.y; Wl[(4 * p4 + 2) * 2048 + k] = w.z; Wl[(4 * p4 + 3) * 2048 + k] = w.w; } }
    }
    if (MODE == 0) {
#pragma unroll
        for (int i = 0; i < 4; ++i) { const int k = tid + 512 * i;
#pragma unroll
            for (int p4 = 0; p4 < 4; ++p4) { const f32x4 w = *(const f32x4*)(Wp + (size_t)k * ldw + 4 * p4);
                *(LAS bf16_t*)(Wt + (4 * p4 + 0) * NP_PITCH + 2 * k) = f2bf(w.x); *(LAS bf16_t*)(Wt + (4 * p4 + 1) * NP_PITCH + 2 * k) = f2bf(w.y);
                *(LAS bf16_t*)(Wt + (4 * p4 + 2) * NP_PITCH + 2 * k) = f2bf(w.z); *(LAS bf16_t*)(Wt + (4 * p4 + 3) * NP_PITCH + 2 * k) = f2bf(w.w); } }
    }
    f32x4 gv[8];
#pragma unroll
    for (int j = 0; j < 8; ++j) gv[j] = *(const f32x4*)(gain + 4 * lane + 256 * j);
#pragma unroll 1
    for (int rb = blockIdx.x; rb < T / 64; rb += G) {
        if (MODE == 2) { if (tid < 8) cnt[tid] = 0; }
        __syncthreads();
        u32x2 rawb[8]; f32x4 rawf[8];
        { const int lr0 = MODE == 0 ? 2 * wave : 8 * wave; const int row0 = 64 * rb + lr0;
#pragma unroll
            for (int j = 0; j < 8; ++j) {
                if (INBF) rawb[j] = ((const u32x2*)((const bf16_t*)xin + (size_t)row0 * DM) + lane)[64 * j];
                else rawf[j] = ((const f32x4*)((const float*)xin + (size_t)row0 * DM) + lane)[64 * j]; } }
#pragma unroll 1
        for (int r = 0; r < 8; ++r) {
            const int lrow = MODE == 0 ? 16 * (r >> 1) + 2 * wave + (r & 1) : 8 * wave + r;
            const int row = 64 * rb + lrow;
            f32x4 v[8]; float ss = 0.f;
#pragma unroll
            for (int j = 0; j < 8; ++j) {
                if (INBF) { const u32x2 q = (u32x2){rawb[j].x, rawb[j].y}; v[j] = (f32x4){bf_lo(q.x), bf_hi(q.x), bf_lo(q.y), bf_hi(q.y)}; }
                else v[j] = rawf[j];
                ss += (v[j].x * v[j].x + v[j].y * v[j].y) + (v[j].z * v[j].z + v[j].w * v[j].w); }
            { const int rn = r + 1 < 8 ? r + 1 : r;
                const int lrn = MODE == 0 ? 16 * (rn >> 1) + 2 * wave + (rn & 1) : 8 * wave + rn; const int rown = 64 * rb + lrn;
#pragma unroll
                for (int j = 0; j < 8; ++j) {
                    if (INBF) rawb[j] = ((const u32x2*)((const bf16_t*)xin + (size_t)rown * DM) + lane)[64 * j];
                    else rawf[j] = ((const f32x4*)((const float*)xin + (size_t)rown * DM) + lane)[64 * j]; } }
            const float rstd = rsqrtf(wave_sum(ss) * (1.0f / DM) + EPSF);
            u32x2* ho = TILE_H ? (u32x2*)(H + ((size_t)(row >> 8) * 32 + (lane >> 4)) * 16384 + (size_t)(row & 255) * 64 + 4 * (lane & 15)) : (u32x2*)(H + (size_t)row * DM) + lane;
            constexpr int HJ = TILE_H ? 4 * 16384 / 4 : 64;
#pragma unroll
            for (int j = 0; j < 8; ++j) { v[j] = v[j] * rstd * gv[j];
                if (OUT8) { int w = 0; w = __builtin_amdgcn_cvt_pk_fp8_f32(f8cl(4.f * v[j].x), f8cl(4.f * v[j].y), w, false); w = __builtin_amdgcn_cvt_pk_fp8_f32(f8cl(4.f * v[j].z), f8cl(4.f * v[j].w), w, true);
                    ((unsigned*)((unsigned char*)H + (size_t)row * DM))[lane + 64 * j] = (unsigned)w; }
                else { u32x2 o; o.x = pk_bf16(v[j].x, v[j].y); o.y = pk_bf16(v[j].z, v[j].w); ho[HJ * j] = o;
                    if (MODE == 0) *(LAS u32x2*)(Ht + (lrow & 15) * NP_PITCH + (4 * lane + 256 * j) * 2) = o; } }
            if (MODE == 0 && (r & 1)) {
                __syncthreads();
                f32x4 acc = (f32x4){0.f, 0.f, 0.f, 0.f};
#pragma unroll
                for (int q = 0; q < 8; ++q) { const int ks = 8 * wave + q;
                    const bf16x8 a = *(const LAS bf16x8*)(Ht + (lane & 15) * NP_PITCH + (32 * ks + 8 * (lane >> 4)) * 2);
                    const bf16x8 b = *(const LAS bf16x8*)(Wt + (lane & 15) * NP_PITCH + (32 * ks + 8 * (lane >> 4)) * 2);
                    acc = mma16(a, b, acc); }
#pragma unroll
                for (int i = 0; i < 4; ++i) part[wave * 256 + (4 * (lane >> 4) + i) * 16 + (lane & 15)] = acc[i];
                __syncthreads();
                if (tid < 256) { float s = 0.f;
#pragma unroll
                    for (int w = 0; w < 8; ++w) s += part[w * 256 + tid];
                    glr[(size_t)(64 * rb + 16 * (r >> 1) + (tid >> 4)) * 16 + (tid & 15)] = s; }
            }
            if (MODE == 2) {
                float pr[8];
#pragma unroll
                for (int p = 0; p < 8; ++p) { float s = 0.f;
#pragma unroll
                    for (int j = 0; j < 8; ++j) { const f32x4 w = *(const LAS f32x4*)(Wl + p * 2048 + 4 * lane + 256 * j); s += (v[j].x * w.x + v[j].y * w.y) + (v[j].z * w.z + v[j].w * w.w); }
                    pr[p] = s; }
                float q4[4], q2[2], q1;
#pragma unroll
                for (int e = 0; e < 4; ++e) { const bool hi = (lane & 32) != 0; const float snd = hi ? pr[e] : pr[e + 4], kp = hi ? pr[e + 4] : pr[e]; q4[e] = kp + __shfl_xor(snd, 32); }
#pragma unroll
                for (int e = 0; e < 2; ++e) { const bool hi = (lane & 16) != 0; const float snd = hi ? q4[e] : q4[e + 2], kp = hi ? q4[e + 2] : q4[e]; q2[e] = kp + __shfl_xor(snd, 16); }
                { const bool hi = (lane & 8) != 0; const float snd = hi ? q2[0] : q2[1], kp = hi ? q2[1] : q2[0]; q1 = kp + __shfl_xor(snd, 8); }
                q1 += __shfl_xor(q1, 4); q1 += __shfl_xor(q1, 2); q1 += __shfl_xor(q1, 1);
                float lg[8];
#pragma unroll
                for (int e = 0; e < 8; ++e) lg[e] = __int_as_float(__builtin_amdgcn_readlane(__float_as_int(q1), 8 * e));
                int i0 = 0; float v0 = lg[0];
#pragma unroll
                for (int e = 1; e < 8; ++e) if (lg[e] > v0) { v0 = lg[e]; i0 = e; }
                int i1 = 0; float v1 = -3.4e38f;
#pragma unroll
                for (int e = 0; e < 8; ++e) if (e != i0 && lg[e] > v1) { v1 = lg[e]; i1 = e; }
                if (lane == 0) { const float e1 = __expf(v1 - v0), inv = 1.0f / (1.0f + e1);
                    topi[2 * row] = i0; topi[2 * row + 1] = i1; topw[2 * row] = inv; topw[2 * row + 1] = e1 * inv;
                    __hip_atomic_fetch_add(cnt + i0, 1, __ATOMIC_RELAXED, __HIP_MEMORY_SCOPE_WORKGROUP); __hip_atomic_fetch_add(cnt + i1, 1, __ATOMIC_RELAXED, __HIP_MEMORY_SCOPE_WORKGROUP); }
            }
        }
        if (MODE == 2) { __syncthreads(); if (tid < 8) hist[rb * 8 + tid] = cnt[tid]; }
    }
}
template <int W> __device__ __forceinline__ void pool_d_item(const bf16_t* Z, bf16_t* DP, int t, int c) {
    float s[8];
#pragma unroll
    for (int e = 0; e < 8; ++e) s[e] = 0.f;
    u32x4 q[W];
#pragma unroll
    for (int j = 0; j < W; ++j) { const int tt = t - j; q[j] = tt >= 0 ? *(const u32x4*)(Z + (size_t)tt * 4096 + c) : (u32x4){0u, 0u, 0u, 0u}; }
#pragma unroll
    for (int j = 0; j < W; ++j) { s[0] += bf_lo(q[j].x); s[1] += bf_hi(q[j].x); s[2] += bf_lo(q[j].y); s[3] += bf_hi(q[j].y); s[4] += bf_lo(q[j].z); s[5] += bf_hi(q[j].z); s[6] += bf_lo(q[j].w); s[7] += bf_hi(q[j].w); }
    const int cnt = (t + 1) < W ? (t + 1) : W; const float inv = 1.0f / (float)cnt;
    u32x4 o;
    o.x = pk_bf16(s[0] * inv - bf_lo(q[0].x), s[1] * inv - bf_hi(q[0].x)); o.y = pk_bf16(s[2] * inv - bf_lo(q[0].y), s[3] * inv - bf_hi(q[0].y));
    o.z = pk_bf16(s[4] * inv - bf_lo(q[0].z), s[5] * inv - bf_hi(q[0].z)); o.w = pk_bf16(s[6] * inv - bf_lo(q[0].w), s[7] * inv - bf_hi(q[0].w));
    *(u32x4*)(DP + (size_t)t * 1024 + c) = o;
}
__device__ __forceinline__ void pool_d_phase(const bf16_t* Z, bf16_t* DP, int tid, int G) {
#pragma unroll 1
    for (int item = blockIdx.x * NTHR + tid; item < T * 128; item += G * NTHR) {
        const int g = item / (T * 32), r = item % (T * 32), t = r >> 5, c = g * 256 + (r & 31) * 8;
        if (g == 0) pool_d_item<2>(Z, DP, t, c); else if (g == 1) pool_d_item<4>(Z, DP, t, c); else if (g == 2) pool_d_item<8>(Z, DP, t, c); else pool_d_item<16>(Z, DP, t, c);
    }
}

constexpr int G1_LR = 0, G1_EB = 4096, G1_KD = 6144, KD_PITCH = 1040, G1_V = G1_KD + 64 * KD_PITCH, V_PITCH = 528;
__device__ __forceinline__ void gla_state_phase(LAS unsigned char* lds, bf16_t* Z, const float* GLR, const float* wgu, const float* bgate, bf16_t* CS, float* DEC,
                                                int tid, int lane, int wave, int G) {
    LAS float* lr = (LAS float*)(lds + G1_LR);
    LAS float* eb = (LAS float*)(lds + G1_EB);
    const unsigned kd_a = (unsigned)(size_t)(lds + G1_KD), v_a = (unsigned)(size_t)(lds + G1_V);
    const int g4 = lane >> 4, q4 = (lane & 15) >> 2, p4 = lane & 3;
    float W[16];
#pragma unroll
    for (int r = 0; r < 16; ++r) W[r] = wgu[r * 512 + tid];
    const float bg = bgate[tid];
#pragma unroll 1
    for (int n = blockIdx.x; n < T / 64; n += G) {
        __syncthreads();
        if (tid < 256) *(LAS f32x4*)(lr + 4 * tid) = *(const f32x4*)(GLR + (size_t)n * 1024 + 4 * tid);
#pragma unroll
        for (int i = 0; i < 8; ++i) { const int idx = tid + 512 * i, c = idx >> 6, ch = idx & 63;
            *(LAS u32x4*)(lds + G1_KD + c * KD_PITCH + ch * 16) = *(const u32x4*)(Z + (size_t)(64 * n + c) * 4096 + 1536 + 8 * ch); }
        __syncthreads();
        float bc = 0.f;
        bf16_t* zq = Z + (size_t)(64 * n) * 4096 + 1024 + tid;
#pragma unroll 1
        for (int c0 = 0; c0 < 64; c0 += 16) {
            bf16_t qv[16];
#pragma unroll
            for (int i = 0; i < 16; ++i) qv[i] = zq[(size_t)(c0 + i) * 4096];
#pragma unroll
            for (int i = 0; i < 16; ++i) { const int c = c0 + i; float s = bg;
#pragma unroll
                for (int r4 = 0; r4 < 4; ++r4) { const f32x4 a = *(const LAS f32x4*)(lr + c * 16 + 4 * r4); s += (a.x * W[4 * r4] + a.y * W[4 * r4 + 1]) + (a.z * W[4 * r4 + 2] + a.w * W[4 * r4 + 3]); }
                const float ls = fminf(s, 0.f) - __logf(1.0f + __expf(-fabsf(s)));
                bc += ls * (1.0f / 16.0f);
                const float eq = __expf(bc);
                zq[(size_t)c * 4096] = f2bf(bf2f(qv[i]) * 0.08838834764831845f * eq);
                LAS bf16_t* kp = (LAS bf16_t*)(lds + G1_KD + c * KD_PITCH + 2 * tid);
                *kp = f2bf(bf2f(*kp) * __builtin_amdgcn_rcpf(eq)); }
        }
        { const float e = __expf(bc); eb[tid] = e; DEC[(size_t)n * 512 + tid] = e; }
        __syncthreads();
#pragma unroll
        for (int i = 0; i < 8; ++i) { const int idx = tid + 512 * i, c = idx >> 6, ch = idx & 63;
            *(u32x4*)(Z + (size_t)(64 * n + c) * 4096 + 1536 + 8 * ch) = *(const LAS u32x4*)(lds + G1_KD + c * KD_PITCH + ch * 16); }
#pragma unroll 1
        for (int h = 0; h < 4; ++h) {
            if (h) __syncthreads();
#pragma unroll
            for (int i = 0; i < 4; ++i) { const int idx = tid + 512 * i, c = idx >> 5, ch = idx & 31;
                *(LAS u32x4*)(lds + G1_V + c * V_PITCH + ch * 16) = *(const u32x4*)(Z + (size_t)(64 * n + c) * 4096 + 2048 + h * 256 + 8 * ch); }
            __syncthreads();
            f32x4 acc[8][2];
#pragma unroll
            for (int mb = 0; mb < 8; ++mb) { acc[mb][0] = (f32x4){0.f, 0.f, 0.f, 0.f}; acc[mb][1] = (f32x4){0.f, 0.f, 0.f, 0.f}; }
#pragma unroll
            for (int ks = 0; ks < 2; ++ks) {
                bf16x8 bfr[2];
#pragma unroll
                for (int nb = 0; nb < 2; ++nb) { const unsigned a0 = v_a + (32 * ks + 8 * g4 + q4) * V_PITCH + (32 * wave + 16 * nb + 4 * p4) * 2; bfr[nb] = tr_frag(a0, a0 + 4 * V_PITCH); }
#pragma unroll
                for (int mb = 0; mb < 8; ++mb) { const unsigned a0 = kd_a + (32 * ks + 8 * g4 + q4) * KD_PITCH + (128 * h + 16 * mb + 4 * p4) * 2; const bf16x8 af = tr_frag(a0, a0 + 4 * KD_PITCH);
                    acc[mb][0] = mma16(af, bfr[0], acc[mb][0]); acc[mb][1] = mma16(af, bfr[1], acc[mb][1]); }
            }
            bf16_t* cs = CS + ((size_t)(n * 4 + h) * 256) * 128;
#pragma unroll
            for (int mb = 0; mb < 8; ++mb) { const f32x4 e4 = *(const LAS f32x4*)(eb + 128 * h + 16 * mb + 4 * g4);
#pragma unroll
                for (int nb = 0; nb < 2; ++nb) { const f32x4 v = acc[mb][nb] * e4; u32x2 w; w.x = pk_bf16(v[0], v[1]); w.y = pk_bf16(v[2], v[3]);
                    *(u32x2*)(cs + (size_t)(32 * wave + 16 * nb + (lane & 15)) * 128 + 16 * mb + 4 * g4) = w; } }
        }
    }
}

__device__ __forceinline__ void gla_scan_phase(const bf16_t* CS, const float* DEC, bf16_t* SP, int tid, int G) {
#pragma unroll 1
    for (int e = blockIdx.x * NTHR + tid; e < 4 * 256 * 128; e += G * NTHR) {
        const int h = e >> 15, k = e & 127;
        float S = 0.f;
        const bf16_t* cp = CS + e; const float* dp = DEC + h * 128 + k; bf16_t* sp = SP + e;
        bf16_t c0[16], c1[16]; float d0[16], d1[16];
#pragma unroll
        for (int i = 0; i < 16; ++i) { c0[i] = cp[(size_t)i * 131072]; d0[i] = dp[(size_t)i * 512]; }
#pragma unroll 1
        for (int n0 = 0; n0 < 256; n0 += 32) {
#pragma unroll
            for (int i = 0; i < 16; ++i) { c1[i] = cp[(size_t)(n0 + 16 + i) * 131072]; d1[i] = dp[(size_t)(n0 + 16 + i) * 512]; }
#pragma unroll
            for (int i = 0; i < 16; ++i) { sp[(size_t)(n0 + i) * 131072] = f2bf(S); S = fmaf(d0[i], S, bf2f(c0[i])); }
            if (n0 + 32 < 256) {
#pragma unroll
                for (int i = 0; i < 16; ++i) { c0[i] = cp[(size_t)(n0 + 32 + i) * 131072]; d0[i] = dp[(size_t)(n0 + 32 + i) * 512]; } }
#pragma unroll
            for (int i = 0; i < 16; ++i) { sp[(size_t)(n0 + 16 + i) * 131072] = f2bf(S); S = fmaf(d1[i], S, bf2f(c1[i])); }
        }
    }
}

constexpr int G3_QD = 0, QK_PITCH = 272, G3_KD = 64 * QK_PITCH, G3_V = 2 * 64 * QK_PITCH, G3_ATT = G3_V + 64 * V_PITCH, ATT_PITCH = 144,
              G3_SSQ = G3_ATT + 64 * ATT_PITCH, G3_RSTD = G3_SSQ + 2048, G3_STG = 0, STG_PITCH = 260;
static_assert(64 * STG_PITCH * 4 <= G3_ATT, "o staging aliases the q/k/v images only");
__device__ __forceinline__ void gla_out_phase(LAS unsigned char* lds, const bf16_t* Z, const bf16_t* SP, const float* gnorm, bf16_t* MIX, int tid, int lane, int wave, int G) {
    const unsigned v_a = (unsigned)(size_t)(lds + G3_V);
    const int g4 = lane >> 4, l15 = lane & 15, q4 = l15 >> 2, p4 = lane & 3;
    LAS float* ssq = (LAS float*)(lds + G3_SSQ); LAS float* rstd = (LAS float*)(lds + G3_RSTD); LAS float* stg = (LAS float*)(lds + G3_STG);
#pragma unroll 1
    for (int n = blockIdx.x; n < T / 64; n += G) {
        u32x4 nq[2], nk[2], nv[4], nr[4]; bf16x8 nsp[2][4];
#define G3_REQUEST(hh) do { \
            _Pragma("unroll") for (int i = 0; i < 2; ++i) { const int idx = tid + 512 * i, row = idx >> 4, ch = idx & 15; const bf16_t* zr = Z + (size_t)(64 * n + row) * 4096 + (hh) * 128 + 8 * ch; \
                nq[i] = *(const u32x4*)(zr + 1024); nk[i] = *(const u32x4*)(zr + 1536); } \
            _Pragma("unroll") for (int i = 0; i < 4; ++i) { const int idx = tid + 512 * i, c = idx >> 5, ch = idx & 31; nv[i] = *(const u32x4*)(Z + (size_t)(64 * n + c) * 4096 + 2048 + (hh) * 256 + 8 * ch); } \
            _Pragma("unroll") for (int i = 0; i < 4; ++i) { const int item = tid + 512 * i, row = item >> 5, c8 = (item & 31) * 8; nr[i] = *(const u32x4*)(Z + (size_t)(64 * n + row) * 4096 + 3072 + (hh) * 256 + c8); } \
            { const bf16_t* spb = SP + ((size_t)(n * 4 + (hh)) * 256) * 128; \
              _Pragma("unroll") for (int nb = 0; nb < 2; ++nb) _Pragma("unroll") for (int ks = 0; ks < 4; ++ks) nsp[nb][ks] = *(const bf16x8*)(spb + (size_t)(32 * wave + 16 * nb + l15) * 128 + 32 * ks + 8 * g4); } } while (0)
        G3_REQUEST(0);
#pragma unroll 1
        for (int h = 0; h < 4; ++h) {
            __syncthreads();
#pragma unroll
            for (int i = 0; i < 2; ++i) { const int idx = tid + 512 * i, row = idx >> 4, ch = idx & 15;
                *(LAS u32x4*)(lds + G3_QD + row * QK_PITCH + ch * 16) = nq[i]; *(LAS u32x4*)(lds + G3_KD + row * QK_PITCH + ch * 16) = nk[i]; }
#pragma unroll
            for (int i = 0; i < 4; ++i) { const int idx = tid + 512 * i, c = idx >> 5, ch = idx & 31; *(LAS u32x4*)(lds + G3_V + c * V_PITCH + ch * 16) = nv[i]; }
            u32x4 rpre[4]; bf16x8 sp[2][4];
#pragma unroll
            for (int i = 0; i < 4; ++i) rpre[i] = nr[i];
#pragma unroll
            for (int nb = 0; nb < 2; ++nb)
#pragma unroll
                for (int ks = 0; ks < 4; ++ks) sp[nb][ks] = nsp[nb][ks];
            { const int hn = h < 3 ? h + 1 : 3; G3_REQUEST(hn); }
            __syncthreads();
            f32x4 acc[4][2];
#pragma unroll
            for (int mb = 0; mb < 4; ++mb) { acc[mb][0] = (f32x4){0.f, 0.f, 0.f, 0.f}; acc[mb][1] = (f32x4){0.f, 0.f, 0.f, 0.f}; }
#pragma unroll
            for (int ks = 0; ks < 4; ++ks)
#pragma unroll
                for (int mb = 0; mb < 4; ++mb) { const bf16x8 a = *(const LAS bf16x8*)(lds + G3_QD + (16 * mb + l15) * QK_PITCH + (32 * ks + 8 * g4) * 2);
                    acc[mb][0] = mma16(a, sp[0][ks], acc[mb][0]); acc[mb][1] = mma16(a, sp[1][ks], acc[mb][1]); }
            { const int jb = wave >> 1;
#pragma unroll
                for (int ib2 = 0; ib2 < 2; ++ib2) { const int ib = 2 * (wave & 1) + ib2; f32x4 at = (f32x4){0.f, 0.f, 0.f, 0.f};
                    if (jb <= ib) {
#pragma unroll
                        for (int ks = 0; ks < 4; ++ks) { const bf16x8 a = *(const LAS bf16x8*)(lds + G3_KD + (16 * jb + l15) * QK_PITCH + (32 * ks + 8 * g4) * 2);
                            const bf16x8 b = *(const LAS bf16x8*)(lds + G3_QD + (16 * ib + l15) * QK_PITCH + (32 * ks + 8 * g4) * 2); at = mma16(a, b, at); } }
                    const int i = 16 * ib + l15, j0 = 16 * jb + 4 * g4;
                    u32x2 w; w.x = pk_bf16(j0 + 0 <= i ? at[0] : 0.f, j0 + 1 <= i ? at[1] : 0.f); w.y = pk_bf16(j0 + 2 <= i ? at[2] : 0.f, j0 + 3 <= i ? at[3] : 0.f);
                    *(LAS u32x2*)(lds + G3_ATT + i * ATT_PITCH + j0 * 2) = w; } }
            __syncthreads();
#pragma unroll
            for (int ks = 0; ks < 2; ++ks) {
                bf16x8 bfr[2];
#pragma unroll
                for (int nb = 0; nb < 2; ++nb) { const unsigned a0 = v_a + (32 * ks + 8 * g4 + q4) * V_PITCH + (32 * wave + 16 * nb + 4 * p4) * 2; bfr[nb] = tr_frag(a0, a0 + 4 * V_PITCH); }
#pragma unroll
                for (int mb = 0; mb < 4; ++mb) { const bf16x8 a = *(const LAS bf16x8*)(lds + G3_ATT + (16 * mb + l15) * ATT_PITCH + (32 * ks + 8 * g4) * 2);
                    acc[mb][0] = mma16(a, bfr[0], acc[mb][0]); acc[mb][1] = mma16(a, bfr[1], acc[mb][1]); }
            }
#pragma unroll
            for (int mb = 0; mb < 4; ++mb)
#pragma unroll
                for (int r = 0; r < 4; ++r) { float p = acc[mb][0][r] * acc[mb][0][r] + acc[mb][1][r] * acc[mb][1][r];
                    p += __shfl_xor(p, 1); p += __shfl_xor(p, 2); p += __shfl_xor(p, 4); p += __shfl_xor(p, 8);
                    if (l15 == 0) ssq[wave * 64 + 16 * mb + 4 * g4 + r] = p; }
            __syncthreads();
            if (tid < 64) { float s = 0.f;
#pragma unroll
                for (int w = 0; w < 8; ++w) s += ssq[w * 64 + tid];
                rstd[tid] = rsqrtf(s * (1.0f / 256.0f) + EPSF); }
#pragma unroll
            for (int mb = 0; mb < 4; ++mb)
#pragma unroll
                for (int nb = 0; nb < 2; ++nb)
#pragma unroll
                    for (int r = 0; r < 4; ++r) stg[(16 * mb + 4 * g4 + r) * STG_PITCH + 32 * wave + 16 * nb + l15] = acc[mb][nb][r];
            __syncthreads();
#pragma unroll
            for (int i = 0; i < 4; ++i) { const int item = tid + 512 * i, row = item >> 5, c8 = (item & 31) * 8;
                const f32x4 o0 = *(const LAS f32x4*)(stg + row * STG_PITCH + c8), o1 = *(const LAS f32x4*)(stg + row * STG_PITCH + c8 + 4);
                const float rs = rstd[row];
                const f32x4 g0 = *(const f32x4*)(gnorm + h * 256 + c8), g1 = *(const f32x4*)(gnorm + h * 256 + c8 + 4);
                const u32x4 rr = rpre[i];
                u32x4 w;
                w.x = pk_bf16(o0.x * rs * g0.x * silu_f(bf_lo(rr.x)), o0.y * rs * g0.y * silu_f(bf_hi(rr.x)));
                w.y = pk_bf16(o0.z * rs * g0.z * silu_f(bf_lo(rr.y)), o0.w * rs * g0.w * silu_f(bf_hi(rr.y)));
                w.z = pk_bf16(o1.x * rs * g1.x * silu_f(bf_lo(rr.z)), o1.y * rs * g1.y * silu_f(bf_hi(rr.z)));
                w.w = pk_bf16(o1.z * rs * g1.z * silu_f(bf_lo(rr.w)), o1.w * rs * g1.w * silu_f(bf_hi(rr.w)));
                *(u32x4*)(MIX + (size_t)(64 * n + row) * 2048 + 1024 + h * 256 + c8) = w; }
        }
    }
}

#undef G3_REQUEST
__device__ __forceinline__ void assign_phase(LAS unsigned char* lds, const int* topi, const int* hist, int* tok_slot, int* blk_expert, int* nrb_out,
                                             const bf16_t* H, bf16_t* HS, int tid, int lane, int wave, int G) {
    LAS int* lh = (LAS int*)lds;
    LAS int* tot = (LAS int*)(lds + 8192);
    LAS int* myslot = (LAS int*)(lds + 8192 + 256);
#pragma unroll
    for (int i = 0; i < 4; ++i) lh[tid + 512 * i] = __hip_atomic_load(hist + tid + 512 * i, RLX_AGENT);
    __syncthreads();
#pragma unroll 1
    for (int rb = blockIdx.x; rb < T / 64; rb += G) {
        if (tid < 48) tot[tid] = 0;
        __syncthreads();
        { const int e = tid & 7, j = tid >> 3; int t_ = 0, b_ = 0;
#pragma unroll
            for (int q = 0; q < 4; ++q) { const int bb = 4 * j + q; const int c = lh[bb * 8 + e]; t_ += c; b_ += (bb < rb) ? c : 0; }
            __hip_atomic_fetch_add(tot + e, t_, __ATOMIC_RELAXED, __HIP_MEMORY_SCOPE_WORKGROUP); __hip_atomic_fetch_add(tot + 16 + e, b_, __ATOMIC_RELAXED, __HIP_MEMORY_SCOPE_WORKGROUP); }
        __syncthreads();
        if (tid == 0) { int run = 0;
#pragma unroll
            for (int e = 0; e < 8; ++e) { const int pd = ((tot[e] + 255) >> 8) << 8; tot[8 + e] = pd; tot[24 + e] = run + tot[16 + e]; run += pd; tot[40 + e] = run; }
            if (rb == 0) *nrb_out = run >> 8; }
        __syncthreads();
        if (rb == 0 && tid < NRB_MAX) { int e = 0;
#pragma unroll
            for (int q = 0; q < 8; ++q) e += (tot[40 + q] <= tid * 256) ? 1 : 0;
            blk_expert[tid] = e < 7 ? e : 7; }
        int my_e = 0, my_rank = 0;
        if (wave < 2) { my_e = topi[128 * rb + tid];
#pragma unroll
            for (int e = 0; e < 8; ++e) { const unsigned long long m = __ballot(my_e == e);
                if (my_e == e) my_rank = __popcll(m & ((1ull << lane) - 1ull));
                if (wave == 0 && lane == 0) tot[32 + e] = __popcll(m); } }
        __syncthreads();
        if (wave < 2) { const int s = tot[24 + my_e] + my_rank + (wave == 1 ? tot[32 + my_e] : 0); myslot[tid] = s; tok_slot[128 * rb + tid] = s; }
        __syncthreads();
#pragma unroll 1
        for (int i0 = wave; i0 < 128; i0 += 32) {
#if MOE_UP_FMT == 2
            u32x4 v[4][4]; int sl[4];
#pragma unroll
            for (int k = 0; k < 4; ++k) { const int i = i0 + 8 * k; const int t = 64 * rb + (i >> 1); sl[k] = myslot[i];
#pragma unroll
                for (int q = 0; q < 4; ++q) v[k][q] = ((const u32x4*)(H + (size_t)t * DM))[4 * lane + q]; }
#pragma unroll
            for (int k = 0; k < 4; ++k) { f32x16 lo, hi;
#pragma unroll
                for (int q = 0; q < 2; ++q) { const u32x4 x = v[k][q], y = v[k][2 + q];
                    lo[8 * q + 0] = bf_lo(x.x); lo[8 * q + 1] = bf_hi(x.x); lo[8 * q + 2] = bf_lo(x.y); lo[8 * q + 3] = bf_hi(x.y); lo[8 * q + 4] = bf_lo(x.z); lo[8 * q + 5] = bf_hi(x.z); lo[8 * q + 6] = bf_lo(x.w); lo[8 * q + 7] = bf_hi(x.w);
                    hi[8 * q + 0] = bf_lo(y.x); hi[8 * q + 1] = bf_hi(y.x); hi[8 * q + 2] = bf_lo(y.y); hi[8 * q + 3] = bf_hi(y.y); hi[8 * q + 4] = bf_lo(y.z); hi[8 * q + 5] = bf_hi(y.z); hi[8 * q + 6] = bf_lo(y.w); hi[8 * q + 7] = bf_hi(y.w); }
#pragma unroll
                for (int i = 0; i < 16; ++i) { lo[i] = __builtin_fminf(__builtin_fmaxf(2.f * lo[i], -7.5f), 7.5f); hi[i] = __builtin_fminf(__builtin_fmaxf(2.f * hi[i], -7.5f), 7.5f); }
                const u32x6 w = __builtin_amdgcn_cvt_scalef32_2xpk16_fp6_f32(lo, hi, 1.0f);
                unsigned char* d = (TILE_HS ? (unsigned char*)HS + (size_t)(sl[k] >> 8) * (16 * 32768) + (size_t)(sl[k] & 255) * 128 + (size_t)(lane >> 2) * 32768
                                            : (unsigned char*)HS + (size_t)sl[k] * DM + (lane >> 2) * 128) + 16 * (lane & 3);
                *(u32x4*)d = (u32x4){w[0], w[1], w[2], w[3]}; *(u32x4*)(d + 64) = (u32x4){w[4], w[5], 0u, 0u};     }
#else
            u32x4 v[4][4]; int sl[4];
#pragma unroll
            for (int k = 0; k < 4; ++k) { const int i = i0 + 8 * k; const int t = 64 * rb + (i >> 1); sl[k] = myslot[i];
#pragma unroll
                for (int q = 0; q < 4; ++q) { const int ch = lane + 64 * q;
                    v[k][q] = TILE_H ? *(const u32x4*)(H + ((size_t)(t >> 8) * 32 + (ch >> 3)) * 16384 + (size_t)(t & 255) * 64 + (ch & 7) * 8) : ((const u32x4*)(H + (size_t)t * DM))[ch]; } }
#pragma unroll
            for (int k = 0; k < 4; ++k) { unsigned char* drow = TILE_HS ? (unsigned char*)HS + (size_t)(sl[k] >> 8) * (16 * 32768) + (size_t)(sl[k] & 255) * 128 : (unsigned char*)HS + (size_t)sl[k] * DM;
#pragma unroll
                for (int q = 0; q < 4; ++q) { const u32x4 x = v[k][q]; int w0 = 0, w1 = 0;
                    w0 = __builtin_amdgcn_cvt_pk_fp8_f32(4.f * bf_lo(x.x), 4.f * bf_hi(x.x), w0, false); w0 = __builtin_amdgcn_cvt_pk_fp8_f32(4.f * bf_lo(x.y), 4.f * bf_hi(x.y), w0, true);
                    w1 = __builtin_amdgcn_cvt_pk_fp8_f32(4.f * bf_lo(x.z), 4.f * bf_hi(x.z), w1, false); w1 = __builtin_amdgcn_cvt_pk_fp8_f32(4.f * bf_lo(x.w), 4.f * bf_hi(x.w), w1, true);
                    const int ch = lane + 64 * q;
                    *(u32x2*)(TILE_HS ? drow + (size_t)(ch >> 4) * 32768 + 8 * (ch & 15) : drow + 8 * ch) = (u32x2){(unsigned)w0, (unsigned)w1}; } }
#endif
        }
        __syncthreads();
    }
}

__device__ __forceinline__ void final_phase(LAS unsigned char* lds, const bf16_t* XS, const bf16_t* Y, const float* P, const int* nrb_p, const int* tok_slot, const float* topw,
                                            const float* gain, float* out, int tid, int lane, int wave, int G) {
    LAS int* tbl = (LAS int*)lds;
    const int nrb = __builtin_amdgcn_readfirstlane(__hip_atomic_load(nrb_p, RLX_AGENT));
    int full, tail, sk; moe_tail_split(nrb, G, full, tail, sk);
    for (int i = tid; i < NRB_MAX * 8; i += NTHR) tbl[i] = -1;
    __syncthreads();
    if (tid < tail) { int pm, pn; pg8::unit_map((long)full + tid, nrb, 8, pm, pn); tbl[pm * 8 + pn] = tid; }
    __syncthreads();
    f32x4 gv[8];
#pragma unroll
    for (int j = 0; j < 8; ++j) gv[j] = *(const f32x4*)(gain + 4 * lane + 256 * j);
    const int rstep = G * 8, rfirst = blockIdx.x * 8 + wave;
    if (rfirst >= T) return;
    auto clampr = [&](int r) { return r < T ? r : rfirst; };
    int cs0 = tok_slot[2 * rfirst], cs1 = tok_slot[2 * rfirst + 1]; float cw0 = topw[2 * rfirst], cw1 = topw[2 * rfirst + 1];
    int r1 = clampr(rfirst + rstep);
    int ns0 = tok_slot[2 * r1], ns1 = tok_slot[2 * r1 + 1]; float nw0 = topw[2 * r1], nw1 = topw[2 * r1 + 1];
    u32x2 px[8], py0[8], py1[8];
#pragma unroll
    for (int j = 0; j < 8; ++j) { px[j] = ((const u32x2*)(XS + (size_t)rfirst * DM) + lane)[64 * j]; py0[j] = ((const u32x2*)(Y + (size_t)cs0 * DM) + lane)[64 * j]; py1[j] = ((const u32x2*)(Y + (size_t)cs1 * DM) + lane)[64 * j]; }
#pragma unroll 1
    for (int row = rfirst; row < T; row += rstep) {
        const int s0 = cs0, s1 = cs1; const float w0 = cw0, w1 = cw1;
        u32x2 cx[8], cy0[8], cy1[8];
#pragma unroll
        for (int j = 0; j < 8; ++j) { cx[j] = px[j]; cy0[j] = py0[j]; cy1[j] = py1[j]; }
        { const int rn = clampr(row + rstep), rnn = clampr(row + 2 * rstep);
#pragma unroll
            for (int j = 0; j < 8; ++j) { px[j] = ((const u32x2*)(XS + (size_t)rn * DM) + lane)[64 * j]; py0[j] = ((const u32x2*)(Y + (size_t)ns0 * DM) + lane)[64 * j]; py1[j] = ((const u32x2*)(Y + (size_t)ns1 * DM) + lane)[64 * j]; }
            cs0 = ns0; cs1 = ns1; cw0 = nw0; cw1 = nw1;
            ns0 = tok_slot[2 * rnn]; ns1 = tok_slot[2 * rnn + 1]; nw0 = topw[2 * rnn]; nw1 = topw[2 * rnn + 1]; }
        f32x4 v[8]; float ss = 0.f;
        int anyt = -1;
#pragma unroll
        for (int j = 0; j < 8; ++j) { const int t0 = tbl[(s0 >> 8) * 8 + j], t1 = tbl[(s1 >> 8) * 8 + j]; anyt = t0 > anyt ? t0 : anyt; anyt = t1 > anyt ? t1 : anyt; }
        if (anyt < 0) {
#pragma unroll
            for (int j = 0; j < 8; ++j) { const u32x2 q = cx[j], a = cy0[j], b = cy1[j];
                v[j].x = bf_lo(q.x) + w0 * bf_lo(a.x) + w1 * bf_lo(b.x); v[j].y = bf_hi(q.x) + w0 * bf_hi(a.x) + w1 * bf_hi(b.x);
                v[j].z = bf_lo(q.y) + w0 * bf_lo(a.y) + w1 * bf_lo(b.y); v[j].w = bf_hi(q.y) + w0 * bf_hi(a.y) + w1 * bf_hi(b.y); }
        } else {
#pragma unroll 1
            for (int j = 0; j < 8; ++j) { { const u32x2 q = ((const u32x2*)(XS + (size_t)row * DM) + lane)[64 * j]; v[j] = (f32x4){bf_lo(q.x), bf_hi(q.x), bf_lo(q.y), bf_hi(q.y)}; }
#pragma unroll 1
                for (int k = 0; k < 2; ++k) { const int sl = k ? s1 : s0; const float w = k ? w1 : w0;
                    const int t = tbl[(sl >> 8) * 8 + j]; f32x4 y;
                    if (t >= 0) { y = (f32x4){0.f, 0.f, 0.f, 0.f};
                        for (int q = 0; q < sk; ++q) y += *(const f32x4*)(P + ((size_t)(t * sk + q) * 256 + (sl & 255)) * 256 + 4 * lane); }
                    else { const u32x2 a = ((const u32x2*)(Y + (size_t)sl * DM) + lane)[64 * j]; y = (f32x4){bf_lo(a.x), bf_hi(a.x), bf_lo(a.y), bf_hi(a.y)}; }
                    v[j] += w * y; } }
        }
#pragma unroll
        for (int j = 0; j < 8; ++j) ss += (v[j].x * v[j].x + v[j].y * v[j].y) + (v[j].z * v[j].z + v[j].w * v[j].w);
        const float rstd = rsqrtf(wave_sum(ss) * (1.0f / DM) + EPSF);
        f32x4* orow = (f32x4*)(out + (size_t)row * DM) + lane;
#pragma unroll
        for (int j = 0; j < 8; ++j) orow[64 * j] = v[j] * rstd * gv[j];
    }
}
#ifdef NO_GEMM
#define GEMMCALL(...) ;
#else
#define GEMMCALL(...) __VA_ARGS__
#endif
#ifdef NO_CVT
#define CVTCALL(...) ;
#else
#define CVTCALL(...) __VA_ARGS__
#endif
#ifdef NO_NORM
#define NORMCALL(...) ;
#else
#define NORMCALL(...) __VA_ARGS__
#endif
#ifdef NO_PRE
#define PRECALL(...) ;
#else
#define PRECALL(...) __VA_ARGS__
#endif
#ifdef NO_SCAN
#define SCANCALL(...) ;
#else
#define SCANCALL(...) __VA_ARGS__
#endif
#ifdef NO_OUT
#define OUTCALL(...) ;
#else
#define OUTCALL(...) __VA_ARGS__
#endif
#ifdef NO_ASG
#define ASGCALL(...) ;
#else
#define ASGCALL(...) __VA_ARGS__
#endif
#ifdef NO_FIN
#define FINCALL(...) ;
#else
#define FINCALL(...) __VA_ARGS__
#endif
struct Args { const float* in[18]; float* out; unsigned char* ws; int ph_lo, ph_hi, cvt_items, pad; };

__global__ void __launch_bounds__(NTHR, 2) fwd(Args args) {
    extern __shared__ __attribute__((aligned(16))) unsigned char lds_raw[];
    LAS unsigned char* lds = (LAS unsigned char*)lds_raw;
    volatile LAS unsigned* MISC = (volatile LAS unsigned*)(lds + MISC_OFF);
    const int tid = threadIdx.x, lane = tid & 63, wave = __builtin_amdgcn_readfirstlane(tid >> 6);
    const int G = gridDim.x;
    unsigned char* ws = args.ws;
    unsigned* ctl = (unsigned*)(ws + WS_CTL);
    const int lo = args.ph_lo, hi = args.ph_hi;
    if (tid < 64) MISC[tid] = 0u;
    __syncthreads();
    XcdBarrier bar; bar.bar = ctl + CW_BAR; bar.x = 0; bar.st = nullptr;
    if (hi - lo > 1) bar = xcd_barrier_post(ctl + CW_BAR, MISC + 8);
#define IN(k) (lo <= (k) && (k) < hi)
#define SEAM(k) do { if (IN(k) && IN((k) + 1)) xcd_barrier(bar); } while (0)

    const float* x = args.in[0]; const float* mix_norm = args.in[1]; const float* w_in = args.in[2]; const float* pool_scale = args.in[4];
    const float* w_gate_up = args.in[5]; const float* b_gate = args.in[6]; const float* gla_norm = args.in[7]; const float* ffn_norm = args.in[9];
    const float* w_router = args.in[13]; const float* final_norm = args.in[17];
    bf16_t* H = (bf16_t*)(ws + WS_H); bf16_t* XS = (bf16_t*)(ws + WS_XS); float* GLR = (float*)(ws + WS_GLR);
    bf16_t* Z = (bf16_t*)(ws + WS_Z); bf16_t* DP = (bf16_t*)(ws + WS_DP); bf16_t* MIX = (bf16_t*)(ws + WS_MIX);
    bf16_t* CS = (bf16_t*)(ws + WS_CS); bf16_t* SP = (bf16_t*)(ws + WS_SP); float* DEC = (float*)(ws + WS_DEC);
    bf16_t* ACT = (bf16_t*)(ws + WS_ACT); bf16_t* HS = (bf16_t*)(ws + WS_HS); bf16_t* ACT2 = (bf16_t*)(ws + WS_ACT2); bf16_t* Y = (bf16_t*)(ws + WS_Y);
    int* topi = (int*)(ws + WS_ROUTE + RT_TOPI); float* topw = (float*)(ws + WS_ROUTE + RT_TOPW); int* tok_slot = (int*)(ws + WS_ROUTE + RT_TOKSLOT);
    int* hist = (int*)(ws + WS_ROUTE + RT_HIST); int* blk_expert = (int*)(ws + WS_ROUTE + RT_BLKE); int* nrb_p = (int*)(ws + WS_ROUTE + RT_NRB);

    if (IN(PH_PRO)) {
        CvtPtrs P; P.w_in = w_in; P.w_pool = args.in[3]; P.w_out = args.in[8]; P.dwg = args.in[10]; P.dwu = args.in[11]; P.dwd = args.in[12];
        P.ewg = args.in[14]; P.ewu = args.in[15]; P.ewd = args.in[16]; P.ws = ws;
        LAS float* scr = (LAS float*)(lds + wave * 17408);
        const int gw = blockIdx.x * 8 + wave, NGW = G * 8;
        CVTCALL({ const int nit = args.cvt_items;
            if (gw < nit) { f32x4 va[16], vb[16]; CvtJob ja = cvt_decode(P, gw), jb; cvt_load(ja, va, lane);
                _Pragma("unroll 1") for (int it = gw; it < nit; it += 2 * NGW) {
                    const int i2 = it + NGW, i3 = i2 + NGW;
                    jb = cvt_decode(P, i2 < nit ? i2 : nit - 1); cvt_load(jb, vb, lane);
                    cvt_finish(ja, va, scr, lane);
                    ja = cvt_decode(P, i3 < nit ? i3 : nit - 1); cvt_load(ja, va, lane);
                    if (i2 < nit) cvt_finish(jb, vb, scr, lane);
                } } })
        __syncthreads();
        NORMCALL(norm_phase<0, false, false>(lds, x, mix_norm, H, w_in + 3072, ZW, GLR, nullptr, nullptr, nullptr, tid, lane, wave, G);)
    }
    SEAM(PH_PRO);

    { constexpr int l = 0;
        const int pb = 1 + PH_PER_LAYER * l;
        if (IN(pb + PK_INPROJ)) {
            pg8::Gemm g{TILE_H ? 64 : 2048, 64, 2048, 0, 0, TILE_H ? 32768 : 128, 32768}; pg8::Order<false> S; S.init(T / 256, 16, G, (int)blockIdx.x);
            S.A = (const char*)H; S.B = (const char*)(ws + WS_WIN) + (size_t)l * 4096 * 2048 * 2; S.a_pm = (size_t)256 * 2048 * 2; S.a_pn = 0; S.b_pn = (size_t)256 * 2048 * 2; S.b_e = 0; S.blk_expert = nullptr;
            pg8::EpiBf16 E{Z, 4096, nullptr};
            GEMMCALL(pg8::gemm_phase<pg8::EpiBf16, pg8::Order<false>, GEMM_ALIGN, GEMM_SP2>(lds, g, S, E);)
        }
        SEAM(pb + PK_INPROJ);
        if (IN(pb + PK_PRE)) {
            PRECALL(pool_d_phase(Z, DP, tid, G);)
            PRECALL(gla_state_phase(lds, Z, GLR, w_gate_up + (size_t)l * 16 * 512, b_gate + l * 512, CS, DEC, tid, lane, wave, G);)
        }
        SEAM(pb + PK_PRE);
        if (IN(pb + PK_POOLSCAN)) {
            SCANCALL(gla_scan_phase(CS, DEC, SP, tid, G);)
            __syncthreads();
            pg8::Gemm g{1024, 64, 256, 0, 0, 128, 32768}; pg8::Order<false> S; S.init(T / 256, 4, G, (int)blockIdx.x);
            S.A = (const char*)DP; S.B = (const char*)(ws + WS_WPOOL) + (size_t)l * 4 * 65536 * 2; S.a_pm = (size_t)256 * 1024 * 2; S.a_pn = 256 * 2; S.b_pn = (size_t)65536 * 2; S.b_e = 0; S.blk_expert = nullptr;
            pg8::EpiBf16 E{MIX, 2048, pool_scale + l * 1024};
            GEMMCALL(pg8::gemm_phase<pg8::EpiBf16, pg8::Order<false>, GEMM_ALIGN, GEMM_SP2>(lds, g, S, E);)
        }
        SEAM(pb + PK_POOLSCAN);
        if (IN(pb + PK_GLAOUT)) OUTCALL(gla_out_phase(lds, Z, SP, gla_norm + l * 1024, MIX, tid, lane, wave, G);)
        SEAM(pb + PK_GLAOUT);
        if (IN(pb + PK_OUTPROJ)) {
            pg8::Gemm g{2048, 64, 2048, 0, 0, 128, 32768}; pg8::Order<false> S; S.init(T / 256, 8, G, (int)blockIdx.x);
            S.A = (const char*)MIX; S.B = (const char*)(ws + WS_WOUT) + (size_t)l * 2048 * 2048 * 2; S.a_pm = (size_t)256 * 2048 * 2; S.a_pn = 0; S.b_pn = (size_t)256 * 2048 * 2; S.b_e = 0; S.blk_expert = nullptr;
            pg8::EpiRes<l == 0> E{l == 0 ? (const void*)x : (const void*)XS, XS, 2048};
            GEMMCALL(pg8::gemm_phase<pg8::EpiRes<l == 0>, pg8::Order<false>, true, true>(lds, g, S, E);)
        }
        SEAM(pb + PK_OUTPROJ);
        if (IN(pb + PK_NORM2)) {
            if (l == 0) NORMCALL(norm_phase<1, DENSE_FP8 == 1>(lds, XS, ffn_norm, H, nullptr, 0, nullptr, nullptr, nullptr, nullptr, tid, lane, wave, G);)
            else NORMCALL(norm_phase<2>(lds, XS, ffn_norm + DM, H, w_router, 8, nullptr, topi, topw, hist, tid, lane, wave, G);)
        }
        SEAM(pb + PK_NORM2);
        if (l == 1) { if (IN(pb + PK_ASSIGN)) ASGCALL(assign_phase(lds, topi, hist, tok_slot, blk_expert, nrb_p, H, HS, tid, lane, wave, G);)
            SEAM(pb + PK_ASSIGN); }
        if (IN(pb + PK_UP)) {
            if (l == 0) {
#if DENSE_FP8 == 1
                pg8::Gemm g{1024, 64, 1024, 0, 0x7f7f7f77, 128, 32768}; pg8::Order<false> S; S.init(T / 256, 44, G, (int)blockIdx.x);
                S.A = (const char*)H; S.B = (const char*)(ws + WS_WGU); S.a_pm = (size_t)256 * 2048; S.a_pn = 0; S.b_pn = (size_t)256 * 2048; S.b_e = 0; S.blk_expert = nullptr;
                pg8::EpiSwigluF8 E{(unsigned char*)ACT, 44, 4.f};
                GEMMCALL(pg8::gemm_phase<pg8::EpiSwigluF8, pg8::Order<false>, GEMM_ALIGN, GEMM_SP2, 1>(lds, g, S, E);)
#else
                pg8::Gemm g{TILE_H ? 64 : 2048, 64, 2048, 0, 0, TILE_H ? 32768 : 128, 32768}; pg8::Order<false> S; S.init(T / 256, 44, G, (int)blockIdx.x);
                S.A = (const char*)H; S.B = (const char*)(ws + WS_WGU); S.a_pm = (size_t)256 * 2048 * 2; S.a_pn = 0; S.b_pn = (size_t)256 * 2048 * 2; S.b_e = 0; S.blk_expert = nullptr;
#if DENSE_FP8 == 2
                pg8::EpiSwigluF8S E{(unsigned char*)ACT, 44, 4.f};
#if defined(KPROBE) && KPROBE_PHASE == 8
                if (args.pad) { GEMMCALL(pg8::gemm_phase<pg8::EpiSwigluF8S, pg8::Order<false>, true, GEMM_SP2, 0, KPROBE>(lds, g, S, E);) } else
#endif
                GEMMCALL(pg8::gemm_phase<pg8::EpiSwigluF8S, pg8::Order<false>, true, GEMM_SP2>(lds, g, S, E);)
#else
                pg8::EpiSwiglu E{ACT, TILE_ACT ? 88 : -11264};
                GEMMCALL(pg8::gemm_phase<pg8::EpiSwiglu, pg8::Order<false>, GEMM_ALIGN, GEMM_SP2>(lds, g, S, E);)
#endif
#endif
            } else {
                const int nrb = __builtin_amdgcn_readfirstlane(__hip_atomic_load(nrb_p, RLX_AGENT));
                pg8::Gemm g{TILE_HS ? 64 : 1024, TILE_EWGU ? 64 : 1024, 1024, 0, MOE_UP_FMT == 2 ? 0x7f7f7f78 : 0x7f7f7f77, TILE_HS ? 32768 : 128, TILE_EWGU ? 32768 : 128}; pg8::Order<true> S; S.init(nrb, 56, G, (int)blockIdx.x);
                S.A = (const char*)HS; S.B = (const char*)(ws + WS_EWGU); S.a_pm = (size_t)256 * 2048; S.a_pn = 0; S.b_pn = (size_t)256 * 2048; S.b_e = (size_t)14336 * 2048; S.blk_expert = blk_expert;
                pg8::EpiSwigluF8S E{(unsigned char*)ACT2, 56, 4.f};
                GEMMCALL(pg8::gemm_phase<pg8::EpiSwigluF8S, pg8::Order<true>, true, GEMM_SP2, MOE_UP_FMT>(lds, g, S, E);)
            }
        }
        SEAM(pb + PK_UP);
        if (IN(pb + PK_DOWN)) {
            if (l == 0) {
#if DENSE_FP8
                pg8::Gemm g{64, 64, 2816, 0, 0x7f7f7f76, 32768, 32768}; pg8::Order<false> S; S.init(T / 256, 8, G, (int)blockIdx.x);
                S.A = (const char*)ACT; S.B = (const char*)(ws + WS_WD); S.a_pm = (size_t)256 * 5632; S.a_pn = 0; S.b_pn = (size_t)256 * 5632; S.b_e = 0; S.blk_expert = nullptr;
                pg8::EpiRes<false> E{XS, XS, 2048};
                GEMMCALL(pg8::gemm_phase<pg8::EpiRes<false>, pg8::Order<false>, true, true, 1>(lds, g, S, E);)
#else
                pg8::Gemm g{TILE_ACT ? 64 : 5632, 64, 5632, 0, 0, TILE_ACT ? 32768 : 128, 32768}; pg8::Order<false> S; S.init(T / 256, 8, G, (int)blockIdx.x);
                S.A = (const char*)ACT; S.B = (const char*)(ws + WS_WD); S.a_pm = (size_t)256 * 5632 * 2; S.a_pn = 0; S.b_pn = (size_t)256 * 5632 * 2; S.b_e = 0; S.blk_expert = nullptr;
                pg8::EpiRes<false> E{XS, XS, 2048};
                GEMMCALL(pg8::gemm_phase<pg8::EpiRes<false>, pg8::Order<false>, true, true>(lds, g, S, E);)
#endif
            } else {
                const int nrb = __builtin_amdgcn_readfirstlane(__hip_atomic_load(nrb_p, RLX_AGENT));
                pg8::Gemm g{TILE_ACT2 ? 64 : 3584, 64, 3584, 0, 0x7f7f7f76, TILE_ACT2 ? 32768 : 128, 32768}; pg8::Order<true> S; S.init(nrb, 8, G, (int)blockIdx.x);
                S.A = (const char*)ACT2; S.B = (const char*)(ws + WS_EWD); S.a_pm = (size_t)256 * 7168; S.a_pn = 0; S.b_pn = (size_t)256 * 7168; S.b_e = (size_t)2048 * 7168; S.blk_expert = blk_expert;
                int full, tail, sk; moe_tail_split(nrb, G, full, tail, sk); S.Lend = full;
                pg8::EpiBf16 E{Y, 2048, nullptr};
                GEMMCALL(pg8::gemm_phase<pg8::EpiBf16, pg8::Order<true>, GEMM_ALIGN, GEMM_SP2, 1>(lds, g, S, E);)
                if (sk > 0) {
                    const int kq = 3584 / sk;
                    pg8::Gemm g2{TILE_ACT2 ? 64 : 3584, 64, kq, 0, 0x7f7f7f76, TILE_ACT2 ? 32768 : 128, 32768}; pg8::TailOrder S2; S2.nM = nrb; S2.nN = 8; S2.c = (int)blockIdx.x; S2.full = full; S2.tail = tail; S2.s = sk; S2.ksliceA = TILE_ACT2 ? (size_t)(kq / 64) * 32768 : (size_t)kq * 2; S2.ksliceB = (size_t)(kq / 64) * 32768;
                    S2.A = (const char*)ACT2; S2.B = (const char*)(ws + WS_EWD); S2.a_pm = (size_t)256 * 7168; S2.b_pn = (size_t)256 * 7168; S2.b_e = (size_t)2048 * 7168; S2.blk_expert = blk_expert;
                    pg8::EpiPart E2{(float*)(ws + WS_PART)};
                    GEMMCALL(pg8::gemm_phase<pg8::EpiPart, pg8::TailOrder, false, GEMM_SP2, 1>(lds, g2, S2, E2);)
                }
            }
        }
        SEAM(pb + PK_DOWN);
        if (IN(pb + PK_TAIL)) {
            if (l == 0) NORMCALL(norm_phase<0>(lds, XS, mix_norm + DM, H, w_in + (size_t)DM * ZW + 3072, ZW, GLR, nullptr, nullptr, nullptr, tid, lane, wave, G);)
            else FINCALL(final_phase(lds, XS, Y, (const float*)(ws + WS_PART), nrb_p, tok_slot, topw, final_norm, args.out, tid, lane, wave, G);)
        }
        if (l == 0) SEAM(pb + PK_TAIL);
    }
    { constexpr int l = 1;
        const int pb = 1 + PH_PER_LAYER * l;
        if (IN(pb + PK_INPROJ)) {
            pg8::Gemm g{TILE_H ? 64 : 2048, 64, 2048, 0, 0, TILE_H ? 32768 : 128, 32768}; pg8::Order<false> S; S.init(T / 256, 16, G, (int)blockIdx.x);
            S.A = (const char*)H; S.B = (const char*)(ws + WS_WIN) + (size_t)l * 4096 * 2048 * 2; S.a_pm = (size_t)256 * 2048 * 2; S.a_pn = 0; S.b_pn = (size_t)256 * 2048 * 2; S.b_e = 0; S.blk_expert = nullptr;
            pg8::EpiBf16 E{Z, 4096, nullptr};
            GEMMCALL(pg8::gemm_phase<pg8::EpiBf16, pg8::Order<false>, GEMM_ALIGN, GEMM_SP2>(lds, g, S, E);)
        }
        SEAM(pb + PK_INPROJ);
        if (IN(pb + PK_PRE)) {
            PRECALL(pool_d_phase(Z, DP, tid, G);)
            PRECALL(gla_state_phase(lds, Z, GLR, w_gate_up + (size_t)l * 16 * 512, b_gate + l * 512, CS, DEC, tid, lane, wave, G);)
        }
        SEAM(pb + PK_PRE);
        if (IN(pb + PK_POOLSCAN)) {
            SCANCALL(gla_scan_phase(CS, DEC, SP, tid, G);)
            __syncthreads();
            pg8::Gemm g{1024, 64, 256, 0, 0, 128, 32768}; pg8::Order<false> S; S.init(T / 256, 4, G, (int)blockIdx.x);
            S.A = (const char*)DP; S.B = (const char*)(ws + WS_WPOOL) + (size_t)l * 4 * 65536 * 2; S.a_pm = (size_t)256 * 1024 * 2; S.a_pn = 256 * 2; S.b_pn = (size_t)65536 * 2; S.b_e = 0; S.blk_expert = nullptr;
            pg8::EpiBf16 E{MIX, 2048, pool_scale + l * 1024};
            GEMMCALL(pg8::gemm_phase<pg8::EpiBf16, pg8::Order<false>, GEMM_ALIGN, GEMM_SP2>(lds, g, S, E);)
        }
        SEAM(pb + PK_POOLSCAN);
        if (IN(pb + PK_GLAOUT)) OUTCALL(gla_out_phase(lds, Z, SP, gla_norm + l * 1024, MIX, tid, lane, wave, G);)
        SEAM(pb + PK_GLAOUT);
        if (IN(pb + PK_OUTPROJ)) {
            pg8::Gemm g{2048, 64, 2048, 0, 0, 128, 32768}; pg8::Order<false> S; S.init(T / 256, 8, G, (int)blockIdx.x);
            S.A = (const char*)MIX; S.B = (const char*)(ws + WS_WOUT) + (size_t)l * 2048 * 2048 * 2; S.a_pm = (size_t)256 * 2048 * 2; S.a_pn = 0; S.b_pn = (size_t)256 * 2048 * 2; S.b_e = 0; S.blk_expert = nullptr;
            pg8::EpiRes<l == 0> E{l == 0 ? (const void*)x : (const void*)XS, XS, 2048};
            GEMMCALL(pg8::gemm_phase<pg8::EpiRes<l == 0>, pg8::Order<false>, true, true>(lds, g, S, E);)
        }
        SEAM(pb + PK_OUTPROJ);
        if (IN(pb + PK_NORM2)) {
            if (l == 0) NORMCALL(norm_phase<1, DENSE_FP8 == 1>(lds, XS, ffn_norm, H, nullptr, 0, nullptr, nullptr, nullptr, nullptr, tid, lane, wave, G);)
            else NORMCALL(norm_phase<2>(lds, XS, ffn_norm + DM, H, w_router, 8, nullptr, topi, topw, hist, tid, lane, wave, G);)
        }
        SEAM(pb + PK_NORM2);
        if (l == 1) { if (IN(pb + PK_ASSIGN)) ASGCALL(assign_phase(lds, topi, hist, tok_slot, blk_expert, nrb_p, H, HS, tid, lane, wave, G);)
            SEAM(pb + PK_ASSIGN); }
        if (IN(pb + PK_UP)) {
            if (l == 0) {
#if DENSE_FP8 == 1
                pg8::Gemm g{1024, 64, 1024, 0, 0x7f7f7f77, 128, 32768}; pg8::Order<false> S; S.init(T / 256, 44, G, (int)blockIdx.x);
                S.A = (const char*)H; S.B = (const char*)(ws + WS_WGU); S.a_pm = (size_t)256 * 2048; S.a_pn = 0; S.b_pn = (size_t)256 * 2048; S.b_e = 0; S.blk_expert = nullptr;
                pg8::EpiSwigluF8 E{(unsigned char*)ACT, 44, 4.f};
                GEMMCALL(pg8::gemm_phase<pg8::EpiSwigluF8, pg8::Order<false>, GEMM_ALIGN, GEMM_SP2, 1>(lds, g, S, E);)
#else
                pg8::Gemm g{TILE_H ? 64 : 2048, 64, 2048, 0, 0, TILE_H ? 32768 : 128, 32768}; pg8::Order<false> S; S.init(T / 256, 44, G, (int)blockIdx.x);
                S.A = (const char*)H; S.B = (const char*)(ws + WS_WGU); S.a_pm = (size_t)256 * 2048 * 2; S.a_pn = 0; S.b_pn = (size_t)256 * 2048 * 2; S.b_e = 0; S.blk_expert = nullptr;
#if DENSE_FP8 == 2
                pg8::EpiSwigluF8S E{(unsigned char*)ACT, 44, 4.f};
                GEMMCALL(pg8::gemm_phase<pg8::EpiSwigluF8S, pg8::Order<false>, true, GEMM_SP2>(lds, g, S, E);)
#else
                pg8::EpiSwiglu E{ACT, TILE_ACT ? 88 : -11264};
                GEMMCALL(pg8::gemm_phase<pg8::EpiSwiglu, pg8::Order<false>, GEMM_ALIGN, GEMM_SP2>(lds, g, S, E);)
#endif
#endif
            } else {
                const int nrb = __builtin_amdgcn_readfirstlane(__hip_atomic_load(nrb_p, RLX_AGENT));
                pg8::Gemm g{TILE_HS ? 64 : 1024, TILE_EWGU ? 64 : 1024, 1024, 0, MOE_UP_FMT == 2 ? 0x7f7f7f78 : 0x7f7f7f77, TILE_HS ? 32768 : 128, TILE_EWGU ? 32768 : 128}; pg8::Order<true> S; S.init(nrb, 56, G, (int)blockIdx.x);
                S.A = (const char*)HS; S.B = (const char*)(ws + WS_EWGU); S.a_pm = (size_t)256 * 2048; S.a_pn = 0; S.b_pn = (size_t)256 * 2048; S.b_e = (size_t)14336 * 2048; S.blk_expert = blk_expert;
                pg8::EpiSwigluF8S E{(unsigned char*)ACT2, 56, 4.f};
#if defined(KPROBE) && KPROBE_PHASE == 18
                if (args.pad) { GEMMCALL(pg8::gemm_phase<pg8::EpiSwigluF8S, pg8::Order<true>, true, GEMM_SP2, MOE_UP_FMT, KPROBE>(lds, g, S, E);) } else
#endif
                GEMMCALL(pg8::gemm_phase<pg8::EpiSwigluF8S, pg8::Order<true>, true, GEMM_SP2, MOE_UP_FMT>(lds, g, S, E);)
            }
        }
        SEAM(pb + PK_UP);
        if (IN(pb + PK_DOWN)) {
            if (l == 0) {
#if DENSE_FP8
                pg8::Gemm g{64, 64, 2816, 0, 0x7f7f7f76, 32768, 32768}; pg8::Order<false> S; S.init(T / 256, 8, G, (int)blockIdx.x);
                S.A = (const char*)ACT; S.B = (const char*)(ws + WS_WD); S.a_pm = (size_t)256 * 5632; S.a_pn = 0; S.b_pn = (size_t)256 * 5632; S.b_e = 0; S.blk_expert = nullptr;
                pg8::EpiRes<false> E{XS, XS, 2048};
                GEMMCALL(pg8::gemm_phase<pg8::EpiRes<false>, pg8::Order<false>, true, true, 1>(lds, g, S, E);)
#else
                pg8::Gemm g{TILE_ACT ? 64 : 5632, 64, 5632, 0, 0, TILE_ACT ? 32768 : 128, 32768}; pg8::Order<false> S; S.init(T / 256, 8, G, (int)blockIdx.x);
                S.A = (const char*)ACT; S.B = (const char*)(ws + WS_WD); S.a_pm = (size_t)256 * 5632 * 2; S.a_pn = 0; S.b_pn = (size_t)256 * 5632 * 2; S.b_e = 0; S.blk_expert = nullptr;
                pg8::EpiRes<false> E{XS, XS, 2048};
                GEMMCALL(pg8::gemm_phase<pg8::EpiRes<false>, pg8::Order<false>, true, true>(lds, g, S, E);)
#endif
            } else {
                const int nrb = __builtin_amdgcn_readfirstlane(__hip_atomic_load(nrb_p, RLX_AGENT));
                pg8::Gemm g{TILE_ACT2 ? 64 : 3584, 64, 3584, 0, 0x7f7f7f76, TILE_ACT2 ? 32768 : 128, 32768}; pg8::Order<true> S; S.init(nrb, 8, G, (int)blockIdx.x);
                S.A = (const char*)ACT2; S.B = (const char*)(ws + WS_EWD); S.a_pm = (size_t)256 * 7168; S.a_pn = 0; S.b_pn = (size_t)256 * 7168; S.b_e = (size_t)2048 * 7168; S.blk_expert = blk_expert;
                int full, tail, sk; moe_tail_split(nrb, G, full, tail, sk); S.Lend = full;
                pg8::EpiBf16 E{Y, 2048, nullptr};
#if defined(KPROBE) && KPROBE_PHASE == 19
                if (args.pad) { GEMMCALL(pg8::gemm_phase<pg8::EpiBf16, pg8::Order<true>, GEMM_ALIGN, GEMM_SP2, 1, KPROBE>(lds, g, S, E);) } else
#endif
                GEMMCALL(pg8::gemm_phase<pg8::EpiBf16, pg8::Order<true>, GEMM_ALIGN, GEMM_SP2, 1>(lds, g, S, E);)
                if (sk > 0) {
                    const int kq = 3584 / sk;
                    pg8::Gemm g2{TILE_ACT2 ? 64 : 3584, 64, kq, 0, 0x7f7f7f76, TILE_ACT2 ? 32768 : 128, 32768}; pg8::TailOrder S2; S2.nM = nrb; S2.nN = 8; S2.c = (int)blockIdx.x; S2.full = full; S2.tail = tail; S2.s = sk; S2.ksliceA = TILE_ACT2 ? (size_t)(kq / 64) * 32768 : (size_t)kq * 2; S2.ksliceB = (size_t)(kq / 64) * 32768;
                    S2.A = (const char*)ACT2; S2.B = (const char*)(ws + WS_EWD); S2.a_pm = (size_t)256 * 7168; S2.b_pn = (size_t)256 * 7168; S2.b_e = (size_t)2048 * 7168; S2.blk_expert = blk_expert;
                    pg8::EpiPart E2{(float*)(ws + WS_PART)};
                    GEMMCALL(pg8::gemm_phase<pg8::EpiPart, pg8::TailOrder, false, GEMM_SP2, 1>(lds, g2, S2, E2);)
                }
            }
        }
        SEAM(pb + PK_DOWN);
        if (IN(pb + PK_TAIL)) {
            if (l == 0) NORMCALL(norm_phase<0>(lds, XS, mix_norm + DM, H, w_in + (size_t)DM * ZW + 3072, ZW, GLR, nullptr, nullptr, nullptr, tid, lane, wave, G);)
            else FINCALL(final_phase(lds, XS, Y, (const float*)(ws + WS_PART), nrb_p, tok_slot, topw, final_norm, args.out, tid, lane, wave, G);)
        }
        if (l == 0) SEAM(pb + PK_TAIL);
    }
#undef IN
#undef SEAM
}
}
#ifndef MK_MODE
#define MK_MODE 0
#endif
#ifndef DBG_CUT
#define DBG_CUT 0
#endif
namespace dbg {
using fz::bf16_t;
__global__ __launch_bounds__(256) void k_cvt_z(const bf16_t* Z, const float* GLR, float* z) {
    const size_t i = (size_t)blockIdx.x * 256 + threadIdx.x; if (i >= (size_t)T * ZW) return;
    const int t = (int)(i / ZW), c = (int)(i % ZW);
    float v;
    if (c < 3072) v = fz::bf2f(Z[(size_t)t * 4096 + c]); else if (c < 3088) v = GLR[(size_t)t * 16 + (c - 3072)]; else v = fz::bf2f(Z[(size_t)t * 4096 + c - 16]);
    z[i] = v;
}
__global__ __launch_bounds__(256) void k_cvt_bf(const bf16_t* in, float* out, size_t n) {
    const size_t i = (size_t)blockIdx.x * 256 + threadIdx.x; if (i < n) out[i] = fz::bf2f(in[i]);
}
}

static void launch_fused(const fz::Args& base, int lo, int hi, int grid, hipStream_t stream) {
    fz::Args a = base; a.ph_lo = lo; a.ph_hi = hi;
    hipLaunchKernelGGL(fz::fwd, dim3(grid), dim3(fz::NTHR), fz::LDS_BYTES, stream, a);
}

extern "C" void kernel_launch(void* const* d_in, const int* in_sizes, int n_in, void* d_out, int out_size, void* d_ws, size_t ws_size, hipStream_t stream) {
    static int grid = 0;
    if (grid == 0) {
        int dev = 0, cus = 0;
        if (hipGetDevice(&dev) != hipSuccess || hipDeviceGetAttribute(&cus, hipDeviceAttributeMultiprocessorCount, dev) != hipSuccess) { grid = -1; return; }
        if (hipFuncSetAttribute((const void*)fz::fwd, hipFuncAttributeMaxDynamicSharedMemorySize, fz::LDS_BYTES) != hipSuccess) { fprintf(stderr, "hipFuncSetAttribute failed\n"); grid = -1; return; }
        int per_cu = 0;
        if (hipOccupancyMaxActiveBlocksPerMultiprocessor(&per_cu, (const void*)fz::fwd, fz::NTHR, fz::LDS_BYTES) != hipSuccess || per_cu < 1) fprintf(stderr, "occupancy query: %d\n", per_cu);
        (void)hipGetLastError();
        grid = cus;
        if (ws_size < fz::WS_END) { fprintf(stderr, "workspace too small\n"); grid = -1; return; }
    }
    if (grid < 0) return;
    unsigned char* ws = (unsigned char*)d_ws;
    (void)hipMemsetAsync(ws + fz::WS_CTL + (size_t)fz::CW_BAR * 4, 0, 16384, stream);
    fz::Args a{};
    for (int i = 0; i < 18; ++i) a.in[i] = (const float*)d_in[i];
    a.out = (float*)d_out; a.ws = ws; a.cvt_items = fz::CI_TOTAL;
#if MK_MODE == 0
    launch_fused(a, 0, fz::NPH, grid, stream);
#elif MK_MODE == 1
    for (int p = 0; p < fz::NPH; ++p) { if (p == 1 + fz::PK_ASSIGN) continue;
#ifdef KPROBE
        if (p == KPROBE_PHASE) { fz::Args b = a; b.pad = 1; for (int rr = 0; rr < KPROBE_N; ++rr) launch_fused(b, p, p + 1, grid, stream); }
#endif
        launch_fused(a, p, p + 1, grid, stream);
#ifdef REP_HI
#ifndef REP_N
#define REP_N 1
#endif
        if (p == REP_HI) for (int rr = 0; rr < REP_N; ++rr) for (int q = REP_LO; q <= REP_HI; ++q) { if (q == 1 + fz::PK_ASSIGN) continue; launch_fused(a, q, q + 1, grid, stream); }
#endif
    }
#elif MK_MODE == 2
    {
        const int l = DBG_CUT / 10, kind = DBG_CUT % 10; const int pb = 1 + fz::PH_PER_LAYER * l;
        const int pcut = kind == 1 ? pb + 1 : kind == 2 ? pb + 4 : kind == 3 ? pb + 5 : kind == 4 ? pb + 6 : pb + 9;
        const int scut = kind == 1 ? 7 * l + 2 : kind == 2 ? 7 * l + 4 : kind == 3 ? 7 * l + 5 : kind == 4 ? 7 * l + 6 : 7 * l + 7;
        a.cvt_items = fz::CI_NONEXP;
        for (int p = 0; p < pcut; ++p) { if (p == 1 + fz::PK_ASSIGN) continue; launch_fused(a, p, p + 1, grid, stream); }
        ora::Bufs B = ora::make_bufs(ws + fz::WS_EWGU, (float*)(ws + fz::WS_XS));
        if (kind == 1) hipLaunchKernelGGL(dbg::k_cvt_z, dim3((unsigned)(((size_t)T * ZW + 255) / 256)), dim3(256), 0, stream, (const fz::bf16_t*)(ws + fz::WS_Z), (const float*)(ws + fz::WS_GLR), B.z);
        if (kind == 2) hipLaunchKernelGGL(dbg::k_cvt_bf, dim3((unsigned)(((size_t)T * 2048 + 255) / 256)), dim3(256), 0, stream, (const fz::bf16_t*)(ws + fz::WS_MIX), B.mixf, (size_t)T * 2048);
        if (kind == 4) hipLaunchKernelGGL(dbg::k_cvt_bf, dim3((unsigned)(((size_t)T * 2048 + 255) / 256)), dim3(256), 0, stream, (const fz::bf16_t*)(ws + fz::WS_H), B.hf, (size_t)T * 2048);
        ora::run_range(d_in, (float*)d_out, B, scut, 15, stream);
    }
#elif MK_MODE == 3
    {
        const int scut = DBG_CUT; const int pcut = scut == 5 ? 1 + fz::PK_NORM2 : scut == 7 ? 1 + fz::PK_TAIL : 1 + fz::PH_PER_LAYER + fz::PK_NORM2;
        ora::Bufs B = ora::make_bufs(ws + fz::WS_EWGU, (float*)(ws + fz::WS_XS));
        ora::run_range(d_in, (float*)d_out, B, 0, scut, stream);
        launch_fused(a, 0, 1, grid, stream);
        for (int p = pcut; p < fz::NPH; ++p) { if (p == 1 + fz::PK_ASSIGN) continue; launch_fused(a, p, p + 1, grid, stream); }
    }
#endif
}
```
